# Optimizing an MI355X kernel written in HIP

```python
import jax
import jax.numpy as jnp
from jax import lax
import numpy as np

D_MODEL = 1024
BATCH = 8
SEQ = 4096
DEPTH = 1

HEAD_DIM = 64
MIX_WIDTH = D_MODEL
N_FOX_HEADS = MIX_WIDTH // (2 * HEAD_DIM)
N_SWA_HEADS = MIX_WIDTH // (2 * HEAD_DIM)
N_SWA_KV_HEADS = 2
SWA_GROUP = N_SWA_HEADS // N_SWA_KV_HEADS
WINDOW = 128
Q_BLOCK = 128
ROPE_THETA = 10000.0
N_MEM = 256
N_XATTN_HEADS = 4
XATTN_HEAD_DIM = D_MODEL // N_XATTN_HEADS
N_GROUPS = 4
EXPERTS_PER_GROUP = 8
N_EXPERTS = N_GROUPS * EXPERTS_PER_GROUP
TOP_K_IN_GROUP = 2
D_EXPERT = 512
ROW_BLOCK = 128
LN_EPS = 1e-5
FOX_W = N_FOX_HEADS * HEAD_DIM
SWA_Q_W = N_SWA_HEADS * HEAD_DIM
SWA_KV_W = N_SWA_KV_HEADS * HEAD_DIM
IN_SIZES = (FOX_W, FOX_W, FOX_W, N_FOX_HEADS, SWA_Q_W, SWA_KV_W, SWA_KV_W)
IN_PROJ_W = sum(IN_SIZES)

kernel_name = 'hybrid_fox_swa_sink_hmoe_deepnorm'


def layer_norm(x, g, b):
    xf = x.astype(jnp.float32)
    mu = jnp.mean(xf, axis=-1, keepdims=True)
    var = jnp.mean(jnp.square(xf - mu), axis=-1, keepdims=True)
    y = (xf - mu) * lax.rsqrt(var + LN_EPS) * g.astype(jnp.float32) + b.astype(jnp.float32)
    return y.astype(x.dtype)


def rope(x, positions):
    half = x.shape[-1] // 2
    inv_freq = ROPE_THETA ** (-jnp.arange(half, dtype=jnp.float32) / half)
    ang = positions.astype(jnp.float32)[..., None] * inv_freq
    cos = jnp.cos(ang)[:, :, None, :]
    sin = jnp.sin(ang)[:, :, None, :]
    xf = x.astype(jnp.float32)
    x1, x2 = xf[..., :half], xf[..., half:]
    return jnp.concatenate([x1 * cos - x2 * sin, x2 * cos + x1 * sin], axis=-1).astype(x.dtype)


def forgetting_attention(q, k, v, log_f):
    B, S, H, dh = q.shape
    nb = S // Q_BLOCK
    scale = dh ** -0.5
    c = jnp.cumsum(log_f, axis=1).transpose(0, 2, 1)
    kh = k.transpose(0, 2, 1, 3)
    vh = v.transpose(0, 2, 1, 3)
    qb = q.reshape(B, nb, Q_BLOCK, H, dh).transpose(1, 0, 3, 2, 4)
    cb = c.reshape(B, H, nb, Q_BLOCK).transpose(2, 0, 1, 3)
    key_pos = jnp.arange(S)

    def block(args):
        q_blk, c_blk, i = args
        s = jnp.einsum('bhqd,bhsd->bhqs', q_blk, kh).astype(jnp.float32) * scale
        s = s + c_blk[..., None] - c[:, :, None, :]
        qpos = i * Q_BLOCK + jnp.arange(Q_BLOCK)
        causal = key_pos[None, :] <= qpos[:, None]
        s = jnp.where(causal, s, -jnp.inf)
        p = jax.nn.softmax(s, axis=-1)
        return jnp.einsum('bhqs,bhsd->bhqd', p.astype(vh.dtype), vh)

    o = lax.map(block, (qb, cb, jnp.arange(nb)))
    return o.transpose(1, 0, 3, 2, 4).reshape(B, S, H * dh)


def sliding_window_sink_attention(q, k, v, sinks):
    B, S, _, dh = q.shape
    nb = S // WINDOW
    scale = dh ** -0.5
    qb = q.reshape(B, nb, WINDOW, N_SWA_KV_HEADS, SWA_GROUP, dh)

    def band(t):
        t = t.reshape(B, nb, WINDOW, N_SWA_KV_HEADS, dh)
        prev = jnp.concatenate([jnp.zeros_like(t[:, :1]), t[:, :-1]], axis=1)
        return jnp.concatenate([prev, t], axis=2)

    kb, vb = band(k), band(v)
    s = jnp.einsum('bnqkgd,bnskd->bnkgqs', qb, kb).astype(jnp.float32) * scale
    blk = jnp.arange(nb)[:, None, None] * WINDOW
    qpos = blk + jnp.arange(WINDOW)[None, :, None]
    kpos = blk + jnp.arange(2 * WINDOW)[None, None, :] - WINDOW
    valid = (kpos <= qpos) & (qpos - kpos < WINDOW) & (kpos >= 0)
    s = jnp.where(valid[None, :, None, None], s, -jnp.inf)
    sink = jnp.broadcast_to(
        sinks.astype(jnp.float32).reshape(1, 1, N_SWA_KV_HEADS, SWA_GROUP, 1, 1),
        s.shape[:-1] + (1,))
    p = jax.nn.softmax(jnp.concatenate([s, sink], axis=-1), axis=-1)[..., :-1]
    o = jnp.einsum('bnkgqs,bnskd->bnqkgd', p.astype(vb.dtype), vb)
    return o.reshape(B, S, N_SWA_HEADS * dh)


def hybrid_mixer(h, positions, w_in, b_forget, sinks, w_out):
    B, S, _ = h.shape
    z = h @ w_in
    splits = [int(v) for v in np.cumsum(IN_SIZES)[:-1]]
    q_f, k_f, v_f, f_logit, q_s, k_s, v_s = jnp.split(z, splits, axis=-1)
    log_f = jax.nn.log_sigmoid((f_logit + b_forget).astype(jnp.float32))
    o_fox = forgetting_attention(
        q_f.reshape(B, S, N_FOX_HEADS, HEAD_DIM),
        k_f.reshape(B, S, N_FOX_HEADS, HEAD_DIM),
        v_f.reshape(B, S, N_FOX_HEADS, HEAD_DIM), log_f)
    q_s = rope(q_s.reshape(B, S, N_SWA_HEADS, HEAD_DIM), positions)
    k_s = rope(k_s.reshape(B, S, N_SWA_KV_HEADS, HEAD_DIM), positions)
    v_s = v_s.reshape(B, S, N_SWA_KV_HEADS, HEAD_DIM)
    o_swa = sliding_window_sink_attention(q_s, k_s, v_s, sinks)
    return jnp.concatenate([o_fox, o_swa], axis=-1) @ w_out


def memory_cross_attention(h, mem, w_q, w_kv, w_out):
    B, S, D = h.shape
    M = mem.shape[1]
    q = (h @ w_q).reshape(B, S, N_XATTN_HEADS, XATTN_HEAD_DIM)
    k, v = jnp.split(mem @ w_kv, 2, axis=-1)
    k = k.reshape(B, M, N_XATTN_HEADS, XATTN_HEAD_DIM)
    v = v.reshape(B, M, N_XATTN_HEADS, XATTN_HEAD_DIM)
    s = jnp.einsum('bqhd,bmhd->bhqm', q, k).astype(jnp.float32) * (XATTN_HEAD_DIM ** -0.5)
    p = jax.nn.softmax(s, axis=-1)
    o = jnp.einsum('bhqm,bmhd->bqhd', p.astype(v.dtype), v).reshape(B, S, D)
    return o @ w_out


def hierarchical_moe(h, w_rg, b_rg, w_re, b_re, w_gate, w_up, w_down):
    B, S, D = h.shape
    T = B * S
    xt = h.reshape(T, D)
    p_g = jax.nn.softmax((xt @ w_rg + b_rg).astype(jnp.float32), axis=-1)
    g_val, g_idx = lax.top_k(p_g, 1)
    g_val, g_idx = g_val[:, 0], g_idx[:, 0]
    el = jnp.einsum('td,gde->tge', xt, w_re) + b_re
    sel = jnp.take_along_axis(el, g_idx[:, None, None], axis=1)[:, 0].astype(jnp.float32)
    e_val, e_idx = lax.top_k(sel, TOP_K_IN_GROUP)
    gate = (g_val[:, None] * jax.nn.softmax(e_val, axis=-1)).astype(h.dtype)
    expert_id = g_idx[:, None] * EXPERTS_PER_GROUP + e_idx

    A = T * TOP_K_IN_GROUP
    flat_e = expert_id.reshape(-1).astype(jnp.int32)
    flat_tok = jnp.repeat(jnp.arange(T, dtype=jnp.int32), TOP_K_IN_GROUP)
    flat_w = gate.reshape(-1)
    order = jnp.argsort(flat_e, stable=True)
    se, st, sw = flat_e[order], flat_tok[order], flat_w[order]
    counts = jax.ops.segment_sum(jnp.ones_like(flat_e), flat_e, num_segments=N_EXPERTS)
    start = jnp.cumsum(counts) - counts
    padded = ((counts + ROW_BLOCK - 1) // ROW_BLOCK) * ROW_BLOCK
    pad_end = jnp.cumsum(padded)
    pad_start = pad_end - padded
    dest = pad_start[se] + (jnp.arange(A, dtype=jnp.int32) - start[se])
    P = A + N_EXPERTS * ROW_BLOCK
    NB = P // ROW_BLOCK
    row_tok = jnp.full((P,), T, dtype=jnp.int32).at[dest].set(st)
    row_w = jnp.zeros((P,), dtype=h.dtype).at[dest].set(sw)
    block_e = jnp.clip(jnp.searchsorted(pad_end, jnp.arange(NB, dtype=jnp.int32) * ROW_BLOCK,
                                        side='right'), 0, N_EXPERTS - 1)
    xt_pad = jnp.concatenate([xt, jnp.zeros((1, D), dtype=xt.dtype)], axis=0)
    xr = xt_pad[row_tok].reshape(NB, ROW_BLOCK, D)

    def expert_block(args):
        xb, e = args
        a = jax.nn.silu(xb @ w_gate[e]) * (xb @ w_up[e])
        return a @ w_down[e]

    yr = lax.map(expert_block, (xr, block_e)).reshape(P, D)
    y = jax.ops.segment_sum(yr * row_w[:, None], row_tok, num_segments=T + 1)[:T]
    return y.reshape(B, S, D)


def setup_inputs(seed: int = 0) -> dict:
    key = jax.random.key(seed)
    ks = jax.random.split(key, 24)
    f32 = jnp.float32

    def nrm(k, shape, s):
        return jax.random.normal(k, shape, f32) * s

    beta = (8.0 * DEPTH) ** -0.25
    d_in = D_MODEL ** -0.5
    L = DEPTH
    x = jax.random.normal(ks[0], (BATCH, SEQ, D_MODEL), f32)
    mem = jax.random.normal(ks[1], (BATCH, N_MEM, D_MODEL), f32)
    start = jax.random.randint(ks[2], (BATCH, 1), 0, 1024, dtype=jnp.int32)
    positions = start + jnp.arange(SEQ, dtype=jnp.int32)[None, :]
    w_in = nrm(ks[3], (L, D_MODEL, IN_PROJ_W), d_in)
    b_forget = jnp.linspace(1.0, 6.0, N_FOX_HEADS, dtype=f32)[None, :] + nrm(ks[4], (L, N_FOX_HEADS), 0.01)
    sinks = nrm(ks[5], (L, N_SWA_HEADS), 0.5)
    w_mix_out = nrm(ks[6], (L, MIX_WIDTH, D_MODEL), MIX_WIDTH ** -0.5 * beta)
    ln_mix_g = 1.0 + nrm(ks[7], (L, D_MODEL), 0.02)
    ln_mix_b = nrm(ks[8], (L, D_MODEL), 0.02)
    w_xq = nrm(ks[9], (L, D_MODEL, D_MODEL), d_in)
    w_xkv = nrm(ks[10], (L, D_MODEL, 2 * D_MODEL), d_in)
    w_xout = nrm(ks[11], (L, D_MODEL, D_MODEL), d_in * beta)
    ln_x_g = 1.0 + nrm(ks[12], (L, D_MODEL), 0.02)
    ln_x_b = nrm(ks[13], (L, D_MODEL), 0.02)
    w_route_group = nrm(ks[14], (L, D_MODEL, N_GROUPS), d_in)
    b_route_group = nrm(ks[15], (L, N_GROUPS), 0.01)
    w_route_expert = nrm(ks[16], (L, N_GROUPS, D_MODEL, EXPERTS_PER_GROUP), d_in)
    b_route_expert = nrm(ks[17], (L, N_GROUPS, EXPERTS_PER_GROUP), 0.01)
    w_exp_gate = nrm(ks[18], (L, N_EXPERTS, D_MODEL, D_EXPERT), d_in)
    w_exp_up = nrm(ks[19], (L, N_EXPERTS, D_MODEL, D_EXPERT), d_in)
    w_exp_down = nrm(ks[20], (L, N_EXPERTS, D_EXPERT, D_MODEL), D_EXPERT ** -0.5 * beta)
    ln_ffn_g = 1.0 + nrm(ks[21], (L, D_MODEL), 0.02)
    ln_ffn_b = nrm(ks[22], (L, D_MODEL), 0.02)
    return {'x': x, 'mem': mem, 'positions': positions, 'w_in': w_in, 'b_forget': b_forget,
            'sinks': sinks, 'w_mix_out': w_mix_out, 'ln_mix_g': ln_mix_g, 'ln_mix_b': ln_mix_b,
            'w_xq': w_xq, 'w_xkv': w_xkv, 'w_xout': w_xout, 'ln_x_g': ln_x_g, 'ln_x_b': ln_x_b,
            'w_route_group': w_route_group, 'b_route_group': b_route_group,
            'w_route_expert': w_route_expert, 'b_route_expert': b_route_expert,
            'w_exp_gate': w_exp_gate, 'w_exp_up': w_exp_up, 'w_exp_down': w_exp_down,
            'ln_ffn_g': ln_ffn_g, 'ln_ffn_b': ln_ffn_b}


def reference(x, mem, positions, w_in, b_forget, sinks, w_mix_out, ln_mix_g, ln_mix_b,
              w_xq, w_xkv, w_xout, ln_x_g, ln_x_b, w_route_group, b_route_group,
              w_route_expert, b_route_expert, w_exp_gate, w_exp_up, w_exp_down,
              ln_ffn_g, ln_ffn_b):
    alpha = (2.0 * DEPTH) ** 0.25
    h = x
    for l in range(DEPTH):
        h = layer_norm(alpha * h + hybrid_mixer(h, positions, w_in[l], b_forget[l], sinks[l], w_mix_out[l]),
                       ln_mix_g[l], ln_mix_b[l])
        h = layer_norm(alpha * h + memory_cross_attention(h, mem, w_xq[l], w_xkv[l], w_xout[l]),
                       ln_x_g[l], ln_x_b[l])
        h = layer_norm(alpha * h + hierarchical_moe(h, w_route_group[l], b_route_group[l],
                                                    w_route_expert[l], b_route_expert[l],
                                                    w_exp_gate[l], w_exp_up[l], w_exp_down[l]),
                       ln_ffn_g[l], ln_ffn_b[l])
    return h
```

```cpp
#include <hip/hip_runtime.h>
#include <cstdio>
#include <cstdint>

typedef _Float16 half_t;
typedef _Float16 h2_t __attribute__((ext_vector_type(2)));
typedef _Float16 h4_t __attribute__((ext_vector_type(4)));
typedef _Float16 h8_t __attribute__((ext_vector_type(8)));
typedef float f2_t __attribute__((ext_vector_type(2)));
typedef float f4_t __attribute__((ext_vector_type(4)));
typedef unsigned u4_t __attribute__((ext_vector_type(4)));
#define LAS __attribute__((address_space(3)))

constexpr int DM = 1024, NB = 8, SEQ = 4096, T = NB * SEQ;
constexpr int NMEM = 256, MROWS = NB * NMEM;
constexpr int INW = 2312, ZW = 2304;
constexpr int NEXP = 32, DEXP = 512, LCAP = T;
constexpr float ALPHA = 1.189207115002721f;
constexpr float LOG2E = 1.4426950408889634f;
constexpr float C2_64 = 0.125f * LOG2E;
constexpr float C2_256 = 0.0625f * LOG2E;
constexpr float LN_EPS = 1e-5f;
constexpr int ZQF = 0, ZKF = 512, ZVF = 1024, ZQS = 1536, ZKS = 2048, ZVS = 2176;

constexpr size_t MiB = 1u << 20;
constexpr size_t WS_CTL = 0, CTL_BYTES = 1 * MiB;
constexpr size_t WS_WIN = 1 * MiB;
constexpr size_t WS_WMO = 6 * MiB;
constexpr size_t WS_WXQ = 8 * MiB, WS_WXK = 10 * MiB, WS_WXV = 12 * MiB, WS_WXO = 14 * MiB;
constexpr size_t WS_WR = 16 * MiB;
constexpr size_t WS_WGU = 17 * MiB;
constexpr size_t WS_WD = 81 * MiB;
constexpr size_t WS_LOGF = 113 * MiB;
constexpr size_t WS_CUM = 114 * MiB;
constexpr size_t WS_MEMH = 115 * MiB;
constexpr size_t WS_KX = 119 * MiB;
constexpr size_t WS_VXT = 123 * MiB;
constexpr size_t WS_LG = 127 * MiB;
constexpr size_t WS_LTOK = 151 * MiB;
constexpr size_t WS_LW = 155 * MiB;
constexpr size_t WS_XH = 160 * MiB;
constexpr size_t WS_H2 = WS_XH;
constexpr size_t WS_Z = 224 * MiB;
constexpr size_t WS_QX = 224 * MiB;
constexpr size_t WS_PX = 288 * MiB;
constexpr size_t WS_Y = 224 * MiB;
constexpr size_t WS_TMP = 224 * MiB;
constexpr size_t WS_O = 368 * MiB;
constexpr size_t WS_OX = 368 * MiB;
constexpr size_t WS_ACT = 368 * MiB;
constexpr size_t WS_H1 = 432 * MiB;
constexpr size_t WS_END = 500 * MiB;
constexpr int CW_CNT = 64;

struct Params {
    const float* x; const float* mem; const int* pos; const float* w_in; const float* b_forget; const float* sinks; const float* w_mix_out;
    const float* ln_mix_g; const float* ln_mix_b; const float* w_xq; const float* w_xkv; const float* w_xout; const float* ln_x_g; const float* ln_x_b;
    const float* w_rg; const float* b_rg; const float* w_re; const float* b_re; const float* w_gate; const float* w_up; const float* w_down;
    const float* ln_f_g; const float* ln_f_b;
    float* out; unsigned char* ws;
};

__device__ __forceinline__ float wave_sum(float v) {
#pragma unroll
    for (int o = 1; o < 64; o <<= 1) v += __shfl_xor(v, o);
    return v;
}
__device__ __forceinline__ unsigned pkh(float lo, float hi) { f2_t v = {lo, hi}; h2_t h = __builtin_convertvector(v, h2_t); return __builtin_bit_cast(unsigned, h); }
__device__ __forceinline__ float inv_freq(int i) { return exp2f(-(float)i * (13.287712379549449f / 32.0f)); }
__device__ __forceinline__ void rope_cs(int pos, int i, float& c, float& s) {
    const float ang = (float)pos * inv_freq(i);
    const float rev = ang * 0.15915494309189535f; const float fr = rev - floorf(rev);
    s = __builtin_amdgcn_sinf(fr); c = __builtin_amdgcn_cosf(fr);
}

__device__ __forceinline__ int win_dest(int c) {
    if (c < 1536) return c;
    if (c < 1544) return -1;
    if (c < 2056) { const int cc = c - 1544, hd = cc >> 6, d = cc & 63; return ZQS + hd * 64 + ((d < 32) ? 2 * d : 2 * (d - 32) + 1); }
    if (c < 2184) { const int cc = c - 2056, hd = cc >> 6, d = cc & 63; return ZKS + hd * 64 + ((d < 32) ? 2 * d : 2 * (d - 32) + 1); }
    if (c < 2312) return ZVS + (c - 2184);
    return -1;
}
template <class DestFn>
__device__ __forceinline__ void tr_item(const float* W, int ldw, int N, half_t* WT, int ldt, LAS float* scr, int k0, int n0, int lane, DestFn dest) {
#pragma unroll 8
    for (int i = 0; i < 32; ++i) { const int kk = 2 * i + (lane >> 5), n = n0 + (lane & 31); scr[kk * 33 + (lane & 31)] = (n < N) ? W[(size_t)(k0 + kk) * ldw + n] : 0.f; }
    asm volatile("s_waitcnt lgkmcnt(0)" ::: "memory");
    const int c = lane & 7;
#pragma unroll
    for (int j = 0; j < 4; ++j) { const int nl = (lane >> 3) + 8 * j; const LAS float* s = scr + (8 * c) * 33 + nl;
        u4_t o; o.x = pkh(s[0 * 33], s[1 * 33]); o.y = pkh(s[2 * 33], s[3 * 33]); o.z = pkh(s[4 * 33], s[5 * 33]); o.w = pkh(s[6 * 33], s[7 * 33]);
        const int dr = (n0 + nl < N) ? dest(n0 + nl) : -1;
        if (dr >= 0) *(u4_t*)(WT + (size_t)dr * ldt + k0 + 8 * c) = o; }
    asm volatile("s_waitcnt lgkmcnt(0)" ::: "memory");
}
constexpr int P0_LDS = 32768 + 8 * 8448;
__device__ __forceinline__ void phase_prep(const Params& P, LAS unsigned char* lds, int wg, int nwg) {
    const int tid = threadIdx.x, lane = tid & 63, wave = tid >> 6;
    const int gw = wg * 8 + wave, ngw = nwg * 8;
    LAS float* wfT = (LAS float*)lds;
    LAS float* scr = (LAS float*)(lds + 32768 + wave * 8448);
    for (int i = tid; i < 8192; i += 512) { const int h = i >> 10, k = i & 1023; wfT[i] = P.w_in[(size_t)k * INW + 1536 + h]; }
    __syncthreads();
    half_t* XH = (half_t*)(P.ws + WS_XH); float* LOGF = (float*)(P.ws + WS_LOGF);
    for (int row = gw; row < T; row += ngw) {
        const f4_t* xr = (const f4_t*)(P.x + (size_t)row * DM) + lane;
        f4_t v[4];
#pragma unroll
        for (int j = 0; j < 4; ++j) v[j] = xr[64 * j];
#pragma unroll
        for (int j = 0; j < 4; ++j) { unsigned long long w = (unsigned long long)pkh(v[j].x, v[j].y) | ((unsigned long long)pkh(v[j].z, v[j].w) << 32);
            *(unsigned long long*)(XH + (size_t)row * DM + 256 * j + 4 * lane) = w; }
        float s[8];
#pragma unroll
        for (int h = 0; h < 8; ++h) { float a = 0.f;
#pragma unroll
            for (int j = 0; j < 4; ++j) { const f4_t w = *(const LAS f4_t*)(wfT + h * 1024 + 256 * j + 4 * lane); a += v[j].x * w.x + v[j].y * w.y + v[j].z * w.z + v[j].w * w.w; }
            s[h] = wave_sum(a); }
        float r = s[0];
#pragma unroll
        for (int h = 1; h < 8; ++h) r = (lane == h) ? s[h] : r;
        if (lane < 8) { const float z = r + P.b_forget[lane]; const float ls = (z >= 0.f) ? -log1pf(expf(-z)) : (z - log1pf(expf(z))); LOGF[(size_t)row * 8 + lane] = ls; }
    }
    half_t* MEMH = (half_t*)(P.ws + WS_MEMH);
    for (int row = gw; row < MROWS; row += ngw) {
        const f4_t* xr = (const f4_t*)(P.mem + (size_t)row * DM) + lane;
#pragma unroll
        for (int j = 0; j < 4; ++j) { const f4_t v = xr[64 * j]; unsigned long long w = (unsigned long long)pkh(v.x, v.y) | ((unsigned long long)pkh(v.z, v.w) << 32);
            *(unsigned long long*)(MEMH + (size_t)row * DM + 256 * j + 4 * lane) = w; }
    }
    { half_t* WRH = (half_t*)(P.ws + WS_WR); half_t* WRL = WRH + 48 * 1024;
      for (int i = wg * 512 + tid; i < 48 * 1024; i += nwg * 512) { const int r = i >> 10, k = i & 1023; float v = 0.f;
          if (r < 4) v = P.w_rg[k * 4 + r]; else if (r < 36) { const int g = (r - 4) >> 3, e = (r - 4) & 7; v = P.w_re[((size_t)g * 1024 + k) * 8 + e]; }
          v *= 32.f; const half_t hi = (half_t)v; const half_t lo = (half_t)(v - (float)hi); WRH[i] = hi; WRL[i] = lo; } }
    constexpr int I_IN = 16 * 73, I_DD = 16 * 32, I_KV = 16 * 64, I_G = 16 * 16, I_D = 8 * 32;
    constexpr int NIT = I_IN + 3 * I_DD + I_KV + NEXP * (2 * I_G + I_D);
    half_t* WIN = (half_t*)(P.ws + WS_WIN); half_t* WMO = (half_t*)(P.ws + WS_WMO); half_t* WXQ = (half_t*)(P.ws + WS_WXQ); half_t* WXK = (half_t*)(P.ws + WS_WXK);
    half_t* WXO = (half_t*)(P.ws + WS_WXO); half_t* WGU = (half_t*)(P.ws + WS_WGU); half_t* WD = (half_t*)(P.ws + WS_WD);
    for (int it = gw; it < NIT; it += ngw) {
        int r = it;
        if (r < I_IN) { tr_item(P.w_in, INW, INW, WIN, 1024, scr, 64 * (r / 73), 32 * (r % 73), lane, [](int c) { return win_dest(c); }); continue; } r -= I_IN;
        if (r < I_DD) { tr_item(P.w_mix_out, 1024, 1024, WMO, 1024, scr, 64 * (r / 32), 32 * (r % 32), lane, [](int c) { return c; }); continue; } r -= I_DD;
        if (r < I_DD) { tr_item(P.w_xq, 1024, 1024, WXQ, 1024, scr, 64 * (r / 32), 32 * (r % 32), lane, [](int c) { return c; }); continue; } r -= I_DD;
        if (r < I_DD) { tr_item(P.w_xout, 1024, 1024, WXO, 1024, scr, 64 * (r / 32), 32 * (r % 32), lane, [](int c) { return c; }); continue; } r -= I_DD;
        if (r < I_KV) { tr_item(P.w_xkv, 2048, 2048, WXK, 1024, scr, 64 * (r / 64), 32 * (r % 64), lane, [](int c) { return c; }); continue; } r -= I_KV;
        const int e = r / (2 * I_G + I_D); r -= e * (2 * I_G + I_D);
        if (r < I_G) { tr_item(P.w_gate + (size_t)e * 1024 * 512, 512, 512, WGU + (size_t)e * 1024 * 1024, 1024, scr, 64 * (r / 16), 32 * (r % 16), lane, [](int c) { return 2 * c; }); continue; } r -= I_G;
        if (r < I_G) { tr_item(P.w_up + (size_t)e * 1024 * 512, 512, 512, WGU + (size_t)e * 1024 * 1024, 1024, scr, 64 * (r / 16), 32 * (r % 16), lane, [](int c) { return 2 * c + 1; }); continue; } r -= I_G;
        tr_item(P.w_down + (size_t)e * 512 * 1024, 1024, 1024, WD + (size_t)e * 1024 * 512, 512, scr, 64 * (r / 32), 32 * (r % 32), lane, [](int c) { return c; });
    }
}
__global__ void __launch_bounds__(512) k_prep(Params P) {
    extern __shared__ __attribute__((aligned(16))) unsigned char lds[];
    phase_prep(P, (LAS unsigned char*)lds, blockIdx.x, gridDim.x);
}

__device__ __forceinline__ void scan_bh(const Params& P, LAS float* sh, int bh) {
    const int tid = threadIdx.x, lane = tid & 63, wave = tid >> 6, b = bh >> 3, h = bh & 7;
    const float* LOGF = (const float*)(P.ws + WS_LOGF); float* CUM = (float*)(P.ws + WS_CUM);
    float v[8]; float run = 0.f;
#pragma unroll
    for (int i = 0; i < 8; ++i) { run += LOGF[((size_t)b * SEQ + tid * 8 + i) * 8 + h]; v[i] = run; }
    float inc = run;
#pragma unroll
    for (int o = 1; o < 64; o <<= 1) { const float t = __shfl_up(inc, o); if (lane >= o) inc += t; }
    if (lane == 63) sh[wave] = inc;
    __syncthreads();
    float base = inc - run;
    for (int w = 0; w < wave; ++w) base += sh[w];
#pragma unroll
    for (int i = 0; i < 8; ++i) CUM[(size_t)bh * SEQ + tid * 8 + i] = base + v[i];
    __syncthreads();
}
__global__ void __launch_bounds__(512) k_scan(Params P) { __shared__ float sh[8]; scan_bh(P, (LAS float*)sh, blockIdx.x); }

template <class F>
__global__ void __launch_bounds__(256) k_gemm_naive(F f) {
    const int K = f.K;
    __shared__ float As[16][68], Bs[16][68];
    const int z = blockIdx.z, m0 = blockIdx.y * 64, n0 = blockIdx.x * 64, tid = threadIdx.x;
    if (m0 >= f.mrows(z)) return;
    const int lr = tid >> 2, lk = (tid & 3) * 4;
    const half_t* ap = f.arow(z, m0 + lr) + lk; const half_t* bp = f.brow(z, n0 + lr) + lk;
    const int ty = tid >> 4, tx = tid & 15;
    float acc[4][4];
#pragma unroll
    for (int i = 0; i < 4; ++i)
#pragma unroll
        for (int j = 0; j < 4; ++j) acc[i][j] = 0.f;
    for (int k0 = 0; k0 < K; k0 += 16) {
        const h4_t av = *(const h4_t*)(ap + k0), bv = *(const h4_t*)(bp + k0);
        __syncthreads();
#pragma unroll
        for (int i = 0; i < 4; ++i) { As[lk + i][lr] = (float)av[i]; Bs[lk + i][lr] = (float)bv[i]; }
        __syncthreads();
#pragma unroll
        for (int k = 0; k < 16; ++k) { const f4_t a = *(const f4_t*)&As[k][ty * 4], b = *(const f4_t*)&Bs[k][tx * 4];
#pragma unroll
            for (int i = 0; i < 4; ++i)
#pragma unroll
                for (int j = 0; j < 4; ++j) acc[i][j] += a[i] * b[j]; }
    }
#pragma unroll
    for (int i = 0; i < 4; ++i) f.epi(z, m0 + ty * 4 + i, n0 + tx * 4, acc[i]);
}

struct FZ {
    const half_t* XH; const half_t* WIN; half_t* Z; const int* pos; int K, pad;
    __device__ int mrows(int) const { return T; }
    __device__ const half_t* arow(int, int m) const { return XH + (size_t)m * DM; }
    __device__ const half_t* brow(int, int n) const { return WIN + (size_t)n * DM; }
    __device__ void epi(int, int m, int n0, float* v) const {
        float o[4] = {v[0], v[1], v[2], v[3]};
        if (n0 >= ZQS && n0 < ZVS) { const int p = pos[m]; const int i0 = (n0 & 63) >> 1; float c, s;
            rope_cs(p, i0, c, s); o[0] = v[0] * c - v[1] * s; o[1] = v[1] * c + v[0] * s;
            rope_cs(p, i0 + 1, c, s); o[2] = v[2] * c - v[3] * s; o[3] = v[3] * c + v[2] * s; }
        if (n0 < ZKF || (n0 >= ZQS && n0 < ZKS)) { o[0] *= C2_64; o[1] *= C2_64; o[2] *= C2_64; o[3] *= C2_64; }
        unsigned long long w = (unsigned long long)pkh(o[0], o[1]) | ((unsigned long long)pkh(o[2], o[3]) << 32);
        *(unsigned long long*)(Z + (size_t)m * ZW + n0) = w;
    }
};
struct FPlain {
    const half_t* A; const half_t* B; half_t* C; int lda, ldb, ldc, M; float scale; int K;
    __device__ int mrows(int) const { return M; }
    __device__ const half_t* arow(int, int m) const { return A + (size_t)m * lda; }
    __device__ const half_t* brow(int, int n) const { return B + (size_t)n * ldb; }
    __device__ void epi(int, int m, int n0, float* v) const {
        unsigned long long w = (unsigned long long)pkh(v[0] * scale, v[1] * scale) | ((unsigned long long)pkh(v[2] * scale, v[3] * scale) << 32);
        *(unsigned long long*)(C + (size_t)m * ldc + n0) = w;
    }
};
struct FTmp {
    const half_t* A; const half_t* B; float* C; int K, pad;
    __device__ int mrows(int) const { return T; }
    __device__ const half_t* arow(int, int m) const { return A + (size_t)m * DM; }
    __device__ const half_t* brow(int, int n) const { return B + (size_t)n * DM; }
    __device__ void epi(int, int m, int n0, float* v) const { *(f4_t*)(C + (size_t)m * DM + n0) = (f4_t){v[0], v[1], v[2], v[3]}; }
};
struct FPV {
    const half_t* PX; const half_t* VXT; half_t* OX; int K, pad;
    __device__ int mrows(int) const { return SEQ; }
    __device__ const half_t* arow(int z, int m) const { return PX + ((size_t)(z >> 2) * SEQ + m) * DM + (z & 3) * 256; }
    __device__ const half_t* brow(int z, int n) const { return VXT + ((size_t)(z & 3) * 256 + n) * MROWS + (z >> 2) * 256; }
    __device__ void epi(int z, int m, int n0, float* v) const {
        unsigned long long w = (unsigned long long)pkh(v[0], v[1]) | ((unsigned long long)pkh(v[2], v[3]) << 32);
        *(unsigned long long*)(OX + ((size_t)(z >> 2) * SEQ + m) * DM + (z & 3) * 256 + n0) = w;
    }
};
__device__ __forceinline__ int pbase_of(const unsigned* cnt, int e) { int b = 0; for (int i = 0; i < e; ++i) b += ((int)cnt[i] + 255) & ~255; return b; }
struct FGU {
    const half_t* H2; const half_t* WGU; half_t* ACT; const unsigned* cnt; const int* ltok; int K, pad;
    __device__ int mrows(int z) const { return (int)cnt[z]; }
    __device__ const half_t* arow(int z, int m) const { const int c = (int)cnt[z]; const int tk = (m < c) ? (ltok[(size_t)z * LCAP + m] >> 1) : 0; return H2 + (size_t)tk * DM; }
    __device__ const half_t* brow(int z, int n) const { return WGU + ((size_t)z * 1024 + n) * 1024; }
    __device__ void epi(int z, int m, int n0, float* v) const {
        const float a0 = v[0] / (1.f + expf(-v[0])) * v[1], a1 = v[2] / (1.f + expf(-v[2])) * v[3];
        *(unsigned*)(ACT + ((size_t)pbase_of(cnt, z) + m) * DEXP + (n0 >> 1)) = pkh(a0, a1);
    }
};
struct FDown {
    const half_t* ACT; const half_t* WD; half_t* Y; const unsigned* cnt; const int* ltok; const float* lw; int K, pad;
    __device__ int mrows(int z) const { return (int)cnt[z]; }
    __device__ const half_t* arow(int z, int m) const { return ACT + ((size_t)pbase_of(cnt, z) + m) * DEXP; }
    __device__ const half_t* brow(int z, int n) const { return WD + ((size_t)z * 1024 + n) * DEXP; }
    __device__ void epi(int z, int m, int n0, float* v) const {
        if (m >= (int)cnt[z]) return;
        const int t2 = ltok[(size_t)z * LCAP + m]; const float g = lw[(size_t)z * LCAP + m];
        unsigned long long w = (unsigned long long)pkh(v[0] * g, v[1] * g) | ((unsigned long long)pkh(v[2] * g, v[3] * g) << 32);
        *(unsigned long long*)(Y + (size_t)t2 * DM + n0) = w;
    }
};

template <int MODE>
__global__ void __launch_bounds__(64) k_attn_naive(Params P) {
    const half_t* Z = (const half_t*)(P.ws + WS_Z); half_t* O = (half_t*)(P.ws + WS_O); const float* CUM = (const float*)(P.ws + WS_CUM);
    const int lane = threadIdx.x, t0 = blockIdx.x * 64, t = t0 + lane, bh = blockIdx.y, b = bh >> 3, h = bh & 7;
    const int qcol = (MODE == 0) ? ZQF + h * 64 : ZQS + h * 64;
    const int kcol = (MODE == 0) ? ZKF + h * 64 : ZKS + (h >> 2) * 64;
    const int vcol = (MODE == 0) ? ZVF + h * 64 : ZVS + (h >> 2) * 64;
    float q[64], o[64];
    { const half_t* qp = Z + ((size_t)b * SEQ + t) * ZW + qcol;
#pragma unroll
      for (int d = 0; d < 64; ++d) { q[d] = (float)qp[d]; o[d] = 0.f; } }
    float m = -INFINITY, l = 0.f;
    const float ct = (MODE == 0) ? CUM[(size_t)bh * SEQ + t] * LOG2E : 0.f;
    const int s_lo = (MODE == 0) ? 0 : ((t0 - 127 > 0) ? t0 - 127 : 0), s_hi = t0 + 63;
    for (int s = s_lo; s <= s_hi; ++s) {
        const half_t* kp = Z + ((size_t)b * SEQ + s) * ZW + kcol; const half_t* vp = Z + ((size_t)b * SEQ + s) * ZW + vcol;
        float sc = 0.f;
#pragma unroll
        for (int d8 = 0; d8 < 8; ++d8) { const h8_t kv = *(const h8_t*)(kp + d8 * 8);
#pragma unroll
            for (int j = 0; j < 8; ++j) sc += q[d8 * 8 + j] * (float)kv[j]; }
        bool ok = (s <= t);
        if (MODE == 0) sc += ct - CUM[(size_t)bh * SEQ + s] * LOG2E; else ok = ok && (t - s < 128);
        if (ok) {
            const float mn = fmaxf(m, sc), f = exp2f(m - mn), p = exp2f(sc - mn);
            l = l * f + p; m = mn;
#pragma unroll
            for (int d8 = 0; d8 < 8; ++d8) { const h8_t vv = *(const h8_t*)(vp + d8 * 8);
#pragma unroll
                for (int j = 0; j < 8; ++j) o[d8 * 8 + j] = o[d8 * 8 + j] * f + p * (float)vv[j]; }
        }
    }
    if (MODE == 1) l += exp2f(P.sinks[h] * LOG2E - m);
    const float rl = 1.f / l;
    half_t* op = O + ((size_t)b * SEQ + t) * DM + ((MODE == 0) ? 0 : 512) + h * 64;
#pragma unroll
    for (int d = 0; d < 64; d += 2) *(unsigned*)(op + d) = pkh(o[d] * rl, o[d + 1] * rl);
}

__global__ void __launch_bounds__(256) k_xs_naive(Params P) {
    const half_t* QX = (const half_t*)(P.ws + WS_QX); const half_t* KX = (const half_t*)(P.ws + WS_KX); half_t* PX = (half_t*)(P.ws + WS_PX);
    __shared__ float S[16][257];
    const int tid = threadIdx.x, r = tid >> 4, c = tid & 15, t = blockIdx.x * 16 + r, h = blockIdx.y, b = t / SEQ;
    const half_t* qp = QX + (size_t)t * DM + h * 256;
    float acc[16];
#pragma unroll
    for (int j = 0; j < 16; ++j) acc[j] = 0.f;
    for (int d0 = 0; d0 < 256; d0 += 8) { const h8_t qv = *(const h8_t*)(qp + d0);
#pragma unroll
        for (int j = 0; j < 16; ++j) { const h8_t kv = *(const h8_t*)(KX + ((size_t)b * 256 + c + 16 * j) * DM + h * 256 + d0);
#pragma unroll
            for (int i = 0; i < 8; ++i) acc[j] += (float)qv[i] * (float)kv[i]; } }
#pragma unroll
    for (int j = 0; j < 16; ++j) S[r][c + 16 * j] = acc[j];
    __syncthreads();
    float mx = -INFINITY;
    for (int j = 0; j < 16; ++j) mx = fmaxf(mx, S[r][c + 16 * j]);
#pragma unroll
    for (int o = 1; o < 16; o <<= 1) mx = fmaxf(mx, __shfl_xor(mx, o));
    float sum = 0.f;
    for (int j = 0; j < 16; ++j) { const float p = exp2f(S[r][c + 16 * j] - mx); S[r][c + 16 * j] = p; sum += p; }
#pragma unroll
    for (int o = 1; o < 16; o <<= 1) sum += __shfl_xor(sum, o);
    const float rs = 1.f / sum;
    for (int j = 0; j < 16; ++j) PX[(size_t)t * DM + h * 256 + c + 16 * j] = (half_t)(S[r][c + 16 * j] * rs);
}

template <int MODE>
__global__ void __launch_bounds__(512) k_ln_naive(Params P) {
    const int lane = threadIdx.x & 63, row = blockIdx.x * 8 + (threadIdx.x >> 6);
    const float* TMP = (const float*)(P.ws + WS_TMP);
    const half_t* H1 = (const half_t*)(P.ws + WS_H1);
    f4_t v[4]; float s = 0.f;
#pragma unroll
    for (int j = 0; j < 4; ++j) { const int c = 256 * j + 4 * lane; f4_t r;
        if (MODE == 0) r = *(const f4_t*)(P.x + (size_t)row * DM + c); else { const h4_t hh = *(const h4_t*)(H1 + (size_t)row * DM + c); r = (f4_t){(float)hh[0], (float)hh[1], (float)hh[2], (float)hh[3]}; }
        v[j] = r * ALPHA + *(const f4_t*)(TMP + (size_t)row * DM + c); s += (v[j].x + v[j].y) + (v[j].z + v[j].w); }
    const float mean = wave_sum(s) * (1.f / DM); float s2 = 0.f;
#pragma unroll
    for (int j = 0; j < 4; ++j) { v[j] = v[j] - mean; s2 += (v[j].x * v[j].x + v[j].y * v[j].y) + (v[j].z * v[j].z + v[j].w * v[j].w); }
    const float rstd = 1.f / sqrtf(wave_sum(s2) * (1.f / DM) + LN_EPS);
    const float* G = (MODE == 0) ? P.ln_mix_g : P.ln_x_g; const float* B = (MODE == 0) ? P.ln_mix_b : P.ln_x_b;
    half_t* OUT = (half_t*)(P.ws + ((MODE == 0) ? WS_H1 : WS_H2));
#pragma unroll
    for (int j = 0; j < 4; ++j) { const int c = 256 * j + 4 * lane; v[j] = v[j] * rstd * *(const f4_t*)(G + c) + *(const f4_t*)(B + c);
        unsigned long long w = (unsigned long long)pkh(v[j].x, v[j].y) | ((unsigned long long)pkh(v[j].z, v[j].w) << 32);
        *(unsigned long long*)(OUT + (size_t)row * DM + c) = w; }
    if (MODE == 1) {
        float* LG = (float*)(P.ws + WS_LG);
        for (int r = 0; r < 36; ++r) { float a = 0.f;
#pragma unroll
            for (int j = 0; j < 4; ++j) { const int c = 256 * j + 4 * lane;
#pragma unroll
                for (int i = 0; i < 4; ++i) { const int k = c + i; const float w = (r < 4) ? P.w_rg[k * 4 + r] : P.w_re[((size_t)((r - 4) >> 3) * 1024 + k) * 8 + ((r - 4) & 7)]; a += v[j][i] * w; } }
            a = wave_sum(a);
            if (lane == 0) { LG[(size_t)row * 48 + r] = a * 32.f; LG[((size_t)T + row) * 48 + r] = 0.f; LG[((size_t)2 * T + row) * 48 + r] = 0.f; LG[((size_t)3 * T + row) * 48 + r] = 0.f; } }
    }
}

__device__ __forceinline__ void route_tokens(const Params& P, LAS unsigned* sh  , int t0) {
    const int tid = threadIdx.x;
    const float* LG = (const float*)(P.ws + WS_LG); unsigned* CNT = (unsigned*)(P.ws + WS_CTL) + CW_CNT;
    int* LTOK = (int*)(P.ws + WS_LTOK); float* LW = (float*)(P.ws + WS_LW);
    if (tid < 64) sh[tid] = 0u;
    __syncthreads();
    int e0 = 0, e1 = 0; float g0 = 0.f, g1 = 0.f; unsigned s0 = 0, s1 = 0;
    if (tid < 128) {
        const int t = t0 + tid;
        float lg[36];
#pragma unroll
        for (int r = 0; r < 36; ++r) lg[r] = (LG[(size_t)t * 48 + r] + LG[((size_t)T + t) * 48 + r] + LG[((size_t)2 * T + t) * 48 + r] + LG[((size_t)3 * T + t) * 48 + r]) * (1.f / 32.f);
        float pg[4]; float mx = -INFINITY;
#pragma unroll
        for (int g = 0; g < 4; ++g) { pg[g] = lg[g] + P.b_rg[g]; mx = fmaxf(mx, pg[g]); }
        float sum = 0.f;
#pragma unroll
        for (int g = 0; g < 4; ++g) { pg[g] = expf(pg[g] - mx); sum += pg[g]; }
        int gi = 0; float gv = pg[0];
#pragma unroll
        for (int g = 1; g < 4; ++g) if (pg[g] > gv) { gv = pg[g]; gi = g; }
        gv /= sum;
        float sel[8];
#pragma unroll
        for (int e = 0; e < 8; ++e) { float a = lg[4 + e];
#pragma unroll
            for (int g = 1; g < 4; ++g) a = (gi == g) ? lg[4 + 8 * g + e] : a;
            sel[e] = a + P.b_re[gi * 8 + e]; }
        int i0 = 0; float v0 = sel[0];
#pragma unroll
        for (int e = 1; e < 8; ++e) if (sel[e] > v0) { v0 = sel[e]; i0 = e; }
        int i1 = -1; float v1 = -INFINITY;
#pragma unroll
        for (int e = 0; e < 8; ++e) if (e != i0 && sel[e] > v1) { v1 = sel[e]; i1 = e; }
        const float p1 = expf(v1 - v0), den = 1.f + p1;
        g0 = gv / den; g1 = gv * p1 / den; e0 = gi * 8 + i0; e1 = gi * 8 + i1;
        s0 = atomicAdd((unsigned*)&sh[e0], 1u); s1 = atomicAdd((unsigned*)&sh[e1], 1u);
    }
    __syncthreads();
    if (tid < 32) { const unsigned c = sh[tid]; sh[32 + tid] = c ? atomicAdd(&CNT[tid], c) : 0u; }
    __syncthreads();
    if (tid < 128) {
        const int t = t0 + tid; const unsigned d0 = sh[32 + e0] + s0, d1 = sh[32 + e1] + s1;
        LTOK[(size_t)e0 * LCAP + d0] = 2 * t; LW[(size_t)e0 * LCAP + d0] = g0;
        LTOK[(size_t)e1 * LCAP + d1] = 2 * t + 1; LW[(size_t)e1 * LCAP + d1] = g1;
    }
    __syncthreads();
}
__global__ void __launch_bounds__(512) k_route(Params P) { __shared__ unsigned sh[64]; route_tokens(P, (LAS unsigned*)sh, blockIdx.x * 128); }

__device__ __forceinline__ void final_ln_row(const Params& P, int row, int lane) {
    const half_t* H2 = (const half_t*)(P.ws + WS_H2); const half_t* Y = (const half_t*)(P.ws + WS_Y);
    f4_t v[4]; float s = 0.f;
#pragma unroll
    for (int j = 0; j < 4; ++j) { const int c = 256 * j + 4 * lane;
        const h4_t hh = *(const h4_t*)(H2 + (size_t)row * DM + c), y0 = *(const h4_t*)(Y + (size_t)(2 * row) * DM + c), y1 = *(const h4_t*)(Y + (size_t)(2 * row + 1) * DM + c);
#pragma unroll
        for (int i = 0; i < 4; ++i) v[j][i] = ALPHA * (float)hh[i] + ((float)y0[i] + (float)y1[i]);
        s += (v[j].x + v[j].y) + (v[j].z + v[j].w); }
    const float mean = wave_sum(s) * (1.f / DM); float s2 = 0.f;
#pragma unroll
    for (int j = 0; j < 4; ++j) { v[j] = v[j] - mean; s2 += (v[j].x * v[j].x + v[j].y * v[j].y) + (v[j].z * v[j].z + v[j].w * v[j].w); }
    const float rstd = 1.f / sqrtf(wave_sum(s2) * (1.f / DM) + LN_EPS);
#pragma unroll
    for (int j = 0; j < 4; ++j) { const int c = 256 * j + 4 * lane; *(f4_t*)(P.out + (size_t)row * DM + c) = v[j] * rstd * *(const f4_t*)(P.ln_f_g + c) + *(const f4_t*)(P.ln_f_b + c); }
}
__global__ void __launch_bounds__(512) k_final(Params P) { final_ln_row(P, blockIdx.x * 8 + (threadIdx.x >> 6), threadIdx.x & 63); }

extern "C" void kernel_launch(void* const* d_in, const int* in_sizes, int n_in, void* d_out, int out_size, void* d_ws, size_t ws_size, hipStream_t stream) {
    static int inited = 0;
    if (!inited) {
        inited = 1;
        if (n_in != 23 || in_sizes[0] != T * DM || out_size != T * DM || ws_size < WS_END) { fprintf(stderr, "kernel_launch: unexpected shapes (n_in %d, in0 %d, out %d, ws %zu)\n", n_in, n_in > 0 ? in_sizes[0] : -1, out_size, ws_size); inited = -1; }
        else (void)hipFuncSetAttribute((const void*)k_prep, hipFuncAttributeMaxDynamicSharedMemorySize, P0_LDS);
    }
    if (inited < 0) return;
    Params P{};
    P.x = (const float*)d_in[0]; P.mem = (const float*)d_in[1]; P.pos = (const int*)d_in[2]; P.w_in = (const float*)d_in[3]; P.b_forget = (const float*)d_in[4];
    P.sinks = (const float*)d_in[5]; P.w_mix_out = (const float*)d_in[6]; P.ln_mix_g = (const float*)d_in[7]; P.ln_mix_b = (const float*)d_in[8];
    P.w_xq = (const float*)d_in[9]; P.w_xkv = (const float*)d_in[10]; P.w_xout = (const float*)d_in[11]; P.ln_x_g = (const float*)d_in[12]; P.ln_x_b = (const float*)d_in[13];
    P.w_rg = (const float*)d_in[14]; P.b_rg = (const float*)d_in[15]; P.w_re = (const float*)d_in[16]; P.b_re = (const float*)d_in[17];
    P.w_gate = (const float*)d_in[18]; P.w_up = (const float*)d_in[19]; P.w_down = (const float*)d_in[20]; P.ln_f_g = (const float*)d_in[21]; P.ln_f_b = (const float*)d_in[22];
    P.out = (float*)d_out; P.ws = (unsigned char*)d_ws;
    unsigned char* ws = P.ws;
    (void)hipMemsetAsync(ws + WS_CTL, 0, CTL_BYTES, stream);
    half_t* XH = (half_t*)(ws + WS_XH); half_t* Z = (half_t*)(ws + WS_Z); half_t* O = (half_t*)(ws + WS_O); half_t* H1 = (half_t*)(ws + WS_H1); half_t* H2 = (half_t*)(ws + WS_H2);
    half_t* QX = (half_t*)(ws + WS_QX); half_t* PX = (half_t*)(ws + WS_PX); half_t* OX = (half_t*)(ws + WS_OX); half_t* KX = (half_t*)(ws + WS_KX); half_t* VXT = (half_t*)(ws + WS_VXT);
    half_t* MEMH = (half_t*)(ws + WS_MEMH); half_t* ACT = (half_t*)(ws + WS_ACT); half_t* Y = (half_t*)(ws + WS_Y); float* TMP = (float*)(ws + WS_TMP);
    half_t* WIN = (half_t*)(ws + WS_WIN); half_t* WMO = (half_t*)(ws + WS_WMO); half_t* WXQ = (half_t*)(ws + WS_WXQ); half_t* WXK = (half_t*)(ws + WS_WXK); half_t* WXV = (half_t*)(ws + WS_WXV);
    half_t* WXO = (half_t*)(ws + WS_WXO); half_t* WGU = (half_t*)(ws + WS_WGU); half_t* WD = (half_t*)(ws + WS_WD);
    const unsigned* CNT = (const unsigned*)(ws + WS_CTL) + CW_CNT; const int* LTOK = (const int*)(ws + WS_LTOK); const float* LW = (const float*)(ws + WS_LW);

    k_prep<<<256, 512, P0_LDS, stream>>>(P);
    k_scan<<<64, 512, 0, stream>>>(P);
    k_gemm_naive<<<dim3(ZW / 64, T / 64, 1), 256, 0, stream>>>(FZ{XH, WIN, Z, P.pos, 1024, 0});
    k_gemm_naive<<<dim3(1024 / 64, MROWS / 64, 1), 256, 0, stream>>>(FPlain{MEMH, WXK, KX, 1024, 1024, 1024, MROWS, 1.f, 1024});
    k_gemm_naive<<<dim3(MROWS / 64, 1024 / 64, 1), 256, 0, stream>>>(FPlain{WXV, MEMH, VXT, 1024, 1024, MROWS, 1024, 1.f, 1024});
    k_attn_naive<0><<<dim3(SEQ / 64, 64), 64, 0, stream>>>(P);
    k_attn_naive<1><<<dim3(SEQ / 64, 64), 64, 0, stream>>>(P);
    k_gemm_naive<<<dim3(1024 / 64, T / 64, 1), 256, 0, stream>>>(FTmp{O, WMO, TMP, 1024, 0});
    k_ln_naive<0><<<T / 8, 512, 0, stream>>>(P);
    k_gemm_naive<<<dim3(1024 / 64, T / 64, 1), 256, 0, stream>>>(FPlain{H1, WXQ, QX, 1024, 1024, 1024, T, C2_256, 1024});
    k_xs_naive<<<dim3(T / 16, 4), 256, 0, stream>>>(P);
    k_gemm_naive<<<dim3(256 / 64, SEQ / 64, 32), 256, 0, stream>>>(FPV{PX, VXT, OX, 256, 0});
    k_gemm_naive<<<dim3(1024 / 64, T / 64, 1), 256, 0, stream>>>(FTmp{OX, WXO, TMP, 1024, 0});
    k_ln_naive<1><<<T / 8, 512, 0, stream>>>(P);
    k_route<<<T / 128, 512, 0, stream>>>(P);
    k_gemm_naive<<<dim3(1024 / 64, T / 64, NEXP), 256, 0, stream>>>(FGU{H2, WGU, ACT, CNT, LTOK, 1024, 0});
    k_gemm_naive<<<dim3(1024 / 64, T / 64, NEXP), 256, 0, stream>>>(FDown{ACT, WD, Y, CNT, LTOK, LW, 512, 0});
    k_final<<<T / 8, 512, 0, stream>>>(P);
}
```

```cpp
#include <hip/hip_runtime.h>
#include <cstdio>
#include <cstdint>

typedef _Float16 half_t;
typedef _Float16 h2_t __attribute__((ext_vector_type(2)));
typedef _Float16 h4_t __attribute__((ext_vector_type(4)));
typedef _Float16 h8_t __attribute__((ext_vector_type(8)));
typedef float f2_t __attribute__((ext_vector_type(2)));
typedef float f4_t __attribute__((ext_vector_type(4)));
typedef unsigned u4_t __attribute__((ext_vector_type(4)));
#define LAS __attribute__((address_space(3)))

constexpr int DM = 1024, NB = 8, SEQ = 4096, T = NB * SEQ;
constexpr int NMEM = 256, MROWS = NB * NMEM;
constexpr int INW = 2312, ZW = 2304;
constexpr int NEXP = 32, DEXP = 512, LCAP = T;
constexpr float ALPHA = 1.189207115002721f;
constexpr float LOG2E = 1.4426950408889634f;
constexpr float C2_64 = 0.125f * LOG2E;
constexpr float C2_256 = 0.0625f * LOG2E;
constexpr float LN_EPS = 1e-5f;
constexpr int ZQF = 0, ZKF = 512, ZVF = 1024, ZQS = 1536, ZKS = 2048, ZVS = 2176;

constexpr size_t MiB = 1u << 20;
constexpr size_t WS_CTL = 0, CTL_BYTES = 1 * MiB;
constexpr size_t WS_WIN = 1 * MiB;
constexpr size_t WS_WMO = 6 * MiB;
constexpr size_t WS_WXQ = 8 * MiB, WS_WXK = 10 * MiB, WS_WXV = 12 * MiB, WS_WXO = 14 * MiB;
constexpr size_t WS_WR = 16 * MiB;
constexpr size_t WS_WGU = 17 * MiB;
constexpr size_t WS_WD = 81 * MiB;
constexpr size_t WS_LOGF = 113 * MiB;
constexpr size_t WS_CUM = 114 * MiB;
constexpr size_t WS_MEMH = 115 * MiB;
constexpr size_t WS_KX = 119 * MiB;
constexpr size_t WS_VXT = 123 * MiB;
constexpr size_t WS_LG = 127 * MiB;
constexpr size_t WS_LTOK = 151 * MiB;
constexpr size_t WS_LW = 155 * MiB;
constexpr size_t WS_XH = 160 * MiB;
constexpr size_t WS_H2 = WS_XH;
constexpr size_t WS_Z = 224 * MiB;
constexpr size_t WS_QX = 224 * MiB;
constexpr size_t WS_PX = 288 * MiB;
constexpr size_t WS_Y = 224 * MiB;
constexpr size_t WS_TMP = 224 * MiB;
constexpr size_t WS_O = 368 * MiB;
constexpr size_t WS_OX = 368 * MiB;
constexpr size_t WS_ACT = 368 * MiB;
constexpr size_t WS_H1 = 432 * MiB;
constexpr size_t WS_END = 500 * MiB;
constexpr int CW_CNT = 64;

struct Params {
    const float* x; const float* mem; const int* pos; const float* w_in; const float* b_forget; const float* sinks; const float* w_mix_out;
    const float* ln_mix_g; const float* ln_mix_b; const float* w_xq; const float* w_xkv; const float* w_xout; const float* ln_x_g; const float* ln_x_b;
    const float* w_rg; const float* b_rg; const float* w_re; const float* b_re; const float* w_gate; const float* w_up; const float* w_down;
    const float* ln_f_g; const float* ln_f_b;
    float* out; unsigned char* ws;
};

__device__ __forceinline__ float wave_sum(float v) {
#pragma unroll
    for (int o = 1; o < 64; o <<= 1) v += __shfl_xor(v, o);
    return v;
}
__device__ __forceinline__ unsigned pkh(float lo, float hi) { f2_t v = {lo, hi}; h2_t h = __builtin_convertvector(v, h2_t); return __builtin_bit_cast(unsigned, h); }
__device__ __forceinline__ float inv_freq(int i) { return exp2f(-(float)i * (13.287712379549449f / 32.0f)); }
__device__ __forceinline__ void rope_cs(int pos, int i, float& c, float& s) {
    const float ang = (float)pos * inv_freq(i);
    const float rev = ang * 0.15915494309189535f; const float fr = rev - floorf(rev);
    s = __builtin_amdgcn_sinf(fr); c = __builtin_amdgcn_cosf(fr);
}

__device__ __forceinline__ int win_dest(int c) {
    if (c < 1536) return c;
    if (c < 1544) return -1;
    if (c < 2056) { const int cc = c - 1544, hd = cc >> 6, d = cc & 63; return ZQS + hd * 64 + ((d < 32) ? 2 * d : 2 * (d - 32) + 1); }
    if (c < 2184) { const int cc = c - 2056, hd = cc >> 6, d = cc & 63; return ZKS + hd * 64 + ((d < 32) ? 2 * d : 2 * (d - 32) + 1); }
    if (c < 2312) return ZVS + (c - 2184);
    return -1;
}
template <class DestFn>
__device__ __forceinline__ void tr_item(const float* W, int ldw, int N, half_t* WT, int ldt, LAS float* scr, int k0, int n0, int lane, DestFn dest) {
#pragma unroll 8
    for (int i = 0; i < 32; ++i) { const int kk = 2 * i + (lane >> 5), n = n0 + (lane & 31); scr[kk * 33 + (lane & 31)] = (n < N) ? W[(size_t)(k0 + kk) * ldw + n] : 0.f; }
    asm volatile("s_waitcnt lgkmcnt(0)" ::: "memory");
    const int c = lane & 7;
#pragma unroll
    for (int j = 0; j < 4; ++j) { const int nl = (lane >> 3) + 8 * j; const LAS float* s = scr + (8 * c) * 33 + nl;
        u4_t o; o.x = pkh(s[0 * 33], s[1 * 33]); o.y = pkh(s[2 * 33], s[3 * 33]); o.z = pkh(s[4 * 33], s[5 * 33]); o.w = pkh(s[6 * 33], s[7 * 33]);
        const int dr = (n0 + nl < N) ? dest(n0 + nl) : -1;
        if (dr >= 0) *(u4_t*)(WT + (size_t)dr * ldt + k0 + 8 * c) = o; }
    asm volatile("s_waitcnt lgkmcnt(0)" ::: "memory");
}
constexpr int P0_LDS = 32768 + 8 * 8448;
__device__ __forceinline__ void phase_prep(const Params& P, LAS unsigned char* lds, int wg, int nwg) {
    const int tid = threadIdx.x, lane = tid & 63, wave = tid >> 6;
    const int gw = wg * 8 + wave, ngw = nwg * 8;
    LAS float* wfT = (LAS float*)lds;
    LAS float* scr = (LAS float*)(lds + 32768 + wave * 8448);
    for (int i = tid; i < 8192; i += 512) { const int h = i >> 10, k = i & 1023; wfT[i] = P.w_in[(size_t)k * INW + 1536 + h]; }
    __syncthreads();
    half_t* XH = (half_t*)(P.ws + WS_XH); float* LOGF = (float*)(P.ws + WS_LOGF);
    for (int row = gw; row < T; row += ngw) {
        const f4_t* xr = (const f4_t*)(P.x + (size_t)row * DM) + lane;
        f4_t v[4];
#pragma unroll
        for (int j = 0; j < 4; ++j) v[j] = xr[64 * j];
#pragma unroll
        for (int j = 0; j < 4; ++j) { unsigned long long w = (unsigned long long)pkh(v[j].x, v[j].y) | ((unsigned long long)pkh(v[j].z, v[j].w) << 32);
            *(unsigned long long*)(XH + (size_t)row * DM + 256 * j + 4 * lane) = w; }
        float s[8];
#pragma unroll
        for (int h = 0; h < 8; ++h) { float a = 0.f;
#pragma unroll
            for (int j = 0; j < 4; ++j) { const f4_t w = *(const LAS f4_t*)(wfT + h * 1024 + 256 * j + 4 * lane); a += v[j].x * w.x + v[j].y * w.y + v[j].z * w.z + v[j].w * w.w; }
            s[h] = wave_sum(a); }
        float r = s[0];
#pragma unroll
        for (int h = 1; h < 8; ++h) r = (lane == h) ? s[h] : r;
        if (lane < 8) { const float z = r + P.b_forget[lane]; const float ls = (z >= 0.f) ? -log1pf(expf(-z)) : (z - log1pf(expf(z))); LOGF[(size_t)row * 8 + lane] = ls; }
    }
    half_t* MEMH = (half_t*)(P.ws + WS_MEMH);
    for (int row = gw; row < MROWS; row += ngw) {
        const f4_t* xr = (const f4_t*)(P.mem + (size_t)row * DM) + lane;
#pragma unroll
        for (int j = 0; j < 4; ++j) { const f4_t v = xr[64 * j]; unsigned long long w = (unsigned long long)pkh(v.x, v.y) | ((unsigned long long)pkh(v.z, v.w) << 32);
            *(unsigned long long*)(MEMH + (size_t)row * DM + 256 * j + 4 * lane) = w; }
    }
    { half_t* WRH = (half_t*)(P.ws + WS_WR); half_t* WRL = WRH + 48 * 1024;
      for (int i = wg * 512 + tid; i < 48 * 1024; i += nwg * 512) { const int r = i >> 10, k = i & 1023; float v = 0.f;
          if (r < 4) v = P.w_rg[k * 4 + r]; else if (r < 36) { const int g = (r - 4) >> 3, e = (r - 4) & 7; v = P.w_re[((size_t)g * 1024 + k) * 8 + e]; }
          v *= 32.f; const half_t hi = (half_t)v; const half_t lo = (half_t)(v - (float)hi); WRH[i] = hi; WRL[i] = lo; } }
    constexpr int I_IN = 16 * 73, I_DD = 16 * 32, I_KV = 16 * 64, I_G = 16 * 16, I_D = 8 * 32;
    constexpr int NIT = I_IN + 3 * I_DD + I_KV + NEXP * (2 * I_G + I_D);
    half_t* WIN = (half_t*)(P.ws + WS_WIN); half_t* WMO = (half_t*)(P.ws + WS_WMO); half_t* WXQ = (half_t*)(P.ws + WS_WXQ); half_t* WXK = (half_t*)(P.ws + WS_WXK);
    half_t* WXO = (half_t*)(P.ws + WS_WXO); half_t* WGU = (half_t*)(P.ws + WS_WGU); half_t* WD = (half_t*)(P.ws + WS_WD);
    for (int it = gw; it < NIT; it += ngw) {
        int r = it;
        if (r < I_IN) { tr_item(P.w_in, INW, INW, WIN, 1024, scr, 64 * (r / 73), 32 * (r % 73), lane, [](int c) { return win_dest(c); }); continue; } r -= I_IN;
        if (r < I_DD) { tr_item(P.w_mix_out, 1024, 1024, WMO, 1024, scr, 64 * (r / 32), 32 * (r % 32), lane, [](int c) { return c; }); continue; } r -= I_DD;
        if (r < I_DD) { tr_item(P.w_xq, 1024, 1024, WXQ, 1024, scr, 64 * (r / 32), 32 * (r % 32), lane, [](int c) { return c; }); continue; } r -= I_DD;
        if (r < I_DD) { tr_item(P.w_xout, 1024, 1024, WXO, 1024, scr, 64 * (r / 32), 32 * (r % 32), lane, [](int c) { return c; }); continue; } r -= I_DD;
        if (r < I_KV) { tr_item(P.w_xkv, 2048, 2048, WXK, 1024, scr, 64 * (r / 64), 32 * (r % 64), lane, [](int c) { return c; }); continue; } r -= I_KV;
        const int e = r / (2 * I_G + I_D); r -= e * (2 * I_G + I_D);
        if (r < I_G) { tr_item(P.w_gate + (size_t)e * 1024 * 512, 512, 512, WGU + (size_t)e * 1024 * 1024, 1024, scr, 64 * (r / 16), 32 * (r % 16), lane, [](int c) { return 2 * c; }); continue; } r -= I_G;
        if (r < I_G) { tr_item(P.w_up + (size_t)e * 1024 * 512, 512, 512, WGU + (size_t)e * 1024 * 1024, 1024, scr, 64 * (r / 16), 32 * (r % 16), lane, [](int c) { return 2 * c + 1; }); continue; } r -= I_G;
        tr_item(P.w_down + (size_t)e * 512 * 1024, 1024, 1024, WD + (size_t)e * 1024 * 512, 512, scr, 64 * (r / 32), 32 * (r % 32), lane, [](int c) { return c; });
    }
}

__device__ __forceinline__ void scan_bh(const Params& P, LAS float* sh, int bh) {
    const int tid = threadIdx.x, lane = tid & 63, wave = tid >> 6, b = bh >> 3, h = bh & 7;
    const float* LOGF = (const float*)(P.ws + WS_LOGF); float* CUM = (float*)(P.ws + WS_CUM);
    float v[8]; float run = 0.f;
#pragma unroll
    for (int i = 0; i < 8; ++i) { run += LOGF[((size_t)b * SEQ + tid * 8 + i) * 8 + h]; v[i] = run; }
    float inc = run;
#pragma unroll
    for (int o = 1; o < 64; o <<= 1) { const float t = __shfl_up(inc, o); if (lane >= o) inc += t; }
    if (lane == 63) sh[wave] = inc;
    __syncthreads();
    float base = inc - run;
    for (int w = 0; w < wave; ++w) base += sh[w];
#pragma unroll
    for (int i = 0; i < 8; ++i) CUM[(size_t)bh * SEQ + tid * 8 + i] = base + v[i];
    __syncthreads();
}

template <class F>
__device__ __forceinline__ void gemm_naive_phase(const F& f, LAS unsigned char* lds, int wg, int nwg, int nz, int Mmax, int N) {
    LAS float* As = (LAS float*)lds;
    LAS float* Bs = As + 16 * 68;
    const int K = f.K, tid = threadIdx.x;
    const int ntm = Mmax / 64, ntn = N / 128, per = ntm * ntn, total = nz * per;
    const int lr = tid >> 2, lk = (tid & 3) * 4, ty = tid >> 5, tx = tid & 31;
    for (int it = wg; it < total; it += nwg) {
        const int z = it / per, r = it % per, m0 = (r / ntn) * 64, n0 = (r % ntn) * 128;
        if (m0 >= f.mrows(z)) continue;
        const half_t* ap = f.arow(z, m0 + (lr & 63)) + lk; const half_t* bp = f.brow(z, n0 + lr) + lk;
        float acc[4][4];
#pragma unroll
        for (int i = 0; i < 4; ++i)
#pragma unroll
            for (int j = 0; j < 4; ++j) acc[i][j] = 0.f;
        for (int k0 = 0; k0 < K; k0 += 16) {
            const h4_t av = *(const h4_t*)(ap + k0), bv = *(const h4_t*)(bp + k0);
            __syncthreads();
#pragma unroll
            for (int i = 0; i < 4; ++i) { if (tid < 256) As[(lk + i) * 68 + lr] = (float)av[i]; Bs[(lk + i) * 132 + lr] = (float)bv[i]; }
            __syncthreads();
#pragma unroll
            for (int k = 0; k < 16; ++k) { const f4_t a = *(const LAS f4_t*)&As[k * 68 + ty * 4], b = *(const LAS f4_t*)&Bs[k * 132 + tx * 4];
#pragma unroll
                for (int i = 0; i < 4; ++i)
#pragma unroll
                    for (int j = 0; j < 4; ++j) acc[i][j] += a[i] * b[j]; }
        }
#pragma unroll
        for (int i = 0; i < 4; ++i) f.epi(z, m0 + ty * 4 + i, n0 + tx * 4, acc[i]);
    }
    __syncthreads();
}

struct FZ {
    const half_t* XH; const half_t* WIN; half_t* Z; const int* pos; int K, pad;
    __device__ int mrows(int) const { return T; }
    __device__ const half_t* arow(int, int m) const { return XH + (size_t)m * DM; }
    __device__ const half_t* brow(int, int n) const { return WIN + (size_t)n * DM; }
    __device__ void epi(int, int m, int n0, float* v) const {
        float o[4] = {v[0], v[1], v[2], v[3]};
        if (n0 >= ZQS && n0 < ZVS) { const int p = pos[m]; const int i0 = (n0 & 63) >> 1; float c, s;
            rope_cs(p, i0, c, s); o[0] = v[0] * c - v[1] * s; o[1] = v[1] * c + v[0] * s;
            rope_cs(p, i0 + 1, c, s); o[2] = v[2] * c - v[3] * s; o[3] = v[3] * c + v[2] * s; }
        if (n0 < ZKF || (n0 >= ZQS && n0 < ZKS)) { o[0] *= C2_64; o[1] *= C2_64; o[2] *= C2_64; o[3] *= C2_64; }
        unsigned long long w = (unsigned long long)pkh(o[0], o[1]) | ((unsigned long long)pkh(o[2], o[3]) << 32);
        *(unsigned long long*)(Z + (size_t)m * ZW + n0) = w;
    }
};
struct FPlain {
    const half_t* A; const half_t* B; half_t* C; int lda, ldb, ldc, M; float scale; int K;
    __device__ int mrows(int) const { return M; }
    __device__ const half_t* arow(int, int m) const { return A + (size_t)m * lda; }
    __device__ const half_t* brow(int, int n) const { return B + (size_t)n * ldb; }
    __device__ void epi(int, int m, int n0, float* v) const {
        unsigned long long w = (unsigned long long)pkh(v[0] * scale, v[1] * scale) | ((unsigned long long)pkh(v[2] * scale, v[3] * scale) << 32);
        *(unsigned long long*)(C + (size_t)m * ldc + n0) = w;
    }
};
struct FTmp {
    const half_t* A; const half_t* B; float* C; int K, pad;
    __device__ int mrows(int) const { return T; }
    __device__ const half_t* arow(int, int m) const { return A + (size_t)m * DM; }
    __device__ const half_t* brow(int, int n) const { return B + (size_t)n * DM; }
    __device__ void epi(int, int m, int n0, float* v) const { *(f4_t*)(C + (size_t)m * DM + n0) = (f4_t){v[0], v[1], v[2], v[3]}; }
};
struct FPV {
    const half_t* PX; const half_t* VXT; half_t* OX; int K, pad;
    __device__ int mrows(int) const { return SEQ; }
    __device__ const half_t* arow(int z, int m) const { return PX + ((size_t)(z >> 2) * SEQ + m) * DM + (z & 3) * 256; }
    __device__ const half_t* brow(int z, int n) const { return VXT + ((size_t)(z & 3) * 256 + n) * MROWS + (z >> 2) * 256; }
    __device__ void epi(int z, int m, int n0, float* v) const {
        unsigned long long w = (unsigned long long)pkh(v[0], v[1]) | ((unsigned long long)pkh(v[2], v[3]) << 32);
        *(unsigned long long*)(OX + ((size_t)(z >> 2) * SEQ + m) * DM + (z & 3) * 256 + n0) = w;
    }
};
__device__ __forceinline__ int pbase_of(const unsigned* cnt, int e) { int b = 0; for (int i = 0; i < e; ++i) b += ((int)cnt[i] + 255) & ~255; return b; }
struct FGU {
    const half_t* H2; const half_t* WGU; half_t* ACT; const unsigned* cnt; const int* ltok; int K, pad;
    __device__ int mrows(int z) const { return (int)cnt[z]; }
    __device__ const half_t* arow(int z, int m) const { const int c = (int)cnt[z]; const int tk = (m < c) ? (ltok[(size_t)z * LCAP + m] >> 1) : 0; return H2 + (size_t)tk * DM; }
    __device__ const half_t* brow(int z, int n) const { return WGU + ((size_t)z * 1024 + n) * 1024; }
    __device__ void epi(int z, int m, int n0, float* v) const {
        const float a0 = v[0] / (1.f + expf(-v[0])) * v[1], a1 = v[2] / (1.f + expf(-v[2])) * v[3];
        *(unsigned*)(ACT + ((size_t)pbase_of(cnt, z) + m) * DEXP + (n0 >> 1)) = pkh(a0, a1);
    }
};
struct FDown {
    const half_t* ACT; const half_t* WD; half_t* Y; const unsigned* cnt; const int* ltok; const float* lw; int K, pad;
    __device__ int mrows(int z) const { return (int)cnt[z]; }
    __device__ const half_t* arow(int z, int m) const { return ACT + ((size_t)pbase_of(cnt, z) + m) * DEXP; }
    __device__ const half_t* brow(int z, int n) const { return WD + ((size_t)z * 1024 + n) * DEXP; }
    __device__ void epi(int z, int m, int n0, float* v) const {
        if (m >= (int)cnt[z]) return;
        const int t2 = ltok[(size_t)z * LCAP + m]; const float g = lw[(size_t)z * LCAP + m];
        unsigned long long w = (unsigned long long)pkh(v[0] * g, v[1] * g) | ((unsigned long long)pkh(v[2] * g, v[3] * g) << 32);
        *(unsigned long long*)(Y + (size_t)t2 * DM + n0) = w;
    }
};

template <int MODE>
__device__ __forceinline__ void attn_naive_item(const Params& P, int tblk, int bh, int lane) {
    const half_t* Z = (const half_t*)(P.ws + WS_Z); half_t* O = (half_t*)(P.ws + WS_O); const float* CUM = (const float*)(P.ws + WS_CUM);
    const int t0 = tblk * 64, t = t0 + lane, b = bh >> 3, h = bh & 7;
    const int qcol = (MODE == 0) ? ZQF + h * 64 : ZQS + h * 64;
    const int kcol = (MODE == 0) ? ZKF + h * 64 : ZKS + (h >> 2) * 64;
    const int vcol = (MODE == 0) ? ZVF + h * 64 : ZVS + (h >> 2) * 64;
    float q[64], o[64];
    { const half_t* qp = Z + ((size_t)b * SEQ + t) * ZW + qcol;
#pragma unroll
      for (int d = 0; d < 64; ++d) { q[d] = (float)qp[d]; o[d] = 0.f; } }
    float m = -INFINITY, l = 0.f;
    const float ct = (MODE == 0) ? CUM[(size_t)bh * SEQ + t] * LOG2E : 0.f;
    const int s_lo = (MODE == 0) ? 0 : ((t0 - 127 > 0) ? t0 - 127 : 0), s_hi = t0 + 63;
    for (int s = s_lo; s <= s_hi; ++s) {
        const half_t* kp = Z + ((size_t)b * SEQ + s) * ZW + kcol; const half_t* vp = Z + ((size_t)b * SEQ + s) * ZW + vcol;
        float sc = 0.f;
#pragma unroll
        for (int d8 = 0; d8 < 8; ++d8) { const h8_t kv = *(const h8_t*)(kp + d8 * 8);
#pragma unroll
            for (int j = 0; j < 8; ++j) sc += q[d8 * 8 + j] * (float)kv[j]; }
        bool ok = (s <= t);
        if (MODE == 0) sc += ct - CUM[(size_t)bh * SEQ + s] * LOG2E; else ok = ok && (t - s < 128);
        if (ok) {
            const float mn = fmaxf(m, sc), f = exp2f(m - mn), p = exp2f(sc - mn);
            l = l * f + p; m = mn;
#pragma unroll
            for (int d8 = 0; d8 < 8; ++d8) { const h8_t vv = *(const h8_t*)(vp + d8 * 8);
#pragma unroll
                for (int j = 0; j < 8; ++j) o[d8 * 8 + j] = o[d8 * 8 + j] * f + p * (float)vv[j]; }
        }
    }
    if (MODE == 1) l += exp2f(P.sinks[h] * LOG2E - m);
    const float rl = 1.f / l;
    half_t* op = O + ((size_t)b * SEQ + t) * DM + ((MODE == 0) ? 0 : 512) + h * 64;
#pragma unroll
    for (int d = 0; d < 64; d += 2) *(unsigned*)(op + d) = pkh(o[d] * rl, o[d + 1] * rl);
}

__device__ __forceinline__ void xs_naive_item(const Params& P, LAS unsigned char* lds, int item) {
    const half_t* QX = (const half_t*)(P.ws + WS_QX); const half_t* KX = (const half_t*)(P.ws + WS_KX); half_t* PX = (half_t*)(P.ws + WS_PX);
    LAS float (*S)[257] = (LAS float (*)[257])lds;
    const int tid = threadIdx.x, r = tid >> 4, c = tid & 15, t = (item >> 2) * 32 + r, h = item & 3, b = t / SEQ;
    const half_t* qp = QX + (size_t)t * DM + h * 256;
    float acc[16];
#pragma unroll
    for (int j = 0; j < 16; ++j) acc[j] = 0.f;
    for (int d0 = 0; d0 < 256; d0 += 8) { const h8_t qv = *(const h8_t*)(qp + d0);
#pragma unroll
        for (int j = 0; j < 16; ++j) { const h8_t kv = *(const h8_t*)(KX + ((size_t)b * 256 + c + 16 * j) * DM + h * 256 + d0);
#pragma unroll
            for (int i = 0; i < 8; ++i) acc[j] += (float)qv[i] * (float)kv[i]; } }
#pragma unroll
    for (int j = 0; j < 16; ++j) S[r][c + 16 * j] = acc[j];
    __syncthreads();
    float mx = -INFINITY;
    for (int j = 0; j < 16; ++j) mx = fmaxf(mx, S[r][c + 16 * j]);
#pragma unroll
    for (int o = 1; o < 16; o <<= 1) mx = fmaxf(mx, __shfl_xor(mx, o));
    float sum = 0.f;
    for (int j = 0; j < 16; ++j) { const float p = exp2f(S[r][c + 16 * j] - mx); S[r][c + 16 * j] = p; sum += p; }
#pragma unroll
    for (int o = 1; o < 16; o <<= 1) sum += __shfl_xor(sum, o);
    const float rs = 1.f / sum;
    for (int j = 0; j < 16; ++j) PX[(size_t)t * DM + h * 256 + c + 16 * j] = (half_t)(S[r][c + 16 * j] * rs);
    __syncthreads();
}

template <int MODE>
__device__ __forceinline__ void ln_naive_row(const Params& P, int row, int lane) {
    const float* TMP = (const float*)(P.ws + WS_TMP);
    const half_t* H1 = (const half_t*)(P.ws + WS_H1);
    f4_t v[4]; float s = 0.f;
#pragma unroll
    for (int j = 0; j < 4; ++j) { const int c = 256 * j + 4 * lane; f4_t r;
        if (MODE == 0) r = *(const f4_t*)(P.x + (size_t)row * DM + c); else { const h4_t hh = *(const h4_t*)(H1 + (size_t)row * DM + c); r = (f4_t){(float)hh[0], (float)hh[1], (float)hh[2], (float)hh[3]}; }
        v[j] = r * ALPHA + *(const f4_t*)(TMP + (size_t)row * DM + c); s += (v[j].x + v[j].y) + (v[j].z + v[j].w); }
    const float mean = wave_sum(s) * (1.f / DM); float s2 = 0.f;
#pragma unroll
    for (int j = 0; j < 4; ++j) { v[j] = v[j] - mean; s2 += (v[j].x * v[j].x + v[j].y * v[j].y) + (v[j].z * v[j].z + v[j].w * v[j].w); }
    const float rstd = 1.f / sqrtf(wave_sum(s2) * (1.f / DM) + LN_EPS);
    const float* G = (MODE == 0) ? P.ln_mix_g : P.ln_x_g; const float* B = (MODE == 0) ? P.ln_mix_b : P.ln_x_b;
    half_t* OUT = (half_t*)(P.ws + ((MODE == 0) ? WS_H1 : WS_H2));
#pragma unroll
    for (int j = 0; j < 4; ++j) { const int c = 256 * j + 4 * lane; v[j] = v[j] * rstd * *(const f4_t*)(G + c) + *(const f4_t*)(B + c);
        unsigned long long w = (unsigned long long)pkh(v[j].x, v[j].y) | ((unsigned long long)pkh(v[j].z, v[j].w) << 32);
        *(unsigned long long*)(OUT + (size_t)row * DM + c) = w; }
    if (MODE == 1) {
        float* LG = (float*)(P.ws + WS_LG);
        for (int r = 0; r < 36; ++r) { float a = 0.f;
#pragma unroll
            for (int j = 0; j < 4; ++j) { const int c = 256 * j + 4 * lane;
#pragma unroll
                for (int i = 0; i < 4; ++i) { const int k = c + i; const float w = (r < 4) ? P.w_rg[k * 4 + r] : P.w_re[((size_t)((r - 4) >> 3) * 1024 + k) * 8 + ((r - 4) & 7)]; a += v[j][i] * w; } }
            a = wave_sum(a);
            if (lane == 0) { LG[(size_t)row * 48 + r] = a * 32.f; LG[((size_t)T + row) * 48 + r] = 0.f; LG[((size_t)2 * T + row) * 48 + r] = 0.f; LG[((size_t)3 * T + row) * 48 + r] = 0.f; } }
    }
}

__device__ __forceinline__ void route_tokens(const Params& P, LAS unsigned* sh  , int t0) {
    const int tid = threadIdx.x;
    const float* LG = (const float*)(P.ws + WS_LG); unsigned* CNT = (unsigned*)(P.ws + WS_CTL) + CW_CNT;
    int* LTOK = (int*)(P.ws + WS_LTOK); float* LW = (float*)(P.ws + WS_LW);
    if (tid < 64) sh[tid] = 0u;
    __syncthreads();
    int e0 = 0, e1 = 0; float g0 = 0.f, g1 = 0.f; unsigned s0 = 0, s1 = 0;
    if (tid < 128) {
        const int t = t0 + tid;
        float lg[36];
#pragma unroll
        for (int r = 0; r < 36; ++r) lg[r] = (LG[(size_t)t * 48 + r] + LG[((size_t)T + t) * 48 + r] + LG[((size_t)2 * T + t) * 48 + r] + LG[((size_t)3 * T + t) * 48 + r]) * (1.f / 32.f);
        float pg[4]; float mx = -INFINITY;
#pragma unroll
        for (int g = 0; g < 4; ++g) { pg[g] = lg[g] + P.b_rg[g]; mx = fmaxf(mx, pg[g]); }
        float sum = 0.f;
#pragma unroll
        for (int g = 0; g < 4; ++g) { pg[g] = expf(pg[g] - mx); sum += pg[g]; }
        int gi = 0; float gv = pg[0];
#pragma unroll
        for (int g = 1; g < 4; ++g) if (pg[g] > gv) { gv = pg[g]; gi = g; }
        gv /= sum;
        float sel[8];
#pragma unroll
        for (int e = 0; e < 8; ++e) { float a = lg[4 + e];
#pragma unroll
            for (int g = 1; g < 4; ++g) a = (gi == g) ? lg[4 + 8 * g + e] : a;
            sel[e] = a + P.b_re[gi * 8 + e]; }
        int i0 = 0; float v0 = sel[0];
#pragma unroll
        for (int e = 1; e < 8; ++e) if (sel[e] > v0) { v0 = sel[e]; i0 = e; }
        int i1 = -1; float v1 = -INFINITY;
#pragma unroll
        for (int e = 0; e < 8; ++e) if (e != i0 && sel[e] > v1) { v1 = sel[e]; i1 = e; }
        const float p1 = expf(v1 - v0), den = 1.f + p1;
        g0 = gv / den; g1 = gv * p1 / den; e0 = gi * 8 + i0; e1 = gi * 8 + i1;
        s0 = atomicAdd((unsigned*)&sh[e0], 1u); s1 = atomicAdd((unsigned*)&sh[e1], 1u);
    }
    __syncthreads();
    if (tid < 32) { const unsigned c = sh[tid]; sh[32 + tid] = c ? atomicAdd(&CNT[tid], c) : 0u; }
    __syncthreads();
    if (tid < 128) {
        const int t = t0 + tid; const unsigned d0 = sh[32 + e0] + s0, d1 = sh[32 + e1] + s1;
        LTOK[(size_t)e0 * LCAP + d0] = 2 * t; LW[(size_t)e0 * LCAP + d0] = g0;
        LTOK[(size_t)e1 * LCAP + d1] = 2 * t + 1; LW[(size_t)e1 * LCAP + d1] = g1;
    }
    __syncthreads();
}

__device__ __forceinline__ void final_ln_row(const Params& P, int row, int lane) {
    const half_t* H2 = (const half_t*)(P.ws + WS_H2); const half_t* Y = (const half_t*)(P.ws + WS_Y);
    f4_t v[4]; float s = 0.f;
#pragma unroll
    for (int j = 0; j < 4; ++j) { const int c = 256 * j + 4 * lane;
        const h4_t hh = *(const h4_t*)(H2 + (size_t)row * DM + c), y0 = *(const h4_t*)(Y + (size_t)(2 * row) * DM + c), y1 = *(const h4_t*)(Y + (size_t)(2 * row + 1) * DM + c);
#pragma unroll
        for (int i = 0; i < 4; ++i) v[j][i] = ALPHA * (float)hh[i] + ((float)y0[i] + (float)y1[i]);
        s += (v[j].x + v[j].y) + (v[j].z + v[j].w); }
    const float mean = wave_sum(s) * (1.f / DM); float s2 = 0.f;
#pragma unroll
    for (int j = 0; j < 4; ++j) { v[j] = v[j] - mean; s2 += (v[j].x * v[j].x + v[j].y * v[j].y) + (v[j].z * v[j].z + v[j].w * v[j].w); }
    const float rstd = 1.f / sqrtf(wave_sum(s2) * (1.f / DM) + LN_EPS);
#pragma unroll
    for (int j = 0; j < 4; ++j) { const int c = 256 * j + 4 * lane; *(f4_t*)(P.out + (size_t)row * DM + c) = v[j] * rstd * *(const f4_t*)(P.ln_f_g + c) + *(const f4_t*)(P.ln_f_b + c); }
}

#define GAS __attribute__((address_space(1)))
typedef GAS unsigned gu32;
#define RLX_AGENT __ATOMIC_RELAXED, __HIP_MEMORY_SCOPE_AGENT
constexpr int CW_TMO = 0, CW_CODE = 1;
constexpr int CW_BAR = 4096;
constexpr int LDS_BYTES = 147456;
constexpr int MISC_OFF = 131072 + 320;

#define XB_TMO      128
#define XB_XCNT(j)  (256  + 64 * (j))
#define XB_XSUB(j)  (1280 + 64 * (j))
#define XB_XGEN(j)  (2304 + 64 * (j))
#define XB_TOP      3328
#define XB_TOPGEN   3392
#define XCD_BAR_WORDS 3456
#define XB_SPIN_CAP (1u << 22)
__device__ __forceinline__ unsigned xb_ld(unsigned* p)              { return __hip_atomic_load(p, __ATOMIC_RELAXED, __HIP_MEMORY_SCOPE_AGENT); }
__device__ __forceinline__ unsigned xb_add(unsigned* p, unsigned v) { return __hip_atomic_fetch_add(p, v, __ATOMIC_RELAXED, __HIP_MEMORY_SCOPE_AGENT); }
__device__ __forceinline__ unsigned xb_xcc_id() { return (unsigned)__builtin_amdgcn_s_getreg((3 << 11) | 20) & 0xFu; }
#define XB_SPIN(cond, bar) do { unsigned _sp = 0; while (cond) { __builtin_amdgcn_s_sleep(1); \
    if ((++_sp & 255u) == 0u) { if (xb_ld(&(bar)[XB_TMO])) break; if (_sp > XB_SPIN_CAP) { atomicAdd(&(bar)[XB_TMO], 1u); break; } } } } while (0)
struct XcdBarrier { unsigned* bar; unsigned x; volatile LAS unsigned* st; };
__device__ __forceinline__ XcdBarrier xcd_barrier_post(unsigned* bar, volatile LAS unsigned* st) {
    XcdBarrier b; b.bar = bar; b.x = xb_xcc_id(); b.st = st;
    if (threadIdx.x == 0) (void)xb_add(&bar[XB_XCNT(b.x)], 1u);
    return b;
}
__device__ __forceinline__ void xcd_barrier_complete(unsigned* bar, unsigned x, unsigned& nloc, unsigned& nx) {
    const unsigned G = gridDim.x * gridDim.y * gridDim.z;
    unsigned sum, cnt, mine, sp = 0u;
    for (;;) {
        sum = 0u; cnt = 0u; mine = 0u;
#pragma unroll
        for (unsigned j = 0; j < 16; ++j) { const unsigned c = xb_ld(&bar[XB_XCNT(j)]); sum += c; cnt += (c > 0u) ? 1u : 0u; mine = (j == x) ? c : mine; }
        if (sum == G) break;
        __builtin_amdgcn_s_sleep(1);
        if ((++sp & 255u) == 0u) { if (xb_ld(&bar[XB_TMO])) break; if (sp > XB_SPIN_CAP) { atomicAdd(&bar[XB_TMO], 1u); break; } }
    }
    nloc = mine > 0u ? mine : 1u; nx = cnt > 0u ? cnt : 1u;
}
__device__ __forceinline__ void xcd_barrier(const XcdBarrier& b) {
    asm volatile("s_waitcnt vmcnt(0)" ::: "memory");
    __syncthreads();
    if (threadIdx.x == 0) {
        unsigned* bar = b.bar;
        __builtin_amdgcn_s_waitcnt(0);
        unsigned nloc = b.st[0], nx = b.st[1];
        if (nloc == 0u) { xcd_barrier_complete(bar, b.x, nloc, nx); b.st[0] = nloc; b.st[1] = nx; }
        const unsigned old = xb_add(&bar[XB_XSUB(b.x)], 1u);
        const unsigned gen = old / nloc;
        if (old + 1u == (gen + 1u) * nloc) {
            __builtin_amdgcn_fence(__ATOMIC_RELEASE, "agent");
            asm volatile("s_waitcnt vmcnt(0)" ::: "memory");
            const unsigned og = xb_add(&bar[XB_TOP], 1u);
            const unsigned tg = og / nx;
            if (og + 1u == (tg + 1u) * nx) xb_add(&bar[XB_TOPGEN], 1u);
            else XB_SPIN(xb_ld(&bar[XB_TOPGEN]) == tg, bar);
            __builtin_amdgcn_fence(__ATOMIC_ACQUIRE, "agent");
            xb_add(&bar[XB_XGEN(b.x)], 1u);
            asm volatile("s_waitcnt vmcnt(0)" ::: "memory");
        } else {
            XB_SPIN(xb_ld(&bar[XB_XGEN(b.x)]) == gen, bar);
            __builtin_amdgcn_fence(__ATOMIC_ACQUIRE, "agent");
            asm volatile("s_waitcnt vmcnt(0)" ::: "memory");
        }
    }
    __syncthreads();
}

constexpr int NPHASE = 14;
struct Args { Params P; int ph_lo, ph_hi; };
static_assert(sizeof(Args) == sizeof(Params) + 8 && sizeof(Params) == 25 * 8, "Args has no padding");

__global__ void __launch_bounds__(512, 2) mega(Args a) {
    extern __shared__ __attribute__((aligned(16))) unsigned char lds_raw[];
    LAS unsigned char* lds = (LAS unsigned char*)lds_raw;
    const Params& P = a.P;
    const int tid = threadIdx.x, lane = tid & 63, wave = __builtin_amdgcn_readfirstlane(tid >> 6);
    const int G = gridDim.x, wg = blockIdx.x, gw = wg * 8 + wave, ngw = G * 8;
    unsigned char* ws = P.ws;
    volatile LAS unsigned* MISC = (volatile LAS unsigned*)(lds + MISC_OFF);
    for (int u = tid; u < (LDS_BYTES - 131072) / 4; u += 512) ((LAS unsigned*)(lds + 131072))[u] = 0u;
    __syncthreads();
    unsigned* ctl = (unsigned*)(ws + WS_CTL);
    XcdBarrier bar = xcd_barrier_post(ctl + CW_BAR, MISC + 8);
    const int lo = a.ph_lo, hi = a.ph_hi;
#define IN(k) (lo <= (k) && (k) < hi)
#define SEAM(k) do { if ((k) + 1 < hi) xcd_barrier(bar); } while (0)

    half_t* XH = (half_t*)(ws + WS_XH); half_t* Z = (half_t*)(ws + WS_Z); half_t* O = (half_t*)(ws + WS_O); half_t* H1 = (half_t*)(ws + WS_H1); half_t* H2 = (half_t*)(ws + WS_H2);
    half_t* QX = (half_t*)(ws + WS_QX); half_t* PX = (half_t*)(ws + WS_PX); half_t* OX = (half_t*)(ws + WS_OX); half_t* KX = (half_t*)(ws + WS_KX); half_t* VXT = (half_t*)(ws + WS_VXT);
    half_t* MEMH = (half_t*)(ws + WS_MEMH); half_t* ACT = (half_t*)(ws + WS_ACT); half_t* Y = (half_t*)(ws + WS_Y); float* TMP = (float*)(ws + WS_TMP);
    half_t* WIN = (half_t*)(ws + WS_WIN); half_t* WMO = (half_t*)(ws + WS_WMO); half_t* WXQ = (half_t*)(ws + WS_WXQ); half_t* WXK = (half_t*)(ws + WS_WXK); half_t* WXV = (half_t*)(ws + WS_WXV);
    half_t* WXO = (half_t*)(ws + WS_WXO); half_t* WGU = (half_t*)(ws + WS_WGU); half_t* WD = (half_t*)(ws + WS_WD);
    const unsigned* CNT = (const unsigned*)(ws + WS_CTL) + CW_CNT; const int* LTOK = (const int*)(ws + WS_LTOK); const float* LW = (const float*)(ws + WS_LW);

    if (IN(0)) { phase_prep(P, lds, wg, G); SEAM(0); }
    if (IN(1)) {
        for (int bh = wg; bh < 64; bh += G) scan_bh(P, (LAS float*)lds, bh);
        gemm_naive_phase(FZ{XH, WIN, Z, P.pos, 1024, 0}, lds, wg, G, 1, T, ZW);
        gemm_naive_phase(FPlain{MEMH, WXK, KX, 1024, 1024, 1024, MROWS, 1.f, 1024}, lds, wg, G, 1, MROWS, 1024);
        gemm_naive_phase(FPlain{WXV, MEMH, VXT, 1024, 1024, MROWS, 1024, 1.f, 1024}, lds, wg, G, 1, 1024, MROWS);
        SEAM(1);
    }
    if (IN(2)) {
        for (int it = gw; it < 2048; it += ngw) { const int bh = it >> 5, j = it & 31; attn_naive_item<0>(P, j, bh, lane); attn_naive_item<0>(P, 63 - j, bh, lane); }
        for (int it = gw; it < 4096; it += ngw) attn_naive_item<1>(P, it & 63, it >> 6, lane);
        SEAM(2);
    }
    if (IN(3)) { gemm_naive_phase(FTmp{O, WMO, TMP, 1024, 0}, lds, wg, G, 1, T, 1024); SEAM(3); }
    if (IN(4)) { for (int row = gw; row < T; row += ngw) ln_naive_row<0>(P, row, lane); SEAM(4); }
    if (IN(5)) { gemm_naive_phase(FPlain{H1, WXQ, QX, 1024, 1024, 1024, T, C2_256, 1024}, lds, wg, G, 1, T, 1024); SEAM(5); }
    if (IN(6)) { for (int it = wg; it < (T / 32) * 4; it += G) xs_naive_item(P, lds, it); SEAM(6); }
    if (IN(7)) { gemm_naive_phase(FPV{PX, VXT, OX, 256, 0}, lds, wg, G, 32, SEQ, 256); SEAM(7); }
    if (IN(8)) { gemm_naive_phase(FTmp{OX, WXO, TMP, 1024, 0}, lds, wg, G, 1, T, 1024); SEAM(8); }
    if (IN(9)) { for (int row = gw; row < T; row += ngw) ln_naive_row<1>(P, row, lane); SEAM(9); }
    if (IN(10)) { for (int it = wg; it < T / 128; it += G) route_tokens(P, (LAS unsigned*)lds, it * 128); SEAM(10); }
    if (IN(11)) { gemm_naive_phase(FGU{H2, WGU, ACT, CNT, LTOK, 1024, 0}, lds, wg, G, NEXP, T, 1024); SEAM(11); }
    if (IN(12)) { gemm_naive_phase(FDown{ACT, WD, Y, CNT, LTOK, LW, 512, 0}, lds, wg, G, NEXP, T, 1024); SEAM(12); }
    if (IN(13)) { for (int row = gw; row < T; row += ngw) final_ln_row(P, row, lane); }
#undef IN
#undef SEAM
}

extern "C" void kernel_launch(void* const* d_in, const int* in_sizes, int n_in, void* d_out, int out_size, void* d_ws, size_t ws_size, hipStream_t stream) {
    static int grid = 0;
    if (grid == 0) {
        if (n_in != 23 || in_sizes[0] != T * DM || out_size != T * DM || ws_size < WS_END) { fprintf(stderr, "kernel_launch: unexpected shapes (n_in %d, in0 %d, out %d, ws %zu)\n", n_in, n_in > 0 ? in_sizes[0] : -1, out_size, ws_size); grid = -1; return; }
        int dev = 0, cus = 0;
        if (hipGetDevice(&dev) != hipSuccess || hipDeviceGetAttribute(&cus, hipDeviceAttributeMultiprocessorCount, dev) != hipSuccess) { grid = -1; return; }
        if (hipFuncSetAttribute((const void*)mega, hipFuncAttributeMaxDynamicSharedMemorySize, LDS_BYTES) != hipSuccess) { fprintf(stderr, "kernel_launch: hipFuncSetAttribute failed\n"); grid = -1; return; }
        int per_cu = 0;
        if (hipOccupancyMaxActiveBlocksPerMultiprocessor(&per_cu, (const void*)mega, 512, LDS_BYTES) != hipSuccess || per_cu < 1) fprintf(stderr, "kernel_launch: occupancy query reports %d\n", per_cu);
        (void)hipGetLastError();
        grid = cus;
    }
    if (grid < 0) return;
    (void)hipMemsetAsync((char*)d_ws + WS_CTL, 0, CTL_BYTES, stream);
    Args a{};
    Params& P = a.P;
    P.x = (const float*)d_in[0]; P.mem = (const float*)d_in[1]; P.pos = (const int*)d_in[2]; P.w_in = (const float*)d_in[3]; P.b_forget = (const float*)d_in[4];
    P.sinks = (const float*)d_in[5]; P.w_mix_out = (const float*)d_in[6]; P.ln_mix_g = (const float*)d_in[7]; P.ln_mix_b = (const float*)d_in[8];
    P.w_xq = (const float*)d_in[9]; P.w_xkv = (const float*)d_in[10]; P.w_xout = (const float*)d_in[11]; P.ln_x_g = (const float*)d_in[12]; P.ln_x_b = (const float*)d_in[13];
    P.w_rg = (const float*)d_in[14]; P.b_rg = (const float*)d_in[15]; P.w_re = (const float*)d_in[16]; P.b_re = (const float*)d_in[17];
    P.w_gate = (const float*)d_in[18]; P.w_up = (const float*)d_in[19]; P.w_down = (const float*)d_in[20]; P.ln_f_g = (const float*)d_in[21]; P.ln_f_b = (const float*)d_in[22];
    P.out = (float*)d_out; P.ws = (unsigned char*)d_ws;
    a.ph_lo = 0; a.ph_hi = NPHASE;
    hipLaunchKernelGGL(mega, dim3(grid), dim3(512), LDS_BYTES, stream, a);
}
```

```cpp
#include <hip/hip_runtime.h>
#include <cstdio>
#include <cstdint>

typedef _Float16 half_t;
typedef _Float16 h2_t __attribute__((ext_vector_type(2)));
typedef _Float16 h4_t __attribute__((ext_vector_type(4)));
typedef _Float16 h8_t __attribute__((ext_vector_type(8)));
typedef float f2_t __attribute__((ext_vector_type(2)));
typedef float f4_t __attribute__((ext_vector_type(4)));
typedef unsigned u4_t __attribute__((ext_vector_type(4)));
#define LAS __attribute__((address_space(3)))

constexpr int DM = 1024, NB = 8, SEQ = 4096, T = NB * SEQ;
constexpr int NMEM = 256, MROWS = NB * NMEM;
constexpr int INW = 2312, ZW = 2304;
constexpr int NEXP = 32, DEXP = 512, LCAP = T;
constexpr float ALPHA = 1.189207115002721f;
constexpr float LOG2E = 1.4426950408889634f;
constexpr float C2_64 = 0.125f * LOG2E;
constexpr float C2_256 = 0.0625f * LOG2E;
constexpr float LN_EPS = 1e-5f;
constexpr float FOX_CUT = 256.f;
constexpr int ZQF = 0, ZKF = 512, ZVF = 1024, ZQS = 1536, ZKS = 2048, ZVS = 2176;

constexpr size_t MiB = 1u << 20;
constexpr size_t WS_CTL = 0, CTL_BYTES = 1 * MiB;
constexpr size_t WS_WIN = 1 * MiB;
constexpr size_t WS_WMO = 6 * MiB;
constexpr size_t WS_WXQ = 8 * MiB, WS_WXK = 10 * MiB, WS_WXV = 12 * MiB, WS_WXO = 14 * MiB;
constexpr size_t WS_WR = 16 * MiB;
constexpr size_t WS_WGU = 17 * MiB;
constexpr size_t WS_WD = 81 * MiB;
constexpr size_t WS_LOGF = 113 * MiB;
constexpr size_t WS_CUM = 114 * MiB;
constexpr size_t WS_BK = 496 * MiB + 2 * MiB;
constexpr size_t WS_MEMH = 115 * MiB;
constexpr size_t WS_KX = 119 * MiB;
constexpr size_t WS_VXT = 123 * MiB;
constexpr size_t WS_LG = 127 * MiB;
constexpr size_t WS_LMR = 127 * MiB;
constexpr size_t WS_MR2 = 135 * MiB;
constexpr size_t WS_WQS = 136 * MiB;
constexpr size_t WS_UBH = 138 * MiB;
constexpr size_t WS_GT = 224 * MiB;
constexpr size_t WS_VWT = 226 * MiB;
constexpr size_t XB_STRIDE = 18 * MiB;
constexpr size_t WS_LTOK = 151 * MiB;
constexpr size_t WS_LW = 155 * MiB;
constexpr size_t WS_XH = 160 * MiB;
constexpr size_t WS_H2 = WS_XH;
constexpr size_t WS_Z = 224 * MiB;
constexpr size_t WS_QX = 224 * MiB;
constexpr size_t WS_PX = 368 * MiB;
constexpr size_t WS_Y = 224 * MiB;
constexpr size_t WS_TMP = 224 * MiB;
constexpr size_t WS_O = 368 * MiB;
constexpr size_t WS_OX = 368 * MiB;
constexpr size_t WS_ACT = 368 * MiB;
constexpr size_t WS_H1 = 432 * MiB;
constexpr size_t WS_V2 = 160 * MiB;
constexpr size_t WS_XB = 496 * MiB;
constexpr size_t WS_TS = 502 * MiB;
constexpr size_t WS_ST1 = 503 * MiB;
constexpr size_t WS_ST2 = 507 * MiB;
constexpr size_t WS_END = 511 * MiB;
constexpr int CW_CNT = 64;
constexpr int CW_UGU = 131072, CW_CGU = 163840;
constexpr int CW_UR = 196608, CW_CR = 196672;
constexpr int CW_U1 = 65536, CW_C1 = 65536 + 1024;

struct Params {
    const float* x; const float* mem; const int* pos; const float* w_in; const float* b_forget; const float* sinks; const float* w_mix_out;
    const float* ln_mix_g; const float* ln_mix_b; const float* w_xq; const float* w_xkv; const float* w_xout; const float* ln_x_g; const float* ln_x_b;
    const float* w_rg; const float* b_rg; const float* w_re; const float* b_re; const float* w_gate; const float* w_up; const float* w_down;
    const float* ln_f_g; const float* ln_f_b;
    float* out; unsigned char* ws;
};

__device__ __forceinline__ float wave_sum(float v) {
#pragma unroll
    for (int o = 1; o < 64; o <<= 1) v += __shfl_xor(v, o);
    return v;
}
__device__ __forceinline__ unsigned pkh(float lo, float hi) { f2_t v = {lo, hi}; h2_t h = __builtin_convertvector(v, h2_t); return __builtin_bit_cast(unsigned, h); }
__device__ __forceinline__ float inv_freq(int i) { return exp2f(-(float)i * (13.287712379549449f / 32.0f)); }
__device__ __forceinline__ void rope_cs(int pos, int i, float& c, float& s) {
    const float ang = (float)pos * inv_freq(i);
    const float rev = ang * 0.15915494309189535f; const float fr = rev - floorf(rev);
    s = __builtin_amdgcn_sinf(fr); c = __builtin_amdgcn_cosf(fr);
}

__device__ __forceinline__ int win_dest(int c) {
    if (c < 1536) return c;
    if (c < 1544) return -1;
    if (c < 2056) { const int cc = c - 1544, hd = cc >> 6, d = cc & 63; return ZQS + hd * 64 + ((d < 32) ? 2 * d : 2 * (d - 32) + 1); }
    if (c < 2184) { const int cc = c - 2056, hd = cc >> 6, d = cc & 63; return ZKS + hd * 64 + ((d < 32) ? 2 * d : 2 * (d - 32) + 1); }
    if (c < 2312) return ZVS + (c - 2184);
    return -1;
}
template <class DestFn>
__device__ __forceinline__ void tr_item(const float* W, int ldw, int N, half_t* WT, int ldt, LAS float* scr, int k0, int n0, int lane, DestFn dest) {
    float tv[32];
    { const int n = n0 + (lane & 31); const bool ok = n < N; const float* wp = W + (size_t)(k0 + (lane >> 5)) * ldw + (ok ? n : 0);
#pragma unroll
      for (int i = 0; i < 32; ++i) tv[i] = wp[(size_t)(2 * i) * ldw];
#pragma unroll
      for (int i = 0; i < 32; ++i) scr[(2 * i + (lane >> 5)) * 33 + (lane & 31)] = ok ? tv[i] : 0.f; }
    asm volatile("s_waitcnt lgkmcnt(0)" ::: "memory");
    const int c = lane & 7;
#pragma unroll
    for (int j = 0; j < 4; ++j) { const int nl = (lane >> 3) + 8 * j; const LAS float* s = scr + (8 * c) * 33 + nl;
        u4_t o; o.x = pkh(s[0 * 33], s[1 * 33]); o.y = pkh(s[2 * 33], s[3 * 33]); o.z = pkh(s[4 * 33], s[5 * 33]); o.w = pkh(s[6 * 33], s[7 * 33]);
        const int dr = (n0 + nl < N) ? dest(n0 + nl) : -1;
        if (dr >= 0) *(u4_t*)(WT + (size_t)dr * ldt + k0 + 8 * c) = o; }
    asm volatile("s_waitcnt lgkmcnt(0)" ::: "memory");
}
template <class DestFn>
__device__ __forceinline__ void tr_item_ln(const float* W, int ldw, half_t* WT, LAS float* scr, int k0, int n0, int lane, const float* gk, const float* bk, float* U, float* C, DestFn dest) {
    float tv[32];
    { const float* wp = W + (size_t)(k0 + (lane >> 5)) * ldw + n0 + (lane & 31);
#pragma unroll
      for (int i = 0; i < 32; ++i) tv[i] = wp[(size_t)(2 * i) * ldw];
#pragma unroll
      for (int i = 0; i < 32; ++i) scr[(2 * i + (lane >> 5)) * 33 + (lane & 31)] = tv[i]; }
    asm volatile("s_waitcnt lgkmcnt(0)" ::: "memory");
    const int c = lane & 7;
    float gs[8], bs[8];
#pragma unroll
    for (int i = 0; i < 8; ++i) { gs[i] = gk[k0 + 8 * c + i]; bs[i] = bk[k0 + 8 * c + i]; }
#pragma unroll
    for (int j = 0; j < 4; ++j) { const int nl = (lane >> 3) + 8 * j; const LAS float* sp = scr + (8 * c) * 33 + nl; const int dr = dest(n0 + nl);
        float sv[8]; float pu = 0.f, pc = 0.f;
#pragma unroll
        for (int i = 0; i < 8; ++i) { const float v = sp[i * 33]; sv[i] = v * gs[i]; pu += sv[i]; pc += v * bs[i]; }
        u4_t o; o.x = pkh(sv[0], sv[1]); o.y = pkh(sv[2], sv[3]); o.z = pkh(sv[4], sv[5]); o.w = pkh(sv[6], sv[7]);
        *(u4_t*)(WT + (size_t)dr * 1024 + k0 + 8 * c) = o;
        pu += __shfl_xor(pu, 1); pu += __shfl_xor(pu, 2); pu += __shfl_xor(pu, 4);
        pc += __shfl_xor(pc, 1); pc += __shfl_xor(pc, 2); pc += __shfl_xor(pc, 4);
        if (c == 0) { atomicAdd(U + dr, pu); atomicAdd(C + dr, pc); } }
    asm volatile("s_waitcnt lgkmcnt(0)" ::: "memory");
}
constexpr int NQ_GU = NEXP * 512;
__device__ __forceinline__ void conv_gu_item(const Params& P, LAS float* scr, int it, int lane) {
    half_t* WGU = (half_t*)(P.ws + WS_WGU); const int e = it >> 9; int r = it & 511; float* U = (float*)(P.ws + WS_CTL) + CW_UGU + e * 1024; float* C = (float*)(P.ws + WS_CTL) + CW_CGU + e * 1024;
    if (r < 256) tr_item_ln(P.w_gate + (size_t)e * 1024 * 512, 512, WGU + (size_t)e * 1024 * 1024, scr, 64 * (r / 16), 32 * (r % 16), lane, P.ln_x_g, P.ln_x_b, U, C, [](int c) { return 2 * c; });
    else { r -= 256; tr_item_ln(P.w_up + (size_t)e * 1024 * 512, 512, WGU + (size_t)e * 1024 * 1024, scr, 64 * (r / 16), 32 * (r % 16), lane, P.ln_x_g, P.ln_x_b, U, C, [](int c) { return 2 * c + 1; }); }
}
constexpr int NQ_WD = NEXP * 256;
__device__ __forceinline__ void conv_wd_item(const Params& P, LAS float* scr, int it, int lane) {
    half_t* WD = (half_t*)(P.ws + WS_WD); const int e = it >> 8, r = it & 255;
    tr_item(P.w_down + (size_t)e * 512 * 1024, 1024, 1024, WD + (size_t)e * 1024 * 512, 512, scr, 64 * (r / 32), 32 * (r % 32), lane, [](int c) { return c; });
}
constexpr int P0_LDS = 32768 + 8 * 8448;
__device__ __forceinline__ void phase_prep(const Params& P, LAS unsigned char* lds, int wg, int nwg) {
    const int tid = threadIdx.x, lane = tid & 63, wave = __builtin_amdgcn_readfirstlane(tid >> 6);
    constexpr int NXW = 5;
    const bool xw = wave < NXW;
    const int gw = xw ? wg * NXW + wave : wg * (8 - NXW) + (wave - NXW), ngw = xw ? nwg * NXW : nwg * (8 - NXW);
    LAS float* wfT = (LAS float*)lds;
    LAS float* scr = (LAS float*)(lds + 32768 + wave * 8448);
    for (int k = tid; k < 1024; k += 512) { const f4_t a = *(const f4_t*)(P.w_in + (size_t)k * INW + 1536), b = *(const f4_t*)(P.w_in + (size_t)k * INW + 1540);
        wfT[0 * 1024 + k] = a.x; wfT[1 * 1024 + k] = a.y; wfT[2 * 1024 + k] = a.z; wfT[3 * 1024 + k] = a.w; wfT[4 * 1024 + k] = b.x; wfT[5 * 1024 + k] = b.y; wfT[6 * 1024 + k] = b.z; wfT[7 * 1024 + k] = b.w; }
    __syncthreads();
    half_t* XH = (half_t*)(P.ws + WS_XH); float* LOGF = (float*)(P.ws + WS_LOGF);
    if (xw) { f4_t wfr[8][4];
#pragma unroll
      for (int h = 0; h < 8; ++h)
#pragma unroll
          for (int j = 0; j < 4; ++j) wfr[h][j] = *(const LAS f4_t*)(wfT + h * 1024 + 256 * j + 4 * lane);
      const int hsel = ((lane >> 5) & 1) * 4 + ((lane >> 4) & 1) * 2 + ((lane >> 3) & 1);
      const float bfg = P.b_forget[hsel];
      f4_t vc[2][4], vn[2][4];
      int row = 2 * gw;
      if (row < T) {
#pragma unroll
          for (int q = 0; q < 2; ++q) { const f4_t* xr = (const f4_t*)(P.x + (size_t)(row + q) * DM) + lane;
#pragma unroll
              for (int j = 0; j < 4; ++j) vc[q][j] = xr[64 * j]; } }
      for (; row < T; row += 2 * ngw) {
          const int nrow = row + 2 * ngw;
          if (nrow < T) {
#pragma unroll
              for (int q = 0; q < 2; ++q) { const f4_t* xr = (const f4_t*)(P.x + (size_t)(nrow + q) * DM) + lane;
#pragma unroll
                  for (int j = 0; j < 4; ++j) vn[q][j] = xr[64 * j]; } }
#pragma unroll
          for (int q = 0; q < 2; ++q) {
#pragma unroll
              for (int j = 0; j < 4; ++j) { unsigned long long w = (unsigned long long)pkh(vc[q][j].x, vc[q][j].y) | ((unsigned long long)pkh(vc[q][j].z, vc[q][j].w) << 32);
                  *(unsigned long long*)(XH + (size_t)(row + q) * DM + 256 * j + 4 * lane) = w; }
              float a[8];
#pragma unroll
              for (int h = 0; h < 8; ++h) { float t = 0.f;
#pragma unroll
                  for (int j = 0; j < 4; ++j) t += vc[q][j].x * wfr[h][j].x + vc[q][j].y * wfr[h][j].y + vc[q][j].z * wfr[h][j].z + vc[q][j].w * wfr[h][j].w;
                  a[h] = t; }
              float b4[4], b2[2], b1;
              { const bool up = (lane & 32) != 0;
#pragma unroll
                for (int i = 0; i < 4; ++i) { const float keep = up ? a[i + 4] : a[i], send = up ? a[i] : a[i + 4]; b4[i] = keep + __shfl_xor(send, 32); } }
              { const bool up = (lane & 16) != 0;
#pragma unroll
                for (int i = 0; i < 2; ++i) { const float keep = up ? b4[i + 2] : b4[i], send = up ? b4[i] : b4[i + 2]; b2[i] = keep + __shfl_xor(send, 16); } }
              { const bool up = (lane & 8) != 0; const float keep = up ? b2[1] : b2[0], send = up ? b2[0] : b2[1]; b1 = keep + __shfl_xor(send, 8); }
              b1 += __shfl_xor(b1, 4); b1 += __shfl_xor(b1, 2); b1 += __shfl_xor(b1, 1);
              if ((lane & 7) == 0) { const float z = b1 + bfg; const float ls = (z >= 0.f) ? -log1pf(expf(-z)) : (z - log1pf(expf(z))); LOGF[(size_t)(row + q) * 8 + hsel] = ls; }
          }
#pragma unroll
          for (int q = 0; q < 2; ++q)
#pragma unroll
              for (int j = 0; j < 4; ++j) vc[q][j] = vn[q][j];
      }
    }
    if (!xw) {
    half_t* MEMH = (half_t*)(P.ws + WS_MEMH);
    for (int row = gw; row < MROWS; row += ngw) {
        const f4_t* xr = (const f4_t*)(P.mem + (size_t)row * DM) + lane;
#pragma unroll
        for (int j = 0; j < 4; ++j) { const f4_t v = xr[64 * j]; unsigned long long w = (unsigned long long)pkh(v.x, v.y) | ((unsigned long long)pkh(v.z, v.w) << 32);
            *(unsigned long long*)(MEMH + (size_t)row * DM + 256 * j + 4 * lane) = w; }
    }
    { half_t* WRH = (half_t*)(P.ws + WS_WR); half_t* WRL = WRH + 48 * 1024;
      for (int i = gw * 64 + lane; i < 48 * 1024; i += ngw * 64) { const int r = i >> 10, k = i & 1023; float v = 0.f;
          if (r < 4) v = P.w_rg[k * 4 + r]; else if (r < 36) { const int g = (r - 4) >> 3, e = (r - 4) & 7; v = P.w_re[((size_t)g * 1024 + k) * 8 + e]; }
          v *= 32.f * P.ln_x_g[k]; const half_t hi = (half_t)v; const half_t lo = (half_t)(v - (float)hi); WRH[i] = hi; WRL[i] = lo; }
      for (int r = gw; r < 48; r += ngw) { float pu = 0.f, pc = 0.f;
          for (int k = lane; k < 1024; k += 64) { float v = 0.f;
              if (r < 4) v = P.w_rg[k * 4 + r]; else if (r < 36) { const int g = (r - 4) >> 3, e = (r - 4) & 7; v = P.w_re[((size_t)g * 1024 + k) * 8 + e]; }
              pu += 32.f * v * P.ln_x_g[k]; pc += 32.f * v * P.ln_x_b[k]; }
          pu = wave_sum(pu); pc = wave_sum(pc);
          if (lane == 0) { ((float*)(P.ws + WS_CTL))[CW_UR + r] = pu; ((float*)(P.ws + WS_CTL))[CW_CR + r] = pc; } } }
    { half_t* WQS = (half_t*)(P.ws + WS_WQS);
      for (int i = gw * 64 + lane; i < 1024 * 256; i += ngw * 64) { const int k = i >> 8; const f4_t v = *(const f4_t*)(P.w_xq + (size_t)i * 4) * P.ln_mix_g[k];
          *(unsigned long long*)(WQS + (size_t)i * 4) = (unsigned long long)pkh(v.x, v.y) | ((unsigned long long)pkh(v.z, v.w) << 32); } }
    constexpr int I_IN = 16 * 73, I_DD = 16 * 32, I_KV = 16 * 64, I_G = 16 * 16, I_D = 8 * 32;
    constexpr int NIT = I_IN + 3 * I_DD + I_KV;
    half_t* WIN = (half_t*)(P.ws + WS_WIN); half_t* WMO = (half_t*)(P.ws + WS_WMO); half_t* WXQ = (half_t*)(P.ws + WS_WXQ); half_t* WXK = (half_t*)(P.ws + WS_WXK);
    half_t* WXO = (half_t*)(P.ws + WS_WXO); half_t* WGU = (half_t*)(P.ws + WS_WGU); half_t* WD = (half_t*)(P.ws + WS_WD);
    for (int it = gw; it < NIT; it += ngw) {
        int r = it;
        if (r < I_IN) { tr_item(P.w_in, INW, INW, WIN, 1024, scr, 64 * (r / 73), 32 * (r % 73), lane, [](int c) { return win_dest(c); }); continue; } r -= I_IN;
        if (r < I_DD) { tr_item(P.w_mix_out, 1024, 1024, WMO, 1024, scr, 64 * (r / 32), 32 * (r % 32), lane, [](int c) { return c; }); continue; } r -= I_DD;
        if (r < I_DD) { tr_item_ln(P.w_xq, 1024, WXQ, scr, 64 * (r / 32), 32 * (r % 32), lane, P.ln_mix_g, P.ln_mix_b, (float*)(P.ws + WS_CTL) + CW_U1, (float*)(P.ws + WS_CTL) + CW_C1, [](int c) { return c; }); continue; } r -= I_DD;
        if (r < I_DD) { tr_item(P.w_xout, 1024, 1024, WXO, 1024, scr, 64 * (r / 32), 32 * (r % 32), lane, [](int c) { return c; }); continue; } r -= I_DD;
        tr_item(P.w_xkv, 2048, 2048, WXK, 1024, scr, 64 * (r / 64), 32 * (r % 64), lane, [](int c) { return c; });
    }
    }
}

__device__ __forceinline__ void scan_bh(const Params& P, LAS float* sh, int bh) {
    const int tid = threadIdx.x, lane = tid & 63, wave = tid >> 6, b = bh >> 3, h = bh & 7;
    const float* LOGF = (const float*)(P.ws + WS_LOGF); float* CUM = (float*)(P.ws + WS_CUM);
    float v[8]; float run = 0.f;
#pragma unroll
    for (int i = 0; i < 8; ++i) { run += LOGF[((size_t)b * SEQ + tid * 8 + i) * 8 + h]; v[i] = run; }
    float inc = run;
#pragma unroll
    for (int o = 1; o < 64; o <<= 1) { const float t = __shfl_up(inc, o); if (lane >= o) inc += t; }
    if (lane == 63) sh[wave] = inc;
    __syncthreads();
    float base = inc - run;
    for (int w = 0; w < wave; ++w) base += sh[w];
    half_t* BK = (half_t*)(P.ws + WS_BK);
#pragma unroll
    for (int i = 0; i < 8; ++i) { const float c = base + v[i]; CUM[(size_t)bh * SEQ + tid * 8 + i] = c;
        const float bias = -c * LOG2E; const half_t bh_ = (half_t)bias; const half_t bl_ = (half_t)(bias - (float)bh_);
        u4_t w; w.x = (unsigned)__builtin_bit_cast(unsigned short, bh_) | ((unsigned)__builtin_bit_cast(unsigned short, bl_) << 16); w.y = 0x3C003C00u; w.z = 0u; w.w = 0u;
        *(u4_t*)(BK + ((size_t)bh * SEQ + tid * 8 + i) * 8) = w; }
    if ((tid & 7) == 7) sh[16 + (tid >> 3)] = base + v[7];
    if ((tid & 31) == 0) sh[80 + (tid >> 5)] = base + v[0];
    __syncthreads();
    if (tid < 16) { const float cq = sh[80 + tid]; int t = 0; while (t < 4 * tid && (sh[16 + t] - cq) * LOG2E > FOX_CUT) ++t; ((int*)(P.ws + WS_TS))[bh * 16 + tid] = t & ~1; }
    __syncthreads();
}

template <class F>
__device__ __forceinline__ void gemm_naive_phase(const F& f, LAS unsigned char* lds, int wg, int nwg, int nz, int Mmax, int N) {
    LAS float* As = (LAS float*)lds;
    LAS float* Bs = As + 16 * 68;
    const int K = f.K, tid = threadIdx.x;
    const int ntm = Mmax / 64, ntn = N / 128, per = ntm * ntn, total = nz * per;
    const int lr = tid >> 2, lk = (tid & 3) * 4, ty = tid >> 5, tx = tid & 31;
    for (int it = wg; it < total; it += nwg) {
        const int z = it / per, r = it % per, m0 = (r / ntn) * 64, n0 = (r % ntn) * 128;
        if (m0 >= f.mrows(z)) continue;
        const half_t* ap = f.arow(z, m0 + (lr & 63)) + lk; const half_t* bp = f.brow(z, n0 + lr) + lk;
        float acc[4][4];
#pragma unroll
        for (int i = 0; i < 4; ++i)
#pragma unroll
            for (int j = 0; j < 4; ++j) acc[i][j] = 0.f;
        for (int k0 = 0; k0 < K; k0 += 16) {
            const h4_t av = *(const h4_t*)(ap + k0), bv = *(const h4_t*)(bp + k0);
            __syncthreads();
#pragma unroll
            for (int i = 0; i < 4; ++i) { if (tid < 256) As[(lk + i) * 68 + lr] = (float)av[i]; Bs[(lk + i) * 132 + lr] = (float)bv[i]; }
            __syncthreads();
#pragma unroll
            for (int k = 0; k < 16; ++k) { const f4_t a = *(const LAS f4_t*)&As[k * 68 + ty * 4], b = *(const LAS f4_t*)&Bs[k * 132 + tx * 4];
#pragma unroll
                for (int i = 0; i < 4; ++i)
#pragma unroll
                    for (int j = 0; j < 4; ++j) acc[i][j] += a[i] * b[j]; }
        }
#pragma unroll
        for (int i = 0; i < 4; ++i) f.epi(z, m0 + ty * 4 + i, n0 + tx * 4, acc[i]);
    }
    __syncthreads();
}

struct FZ {
    const half_t* XH; const half_t* WIN; half_t* Z; const int* pos; int K, pad;
    __device__ int mrows(int) const { return T; }
    __device__ const half_t* arow(int, int m) const { return XH + (size_t)m * DM; }
    __device__ const half_t* brow(int, int n) const { return WIN + (size_t)n * DM; }
    __device__ void epi(int, int m, int n0, float* v) const {
        float o[4] = {v[0], v[1], v[2], v[3]};
        if (n0 >= ZQS && n0 < ZVS) { const int p = pos[m]; const int i0 = (n0 & 63) >> 1; float c, s;
            rope_cs(p, i0, c, s); o[0] = v[0] * c - v[1] * s; o[1] = v[1] * c + v[0] * s;
            rope_cs(p, i0 + 1, c, s); o[2] = v[2] * c - v[3] * s; o[3] = v[3] * c + v[2] * s; }
        if (n0 < ZKF || (n0 >= ZQS && n0 < ZKS)) { o[0] *= C2_64; o[1] *= C2_64; o[2] *= C2_64; o[3] *= C2_64; }
        unsigned long long w = (unsigned long long)pkh(o[0], o[1]) | ((unsigned long long)pkh(o[2], o[3]) << 32);
        *(unsigned long long*)(Z + (size_t)m * ZW + n0) = w;
    }
};
struct FPlain {
    const half_t* A; const half_t* B; half_t* C; int lda, ldb, ldc, M; float scale; int K;
    __device__ int mrows(int) const { return M; }
    __device__ const half_t* arow(int, int m) const { return A + (size_t)m * lda; }
    __device__ const half_t* brow(int, int n) const { return B + (size_t)n * ldb; }
    __device__ void epi(int, int m, int n0, float* v) const {
        unsigned long long w = (unsigned long long)pkh(v[0] * scale, v[1] * scale) | ((unsigned long long)pkh(v[2] * scale, v[3] * scale) << 32);
        *(unsigned long long*)(C + (size_t)m * ldc + n0) = w;
    }
};
struct FTmp {
    const half_t* A; const half_t* B; float* C; int K, pad;
    __device__ int mrows(int) const { return T; }
    __device__ const half_t* arow(int, int m) const { return A + (size_t)m * DM; }
    __device__ const half_t* brow(int, int n) const { return B + (size_t)n * DM; }
    __device__ void epi(int, int m, int n0, float* v) const { *(f4_t*)(C + (size_t)m * DM + n0) = (f4_t){v[0], v[1], v[2], v[3]}; }
};
struct FPV {
    const half_t* PX; const half_t* VXT; half_t* OX; int K, pad;
    __device__ int mrows(int) const { return SEQ; }
    __device__ const half_t* arow(int z, int m) const { return PX + ((size_t)(z >> 2) * SEQ + m) * DM + (z & 3) * 256; }
    __device__ const half_t* brow(int z, int n) const { return VXT + ((size_t)(z & 3) * 256 + n) * MROWS + (z >> 2) * 256; }
    __device__ void epi(int z, int m, int n0, float* v) const {
        unsigned long long w = (unsigned long long)pkh(v[0], v[1]) | ((unsigned long long)pkh(v[2], v[3]) << 32);
        *(unsigned long long*)(OX + ((size_t)(z >> 2) * SEQ + m) * DM + (z & 3) * 256 + n0) = w;
    }
};
__device__ __forceinline__ int pbase_of(const unsigned* cnt, int e) { int b = 0; for (int i = 0; i < e; ++i) b += ((int)cnt[i] + 255) & ~255; return b; }
struct FGU {
    const half_t* H2; const half_t* WGU; half_t* ACT; const unsigned* cnt; const int* ltok; int K, pad;
    __device__ int mrows(int z) const { return (int)cnt[z]; }
    __device__ const half_t* arow(int z, int m) const { const int c = (int)cnt[z]; const int tk = (m < c) ? (ltok[(size_t)z * LCAP + m] >> 1) : 0; return H2 + (size_t)tk * DM; }
    __device__ const half_t* brow(int z, int n) const { return WGU + ((size_t)z * 1024 + n) * 1024; }
    __device__ void epi(int z, int m, int n0, float* v) const {
        const float a0 = v[0] / (1.f + expf(-v[0])) * v[1], a1 = v[2] / (1.f + expf(-v[2])) * v[3];
        *(unsigned*)(ACT + ((size_t)pbase_of(cnt, z) + m) * DEXP + (n0 >> 1)) = pkh(a0, a1);
    }
};
struct FDown {
    const half_t* ACT; const half_t* WD; half_t* Y; const unsigned* cnt; const int* ltok; const float* lw; int K, pad;
    __device__ int mrows(int z) const { return (int)cnt[z]; }
    __device__ const half_t* arow(int z, int m) const { return ACT + ((size_t)pbase_of(cnt, z) + m) * DEXP; }
    __device__ const half_t* brow(int z, int n) const { return WD + ((size_t)z * 1024 + n) * DEXP; }
    __device__ void epi(int z, int m, int n0, float* v) const {
        if (m >= (int)cnt[z]) return;
        const int t2 = ltok[(size_t)z * LCAP + m]; const float g = lw[(size_t)z * LCAP + m];
        unsigned long long w = (unsigned long long)pkh(v[0] * g, v[1] * g) | ((unsigned long long)pkh(v[2] * g, v[3] * g) << 32);
        *(unsigned long long*)(Y + (size_t)t2 * DM + n0) = w;
    }
};

template <int MODE>
__device__ __forceinline__ void attn_naive_item(const Params& P, int tblk, int bh, int lane) {
    const half_t* Z = (const half_t*)(P.ws + WS_Z); half_t* O = (half_t*)(P.ws + WS_O); const float* CUM = (const float*)(P.ws + WS_CUM);
    const int t0 = tblk * 64, t = t0 + lane, b = bh >> 3, h = bh & 7;
    const int qcol = (MODE == 0) ? ZQF + h * 64 : ZQS + h * 64;
    const int kcol = (MODE == 0) ? ZKF + h * 64 : ZKS + (h >> 2) * 64;
    const int vcol = (MODE == 0) ? ZVF + h * 64 : ZVS + (h >> 2) * 64;
    float q[64], o[64];
    { const half_t* qp = Z + ((size_t)b * SEQ + t) * ZW + qcol;
#pragma unroll
      for (int d = 0; d < 64; ++d) { q[d] = (float)qp[d]; o[d] = 0.f; } }
    float m = -INFINITY, l = 0.f;
    const float ct = (MODE == 0) ? CUM[(size_t)bh * SEQ + t] * LOG2E : 0.f;
    const int s_lo = (MODE == 0) ? 0 : ((t0 - 127 > 0) ? t0 - 127 : 0), s_hi = t0 + 63;
    for (int s = s_lo; s <= s_hi; ++s) {
        const half_t* kp = Z + ((size_t)b * SEQ + s) * ZW + kcol; const half_t* vp = Z + ((size_t)b * SEQ + s) * ZW + vcol;
        float sc = 0.f;
#pragma unroll
        for (int d8 = 0; d8 < 8; ++d8) { const h8_t kv = *(const h8_t*)(kp + d8 * 8);
#pragma unroll
            for (int j = 0; j < 8; ++j) sc += q[d8 * 8 + j] * (float)kv[j]; }
        bool ok = (s <= t);
        if (MODE == 0) sc += ct - CUM[(size_t)bh * SEQ + s] * LOG2E; else ok = ok && (t - s < 128);
        if (ok) {
            const float mn = fmaxf(m, sc), f = exp2f(m - mn), p = exp2f(sc - mn);
            l = l * f + p; m = mn;
#pragma unroll
            for (int d8 = 0; d8 < 8; ++d8) { const h8_t vv = *(const h8_t*)(vp + d8 * 8);
#pragma unroll
                for (int j = 0; j < 8; ++j) o[d8 * 8 + j] = o[d8 * 8 + j] * f + p * (float)vv[j]; }
        }
    }
    if (MODE == 1) l += exp2f(P.sinks[h] * LOG2E - m);
    const float rl = 1.f / l;
    half_t* op = O + ((size_t)b * SEQ + t) * DM + ((MODE == 0) ? 0 : 512) + h * 64;
#pragma unroll
    for (int d = 0; d < 64; d += 2) *(unsigned*)(op + d) = pkh(o[d] * rl, o[d + 1] * rl);
}

__device__ __forceinline__ void xs_naive_item(const Params& P, LAS unsigned char* lds, int item) {
    const half_t* QX = (const half_t*)(P.ws + WS_QX); const half_t* KX = (const half_t*)(P.ws + WS_KX); half_t* PX = (half_t*)(P.ws + WS_PX);
    LAS float (*S)[257] = (LAS float (*)[257])lds;
    const int tid = threadIdx.x, r = tid >> 4, c = tid & 15, t = (item >> 2) * 32 + r, h = item & 3, b = t / SEQ;
    const half_t* qp = QX + (size_t)t * DM + h * 256;
    float acc[16];
#pragma unroll
    for (int j = 0; j < 16; ++j) acc[j] = 0.f;
    for (int d0 = 0; d0 < 256; d0 += 8) { const h8_t qv = *(const h8_t*)(qp + d0);
#pragma unroll
        for (int j = 0; j < 16; ++j) { const h8_t kv = *(const h8_t*)(KX + ((size_t)b * 256 + c + 16 * j) * DM + h * 256 + d0);
#pragma unroll
            for (int i = 0; i < 8; ++i) acc[j] += (float)qv[i] * (float)kv[i]; } }
#pragma unroll
    for (int j = 0; j < 16; ++j) S[r][c + 16 * j] = acc[j];
    __syncthreads();
    float mx = -INFINITY;
    for (int j = 0; j < 16; ++j) mx = fmaxf(mx, S[r][c + 16 * j]);
#pragma unroll
    for (int o = 1; o < 16; o <<= 1) mx = fmaxf(mx, __shfl_xor(mx, o));
    float sum = 0.f;
    for (int j = 0; j < 16; ++j) { const float p = exp2f(S[r][c + 16 * j] - mx); S[r][c + 16 * j] = p; sum += p; }
#pragma unroll
    for (int o = 1; o < 16; o <<= 1) sum += __shfl_xor(sum, o);
    const float rs = 1.f / sum;
    for (int j = 0; j < 16; ++j) PX[(size_t)t * DM + h * 256 + c + 16 * j] = (half_t)(S[r][c + 16 * j] * rs);
    __syncthreads();
}

template <int MODE>
__device__ __forceinline__ void ln_naive_row(const Params& P, int row, int lane) {
    const float* TMP = (const float*)(P.ws + WS_TMP);
    const half_t* H1 = (const half_t*)(P.ws + WS_H1);
    f4_t v[4]; float s = 0.f;
#pragma unroll
    for (int j = 0; j < 4; ++j) { const int c = 256 * j + 4 * lane; f4_t r;
        if (MODE == 0) r = *(const f4_t*)(P.x + (size_t)row * DM + c); else { const h4_t hh = *(const h4_t*)(H1 + (size_t)row * DM + c); r = (f4_t){(float)hh[0], (float)hh[1], (float)hh[2], (float)hh[3]}; }
        v[j] = r * ALPHA + *(const f4_t*)(TMP + (size_t)row * DM + c); s += (v[j].x + v[j].y) + (v[j].z + v[j].w); }
    const float mean = wave_sum(s) * (1.f / DM); float s2 = 0.f;
#pragma unroll
    for (int j = 0; j < 4; ++j) { v[j] = v[j] - mean; s2 += (v[j].x * v[j].x + v[j].y * v[j].y) + (v[j].z * v[j].z + v[j].w * v[j].w); }
    const float rstd = 1.f / sqrtf(wave_sum(s2) * (1.f / DM) + LN_EPS);
    const float* G = (MODE == 0) ? P.ln_mix_g : P.ln_x_g; const float* B = (MODE == 0) ? P.ln_mix_b : P.ln_x_b;
    half_t* OUT = (half_t*)(P.ws + ((MODE == 0) ? WS_H1 : WS_H2));
#pragma unroll
    for (int j = 0; j < 4; ++j) { const int c = 256 * j + 4 * lane; v[j] = v[j] * rstd * *(const f4_t*)(G + c) + *(const f4_t*)(B + c);
        unsigned long long w = (unsigned long long)pkh(v[j].x, v[j].y) | ((unsigned long long)pkh(v[j].z, v[j].w) << 32);
        *(unsigned long long*)(OUT + (size_t)row * DM + c) = w; }
    if (MODE == 1) {
        float* LG = (float*)(P.ws + WS_LG);
        for (int r = 0; r < 36; ++r) { float a = 0.f;
#pragma unroll
            for (int j = 0; j < 4; ++j) { const int c = 256 * j + 4 * lane;
#pragma unroll
                for (int i = 0; i < 4; ++i) { const int k = c + i; const float w = (r < 4) ? P.w_rg[k * 4 + r] : P.w_re[((size_t)((r - 4) >> 3) * 1024 + k) * 8 + ((r - 4) & 7)]; a += v[j][i] * w; } }
            a = wave_sum(a);
            if (lane == 0) { LG[(size_t)row * 48 + r] = a * 32.f; LG[((size_t)T + row) * 48 + r] = 0.f; LG[((size_t)2 * T + row) * 48 + r] = 0.f; LG[((size_t)3 * T + row) * 48 + r] = 0.f; } }
    }
}

__device__ __forceinline__ void route_tokens(const Params& P, LAS unsigned* sh  , int t0) {
    const int tid = threadIdx.x;
    const float* LG = (const float*)(P.ws + WS_LG); unsigned* CNT = (unsigned*)(P.ws + WS_CTL) + CW_CNT;
    int* LTOK = (int*)(P.ws + WS_LTOK); float* LW = (float*)(P.ws + WS_LW);
    if (tid < 64) sh[tid] = 0u;
    __syncthreads();
    int e0 = 0, e1 = 0; float g0 = 0.f, g1 = 0.f; unsigned s0 = 0, s1 = 0;
    if (tid < 128) {
        const int t = t0 + tid;
        float lg[36];
#pragma unroll
        for (int r = 0; r < 36; ++r) lg[r] = (LG[(size_t)t * 48 + r] + LG[((size_t)T + t) * 48 + r] + LG[((size_t)2 * T + t) * 48 + r] + LG[((size_t)3 * T + t) * 48 + r]) * (1.f / 32.f);
        float pg[4]; float mx = -INFINITY;
#pragma unroll
        for (int g = 0; g < 4; ++g) { pg[g] = lg[g] + P.b_rg[g]; mx = fmaxf(mx, pg[g]); }
        float sum = 0.f;
#pragma unroll
        for (int g = 0; g < 4; ++g) { pg[g] = expf(pg[g] - mx); sum += pg[g]; }
        int gi = 0; float gv = pg[0];
#pragma unroll
        for (int g = 1; g < 4; ++g) if (pg[g] > gv) { gv = pg[g]; gi = g; }
        gv /= sum;
        float sel[8];
#pragma unroll
        for (int e = 0; e < 8; ++e) { float a = lg[4 + e];
#pragma unroll
            for (int g = 1; g < 4; ++g) a = (gi == g) ? lg[4 + 8 * g + e] : a;
            sel[e] = a + P.b_re[gi * 8 + e]; }
        int i0 = 0; float v0 = sel[0];
#pragma unroll
        for (int e = 1; e < 8; ++e) if (sel[e] > v0) { v0 = sel[e]; i0 = e; }
        int i1 = -1; float v1 = -INFINITY;
#pragma unroll
        for (int e = 0; e < 8; ++e) if (e != i0 && sel[e] > v1) { v1 = sel[e]; i1 = e; }
        const float p1 = expf(v1 - v0), den = 1.f + p1;
        g0 = gv / den; g1 = gv * p1 / den; e0 = gi * 8 + i0; e1 = gi * 8 + i1;
        s0 = atomicAdd((unsigned*)&sh[e0], 1u); s1 = atomicAdd((unsigned*)&sh[e1], 1u);
    }
    __syncthreads();
    if (tid < 32) { const unsigned c = sh[tid]; sh[32 + tid] = c ? atomicAdd(&CNT[tid], c) : 0u; }
    __syncthreads();
    if (tid < 128) {
        const int t = t0 + tid; const unsigned d0 = sh[32 + e0] + s0, d1 = sh[32 + e1] + s1;
        LTOK[(size_t)e0 * LCAP + d0] = 2 * t; LW[(size_t)e0 * LCAP + d0] = g0;
        LTOK[(size_t)e1 * LCAP + d1] = 2 * t + 1; LW[(size_t)e1 * LCAP + d1] = g1;
    }
    __syncthreads();
}

__device__ __forceinline__ void route_tokens_fast(const Params& P, LAS unsigned char* lds, int t0) {
    typedef float f32x4 __attribute__((ext_vector_type(4)));
    const int tid = threadIdx.x, lane = tid & 63, wave = tid >> 6, fr = lane & 15, fq = lane >> 4;
    const half_t* H2 = (const half_t*)(P.ws + WS_V2); const half_t* WR = (const half_t*)(P.ws + WS_WR);
    LAS float* LGT = (LAS float*)(lds + 102400); LAS unsigned* sh = (LAS unsigned*)(lds + 126976);
    f32x4 acc[3];
#pragma unroll
    for (int et = 0; et < 3; ++et) acc[et] = (f32x4){0.f, 0.f, 0.f, 0.f};
    const half_t* hrow = H2 + (size_t)(t0 + wave * 16 + fr) * DM + 8 * fq;
    h8_t bfr[32];
#pragma unroll
    for (int ks = 0; ks < 32; ++ks) bfr[ks] = *(const h8_t*)(hrow + ks * 32);
    f4_t stp[8];
    if (tid < 128) { const f4_t* p = (const f4_t*)((const float*)(P.ws + WS_ST2) + ((size_t)(t0 + tid) * 16) * 2);
#pragma unroll
        for (int k = 0; k < 8; ++k) stp[k] = p[k]; }
#pragma unroll
    for (int kh = 0; kh < 2; ++kh) {
        __syncthreads();
#pragma unroll
        for (int it = 0; it < 12; ++it) { const int i = tid + it * 512; const int p = i / (48 * 64), r = (i / 64) % 48, c = i % 64;
            *(LAS u4_t*)(lds + (p * 48 + r) * 1040 + c * 16) = *(const u4_t*)(WR + (size_t)p * 48 * 1024 + (size_t)r * 1024 + kh * 512 + c * 8); }
        __syncthreads();
#pragma unroll
        for (int ks = 0; ks < 16; ++ks) {
            const h8_t b = bfr[kh * 16 + ks];
#pragma unroll
            for (int et = 0; et < 3; ++et) {
                const h8_t whi = *(const LAS h8_t*)(lds + (et * 16 + fr) * 1040 + ks * 64 + fq * 16);
                const h8_t wlo = *(const LAS h8_t*)(lds + (48 + et * 16 + fr) * 1040 + ks * 64 + fq * 16);
                acc[et] = __builtin_amdgcn_mfma_f32_16x16x32_f16(whi, b, acc[et], 0, 0, 0);
                acc[et] = __builtin_amdgcn_mfma_f32_16x16x32_f16(wlo, b, acc[et], 0, 0, 0);
            }
        }
    }
#pragma unroll
    for (int et = 0; et < 3; ++et)
#pragma unroll
        for (int r = 0; r < 4; ++r) LGT[(wave * 16 + fr) * 48 + et * 16 + 4 * fq + r] = acc[et][r];
    if (tid < 64) sh[tid] = 0u;
    __syncthreads();
    unsigned* CNT = (unsigned*)(P.ws + WS_CTL) + CW_CNT; int* LTOK = (int*)(P.ws + WS_LTOK); float* LW = (float*)(P.ws + WS_LW);
    int e0 = 0, e1 = 0; float g0 = 0.f, g1 = 0.f; unsigned s0 = 0, s1 = 0;
    float rmean = 0.f, rrstd = 0.f;
    if (tid < 128) {
        { float sm = 0.f, sq = 0.f;
#pragma unroll
          for (int k = 0; k < 8; ++k) { const f4_t t = stp[k]; sm += t[0] + t[2]; sq += t[1] + t[3]; }
          rmean = sm * (1.f / DM); rrstd = 1.0f / sqrtf(sq * (1.f / DM) - rmean * rmean + LN_EPS);
          *(f2_t*)((float*)(P.ws + WS_MR2) + (size_t)(t0 + tid) * 2) = (f2_t){rmean, rrstd}; }
        const float* UR = (const float*)(P.ws + WS_CTL) + CW_UR; const float* CR = (const float*)(P.ws + WS_CTL) + CW_CR;
        float lg[36];
#pragma unroll
        for (int r = 0; r < 36; ++r) lg[r] = (rrstd * LGT[tid * 48 + r] - rrstd * rmean * UR[r] + CR[r]) * (1.f / 32.f);
        float pg[4]; float mx = -INFINITY;
#pragma unroll
        for (int g = 0; g < 4; ++g) { pg[g] = lg[g] + P.b_rg[g]; mx = fmaxf(mx, pg[g]); }
        float sum = 0.f;
#pragma unroll
        for (int g = 0; g < 4; ++g) { pg[g] = expf(pg[g] - mx); sum += pg[g]; }
        int gi = 0; float gv = pg[0];
#pragma unroll
        for (int g = 1; g < 4; ++g) if (pg[g] > gv) { gv = pg[g]; gi = g; }
        gv /= sum;
        float sel[8];
#pragma unroll
        for (int e = 0; e < 8; ++e) { float a = lg[4 + e];
#pragma unroll
            for (int g = 1; g < 4; ++g) a = (gi == g) ? lg[4 + 8 * g + e] : a;
            sel[e] = a + P.b_re[gi * 8 + e]; }
        int i0 = 0; float v0 = sel[0];
#pragma unroll
        for (int e = 1; e < 8; ++e) if (sel[e] > v0) { v0 = sel[e]; i0 = e; }
        int i1 = -1; float v1 = -INFINITY;
#pragma unroll
        for (int e = 0; e < 8; ++e) if (e != i0 && sel[e] > v1) { v1 = sel[e]; i1 = e; }
        const float p1 = expf(v1 - v0), den = 1.f + p1;
        g0 = gv / den; g1 = gv * p1 / den; e0 = gi * 8 + i0; e1 = gi * 8 + i1;
        s0 = atomicAdd((unsigned*)&sh[e0], 1u); s1 = atomicAdd((unsigned*)&sh[e1], 1u);
    }
    __syncthreads();
    if (tid < 32) { const unsigned c = sh[tid]; sh[32 + tid] = c ? atomicAdd(&CNT[tid], c) : 0u; }
    __syncthreads();
    if (tid < 128) {
        const int t = t0 + tid; const unsigned d0 = sh[32 + e0] + s0, d1 = sh[32 + e1] + s1;
        LTOK[(size_t)e0 * LCAP + d0] = 2 * t; LW[(size_t)e0 * LCAP + d0] = g0;
        LTOK[(size_t)e1 * LCAP + d1] = 2 * t + 1; LW[(size_t)e1 * LCAP + d1] = g1;
        float* LMR = (float*)(P.ws + WS_LMR);
        *(f2_t*)(LMR + ((size_t)e0 * LCAP + d0) * 2) = (f2_t){rmean, rrstd}; *(f2_t*)(LMR + ((size_t)e1 * LCAP + d1) * 2) = (f2_t){rmean, rrstd};
    }
    __syncthreads();
}

__device__ __forceinline__ void final_ln_row(const Params& P, int row, int lane) {
    const half_t* H2 = (const half_t*)(P.ws + WS_H2); const half_t* Y = (const half_t*)(P.ws + WS_Y);
    f4_t v[4]; float s = 0.f;
#pragma unroll
    for (int j = 0; j < 4; ++j) { const int c = 256 * j + 4 * lane;
        const h4_t hh = *(const h4_t*)(H2 + (size_t)row * DM + c), y0 = *(const h4_t*)(Y + (size_t)(2 * row) * DM + c), y1 = *(const h4_t*)(Y + (size_t)(2 * row + 1) * DM + c);
#pragma unroll
        for (int i = 0; i < 4; ++i) v[j][i] = ALPHA * (float)hh[i] + ((float)y0[i] + (float)y1[i]);
        s += (v[j].x + v[j].y) + (v[j].z + v[j].w); }
    const float mean = wave_sum(s) * (1.f / DM); float s2 = 0.f;
#pragma unroll
    for (int j = 0; j < 4; ++j) { v[j] = v[j] - mean; s2 += (v[j].x * v[j].x + v[j].y * v[j].y) + (v[j].z * v[j].z + v[j].w * v[j].w); }
    const float rstd = 1.f / sqrtf(wave_sum(s2) * (1.f / DM) + LN_EPS);
#pragma unroll
    for (int j = 0; j < 4; ++j) { const int c = 256 * j + 4 * lane; *(f4_t*)(P.out + (size_t)row * DM + c) = v[j] * rstd * *(const f4_t*)(P.ln_f_g + c) + *(const f4_t*)(P.ln_f_b + c); }
}

__device__ __forceinline__ void final_ln_row2(const Params& P, int row, int lane) {
    const half_t* H2 = (const half_t*)(P.ws + WS_V2); const half_t* Y = (const half_t*)(P.ws + WS_Y);
    const f2_t mr0 = *(const f2_t*)((const float*)(P.ws + WS_MR2) + (size_t)row * 2), mr1 = *(const f2_t*)((const float*)(P.ws + WS_MR2) + (size_t)(row + 1) * 2);
    f4_t g2v[4], b2v[4];
#pragma unroll
    for (int j = 0; j < 4; ++j) { g2v[j] = *(const f4_t*)(P.ln_x_g + 256 * j + 4 * lane); b2v[j] = *(const f4_t*)(P.ln_x_b + 256 * j + 4 * lane); }
    h4_t hh[2][4], y0[2][4], y1[2][4];
#pragma unroll
    for (int q = 0; q < 2; ++q)
#pragma unroll
        for (int j = 0; j < 4; ++j) { const int c = 256 * j + 4 * lane; hh[q][j] = *(const h4_t*)(H2 + (size_t)(row + q) * DM + c); y0[q][j] = *(const h4_t*)(Y + (size_t)(2 * (row + q)) * DM + c); y1[q][j] = *(const h4_t*)(Y + (size_t)(2 * (row + q) + 1) * DM + c); }
    f4_t gv[4], bv[4];
#pragma unroll
    for (int j = 0; j < 4; ++j) { const int c = 256 * j + 4 * lane; gv[j] = *(const f4_t*)(P.ln_f_g + c); bv[j] = *(const f4_t*)(P.ln_f_b + c); }
#pragma unroll
    for (int q = 0; q < 2; ++q) {
        f4_t v[4]; float s = 0.f;
#pragma unroll
        for (int j = 0; j < 4; ++j) {
#pragma unroll
            for (int i = 0; i < 4; ++i) { const float mean2 = q ? mr1.x : mr0.x, rstd2 = q ? mr1.y : mr0.y; const float h2v = ((float)hh[q][j][i] - mean2) * rstd2 * g2v[j][i] + b2v[j][i];
                v[j][i] = ALPHA * h2v + ((float)y0[q][j][i] + (float)y1[q][j][i]); }
            s += (v[j].x + v[j].y) + (v[j].z + v[j].w); }
        const float mean = wave_sum(s) * (1.f / DM); float s2 = 0.f;
#pragma unroll
        for (int j = 0; j < 4; ++j) { v[j] = v[j] - mean; s2 += (v[j].x * v[j].x + v[j].y * v[j].y) + (v[j].z * v[j].z + v[j].w * v[j].w); }
        const float rstd = 1.f / sqrtf(wave_sum(s2) * (1.f / DM) + LN_EPS);
#pragma unroll
        for (int j = 0; j < 4; ++j) { const int c = 256 * j + 4 * lane; *(f4_t*)(P.out + (size_t)(row + q) * DM + c) = v[j] * rstd * gv[j] + bv[j]; }
    }
}

__device__ __forceinline__ void final_ln_rows(const Params& P, int gw, int ngw, int lane) {
    const half_t* H2 = (const half_t*)(P.ws + WS_V2); const half_t* Y = (const half_t*)(P.ws + WS_Y); const float* MR = (const float*)(P.ws + WS_MR2);
    f4_t g2v[4], b2v[4], gv[4], bv[4];
#pragma unroll
    for (int j = 0; j < 4; ++j) { const int c = 256 * j + 4 * lane; g2v[j] = *(const f4_t*)(P.ln_x_g + c) * ALPHA; b2v[j] = *(const f4_t*)(P.ln_x_b + c) * ALPHA; gv[j] = *(const f4_t*)(P.ln_f_g + c); bv[j] = *(const f4_t*)(P.ln_f_b + c); }
    h4_t hh[2][4], y0[2][4], y1[2][4], nh[2][4], n0[2][4], n1[2][4]; f2_t mr[2], nm[2];
#define FL_LOAD(HH, Y0, Y1, MRR, R) do { _Pragma("unroll") for (int q = 0; q < 2; ++q) { MRR[q] = *(const f2_t*)(MR + (size_t)((R) + q) * 2); \
        _Pragma("unroll") for (int j = 0; j < 4; ++j) { const int c = 256 * j + 4 * lane; HH[q][j] = *(const h4_t*)(H2 + (size_t)((R) + q) * DM + c); \
            Y0[q][j] = *(const h4_t*)(Y + (size_t)(2 * ((R) + q)) * DM + c); Y1[q][j] = *(const h4_t*)(Y + (size_t)(2 * ((R) + q) + 1) * DM + c); } } } while (0)
    int row = 2 * gw;
    if (row < T) FL_LOAD(hh, y0, y1, mr, row);
    for (; row < T; row += 2 * ngw) {
        const int nrow = row + 2 * ngw;
        if (nrow < T) FL_LOAD(nh, n0, n1, nm, nrow);
#pragma unroll
        for (int q = 0; q < 2; ++q) {
            f4_t v[4]; float s = 0.f; const float mean2 = mr[q].x, rstd2 = mr[q].y;
#pragma unroll
            for (int j = 0; j < 4; ++j) {
#pragma unroll
                for (int i = 0; i < 4; ++i) v[j][i] = (((float)hh[q][j][i] - mean2) * rstd2 * g2v[j][i] + b2v[j][i]) + ((float)y0[q][j][i] + (float)y1[q][j][i]);
                s += (v[j].x + v[j].y) + (v[j].z + v[j].w); }
            const float mean = wave_sum(s) * (1.f / DM); float s2 = 0.f;
#pragma unroll
            for (int j = 0; j < 4; ++j) { v[j] = v[j] - mean; s2 += (v[j].x * v[j].x + v[j].y * v[j].y) + (v[j].z * v[j].z + v[j].w * v[j].w); }
            const float rstd = 1.f / sqrtf(wave_sum(s2) * (1.f / DM) + LN_EPS);
#pragma unroll
            for (int j = 0; j < 4; ++j) { const int c = 256 * j + 4 * lane; *(f4_t*)(P.out + (size_t)(row + q) * DM + c) = v[j] * rstd * gv[j] + bv[j]; }
        }
#pragma unroll
        for (int q = 0; q < 2; ++q) { mr[q] = nm[q];
#pragma unroll
            for (int j = 0; j < 4; ++j) { hh[q][j] = nh[q][j]; y0[q][j] = n0[q][j]; y1[q][j] = n1[q][j]; } }
    }
#undef FL_LOAD
}

namespace pg {
typedef float f32x4 __attribute__((ext_vector_type(4)));
constexpr int BM = 256, BK = 64, HALF = 128, HTB = HALF * BK * 2, STAGE_BYTES = 8 * HTB, NXCD = 8, WGM = 8;
__host__ __device__ __forceinline__ int lds_byte(int r, int c) { const int st = (r >> 4) * 2 + (c >> 5), rr = r & 15, cc = c & 31, ob = rr * 64 + cc * 2; return st * 1024 + (ob ^ (((ob >> 9) & 1) << 5)); }
__host__ __device__ __forceinline__ void stage_rc(int b, int& R, int& C) { const int st = b / 1024, sb = b % 1024, swz = sb ^ (((sb >> 9) & 1) << 5); R = (st >> 1) * 16 + swz / 64; C = (st & 1) * 32 + (swz % 64) / 2; }
__host__ __device__ __forceinline__ int perm32(int rho) { const int n = rho >> 4, i = rho & 15; return 8 * (i >> 2) + 4 * n + (i & 3); }
struct Unit { int pm, pn, z, rb, aux; };

struct StaticOrder {
    int nM, nN, nwg, G, c, pm0;
    __device__ void init(int nM_, int nN_, int G_, int c_, int pm0_) { nM = nM_; nN = nN_; nwg = nM * nN; G = G_; c = c_; pm0 = pm0_; }
    __device__ bool next(int i, Unit& u) const {
        const long L = (long)i * G + c; if (L >= nwg) return false;
        int wgid = (int)L; { const int q = nwg / NXCD, r = nwg % NXCD, xcd = wgid % NXCD, off = wgid / NXCD; wgid = (xcd < r ? xcd * (q + 1) : r * (q + 1) + (xcd - r) * q) + off; }
        const int nig = WGM * nN, gid = wgid / nig, fm = gid * WGM, gsz = (nM - fm) < WGM ? (nM - fm) : WGM;
        u.pm = pm0 + fm + ((wgid % nig) % gsz); u.pn = (wgid % nig) / gsz; u.z = 0; u.rb = i; u.aux = 0; return true;
    }
};
struct OneUnit {
    int pm, pn;
    __device__ bool next(int i, Unit& u) const { if (i) return false; u.pm = pm; u.pn = pn; u.z = 0; u.rb = 0; u.aux = 0; return true; }
};
struct DenseProb {
    static constexpr bool GATHER = false;
    const half_t* A; const half_t* B; size_t a_sm, a_sn, b_sn, b_sb; int lda, ldb, K, pad;
    __device__ __forceinline__ const char* a_ptr(const Unit& u) const { return (const char*)(A + (size_t)u.pm * a_sm + (size_t)u.pn * a_sn); }
    __device__ __forceinline__ const char* b_ptr(const Unit& u) const { return (const char*)(B + (size_t)u.pn * b_sn + (size_t)(u.pm >> 4) * b_sb); }
    __device__ __forceinline__ unsigned a_row_off(const Unit&, int r) const { return (unsigned)(r * lda) * 2u; }
    __device__ __forceinline__ int ldb_of() const { return ldb; }
};
__device__ __forceinline__ DenseProb dense(const half_t* A, int lda, const half_t* B, int ldb, int K) { return DenseProb{A, B, (size_t)BM * lda, 0, (size_t)BM * ldb, 0, lda, ldb, K, 0}; }

struct EpiF16 {
    static constexpr bool PERM = true, AFTER_DRAIN = false;
    half_t* C; int ldc; float scale; int rmode, bskip;
    static constexpr int NVM = 16; __device__ __forceinline__ bool nvm_ok(const Unit&) const { return true; }
    __device__ __forceinline__ void operator()(f32x4 (&acc)[2][2][4][2], const Unit& u, int wr, int wc, int fr, int fq) const {
        const int rt = rmode ? (u.pn >> 2) * 4 + u.pm : u.pm, ct = rmode ? (u.pn & 3) : u.pn;
        const int row0 = rt * BM + wr * 64 + fr, col0 = ct * BM + wc * 32 + 8 * fq;
#pragma unroll
        for (int ai = 0; ai < 2; ++ai)
#pragma unroll
            for (int m = 0; m < 4; ++m) { half_t* rowp = C + (size_t)(rt >> 2) * bskip + (size_t)(row0 + ai * HALF + m * 16) * ldc + col0;
#pragma unroll
                for (int bj = 0; bj < 2; ++bj) { const f32x4 v0 = acc[ai][bj][m][0] * scale, v1 = acc[ai][bj][m][1] * scale;
                    u4_t w; w.x = pkh(v0[0], v0[1]); w.y = pkh(v0[2], v0[3]); w.z = pkh(v1[0], v1[1]); w.w = pkh(v1[2], v1[3]);
                    *(u4_t*)(rowp + bj * HALF) = w; } }
    }
};

struct EpiZ {
    static constexpr bool PERM = true, AFTER_DRAIN = false;
    static constexpr bool PREFETCH = true;
    half_t* Z; const int* pos; LAS unsigned char* side; int mode, pad;
    static constexpr int NVM = 16; __device__ __forceinline__ bool nvm_ok(const Unit&) const { return mode == 0; }
    __device__ __forceinline__ void prefetch(const Unit& u, int tid, int wid) const {
        if (u.pn >= 6 && wid < 4) __builtin_amdgcn_global_load_lds((const unsigned*)(pos + u.pm * BM) + tid, (LAS unsigned*)(side + wid * 256), 4, 0, 0); }
    __device__ __forceinline__ void operator()(f32x4 (&acc)[2][2][4][2], const Unit& u, int wr, int wc, int fr, int fq) const {
        if (mode & 2) return;
        const int pn = u.pn, row0 = u.pm * BM + wr * 64 + fr, col0 = pn * BM + wc * 32 + 8 * fq;
        const bool rope0 = (pn >= 6), rope1 = (pn == 6 || pn == 7);
        const float sc = (pn <= 1 || pn == 6 || pn == 7) ? C2_64 : 1.f;
        const int i0 = 16 * (wc & 1) + 4 * fq;
        float invf[4];
#pragma unroll
        for (int j = 0; j < 4; ++j) invf[j] = inv_freq(i0 + j);
#pragma unroll
        for (int ai = 0; ai < 2; ++ai)
#pragma unroll
            for (int m = 0; m < 4; ++m) { const int row = row0 + ai * HALF + m * 16; half_t* rowp = Z + (size_t)row * ZW + col0;
                float cs[4], sn[4];
                if (rope0) { const float p = (float)((const LAS int*)side)[wr * 64 + fr + ai * HALF + m * 16];
#pragma unroll
                    for (int j = 0; j < 4; ++j) { const float rev = p * invf[j] * 0.15915494309189535f; const float fr_ = rev - floorf(rev); sn[j] = __builtin_amdgcn_sinf(fr_); cs[j] = __builtin_amdgcn_cosf(fr_); } }
#pragma unroll
                for (int bj = 0; bj < 2; ++bj) { f32x4 v0 = acc[ai][bj][m][0], v1 = acc[ai][bj][m][1];
                    if (bj == 0 ? rope0 : rope1) {
                        const f32x4 a = v0, b = v1;
                        v0[0] = a[0] * cs[0] - a[1] * sn[0]; v0[1] = a[1] * cs[0] + a[0] * sn[0]; v0[2] = a[2] * cs[1] - a[3] * sn[1]; v0[3] = a[3] * cs[1] + a[2] * sn[1];
                        v1[0] = b[0] * cs[2] - b[1] * sn[2]; v1[1] = b[1] * cs[2] + b[0] * sn[2]; v1[2] = b[2] * cs[3] - b[3] * sn[3]; v1[3] = b[3] * cs[3] + b[2] * sn[3]; }
                    v0 = v0 * sc; v1 = v1 * sc;
                    u4_t w; w.x = pkh(v0[0], v0[1]); w.y = pkh(v0[2], v0[3]); w.z = pkh(v1[0], v1[1]); w.w = pkh(v1[2], v1[3]);
                    if (mode & 1) { asm volatile("" :: "v"(w)); } else *(u4_t*)(rowp + bj * HALF) = w; } }
    }
};

struct PanelStats {
    unsigned* xbuf;
    unsigned* cnt;
    unsigned* tmo;
    int ntn; float eps; unsigned code; int pad;
    __device__ __forceinline__ bool run(const f32x4 (&v)[2][2][4][2], const Unit& u, int wr, int wc, int fr, int fq, LAS unsigned char* lds, int wid, int lane) const {
        typedef float f32x2v __attribute__((ext_vector_type(2)));
        LAS f32x2v* P = (LAS f32x2v*)lds;
        LAS f32x2v* S = (LAS f32x2v*)(lds + 8192);
        LAS unsigned* flag = (LAS unsigned*)(lds + 8192 + 2048);
#pragma unroll
        for (int ai = 0; ai < 2; ++ai)
#pragma unroll
            for (int m = 0; m < 4; ++m) {
                float s = 0.f;
#pragma unroll
                for (int bj = 0; bj < 2; ++bj)
#pragma unroll
                    for (int n = 0; n < 2; ++n) { const f32x4 x = v[ai][bj][m][n]; s += (x[0] + x[1]) + (x[2] + x[3]); }
                s += __shfl_xor(s, 16); s += __shfl_xor(s, 32);
                const float mw = s * (1.0f / 64.0f); float q = 0.f;
#pragma unroll
                for (int bj = 0; bj < 2; ++bj)
#pragma unroll
                    for (int n = 0; n < 2; ++n) { const f32x4 d = v[ai][bj][m][n] - mw; q += (d[0] * d[0] + d[1] * d[1]) + (d[2] * d[2] + d[3] * d[3]); }
                q += __shfl_xor(q, 16); q += __shfl_xor(q, 32);
                if (fq == 0) P[(ai * HALF + wr * 64 + m * 16 + fr) * 4 + wc] = (f32x2v){mw, q};
            }
        asm volatile("s_waitcnt lgkmcnt(0)" ::: "memory"); __builtin_amdgcn_s_barrier(); asm volatile("" ::: "memory");
        const int row = wid * 32 + (lane & 31);
        if (lane < 32) {
            const f32x2v a = P[row * 4 + 0], b = P[row * 4 + 1], c = P[row * 4 + 2], d = P[row * 4 + 3];
            const float mt = (a.x + b.x + c.x + d.x) * 0.25f;
            const float da = a.x - mt, db = b.x - mt, dc = c.x - mt, dd = d.x - mt;
            const float m2 = (a.y + b.y) + (c.y + d.y) + 64.0f * ((da * da + db * db) + (dc * dc + dd * dd));
            unsigned long long* slot = (unsigned long long*)xbuf + ((size_t)(u.pm * BM + row) * 4 + u.pn);
            __hip_atomic_store(slot, ((unsigned long long)__float_as_uint(m2) << 32) | __float_as_uint(mt), __ATOMIC_RELAXED, __HIP_MEMORY_SCOPE_AGENT);
        }
        asm volatile("s_waitcnt vmcnt(0)" ::: "memory");
        if (lane == 0) __hip_atomic_fetch_add(cnt + 64 * u.pm, 1u, __ATOMIC_RELAXED, __HIP_MEMORY_SCOPE_AGENT);
        if (wid == 0) {
            bool dead = false; const unsigned long long t0 = __builtin_amdgcn_s_memrealtime(); const unsigned want = 8u * (unsigned)ntn;
            for (;;) {
                if ((unsigned)__builtin_amdgcn_readfirstlane(__hip_atomic_load(cnt + 64 * u.pm, __ATOMIC_RELAXED, __HIP_MEMORY_SCOPE_AGENT)) >= want) break;
                if (__builtin_amdgcn_s_memrealtime() - t0 > 2000000ull) {
                    if (lane == 0) { unsigned expect = 0u; __hip_atomic_compare_exchange_strong(tmo + 1, &expect, code | (unsigned)(u.pm & 0xff), __ATOMIC_RELAXED, __ATOMIC_RELAXED, __HIP_MEMORY_SCOPE_AGENT);
                                     __hip_atomic_store(tmo, 1u, __ATOMIC_RELAXED, __HIP_MEMORY_SCOPE_AGENT); }
                    dead = true; break; }
                __builtin_amdgcn_s_sleep(2);
            }
            __builtin_amdgcn_fence(__ATOMIC_ACQUIRE, "agent");
            if (lane == 0) flag[0] = dead ? 1u : 0u;
        }
        asm volatile("s_waitcnt vmcnt(0) lgkmcnt(0)" ::: "memory"); __builtin_amdgcn_s_barrier(); asm volatile("" ::: "memory");
        const bool bad = flag[0] != 0u;
        if (lane < 32) {
            const unsigned long long* slot = (const unsigned long long*)xbuf + (size_t)(u.pm * BM + row) * 4; float mt[4], m2[4]; float ms = 0.f;
#pragma unroll
            for (int t = 0; t < 4; ++t) { if (t < ntn) { const unsigned long long w = __hip_atomic_load(slot + t, __ATOMIC_RELAXED, __HIP_MEMORY_SCOPE_AGENT); mt[t] = __uint_as_float((unsigned)w); m2[t] = __uint_as_float((unsigned)(w >> 32)); } else { mt[t] = 0.f; m2[t] = 0.f; } ms += mt[t]; }
            const float mean = ms / (float)ntn; float q = 0.f;
#pragma unroll
            for (int t = 0; t < 4; ++t) if (t < ntn) { const float dm = mt[t] - mean; q += m2[t] + 256.0f * dm * dm; }
            S[row] = (f32x2v){mean, 1.0f / sqrtf(q / (256.0f * (float)ntn) + eps)};
        }
        asm volatile("s_waitcnt lgkmcnt(0)" ::: "memory"); __builtin_amdgcn_s_barrier(); asm volatile("" ::: "memory");
        return bad;
    }
};
template <bool RES_F32>
struct EpiLN {
    static constexpr bool PERM = true, AFTER_DRAIN = true;
    const float* resf; const half_t* resh; half_t* out; const float* gam; const float* bet; PanelStats st;
    __device__ __forceinline__ void fused(f32x4 (&acc)[2][2][4][2], const Unit& u, int wr, int wc, int fr, int fq, LAS unsigned char* lds, int wid, int lane) const {
        typedef float f32x2v __attribute__((ext_vector_type(2)));
        const LAS f32x2v* S = (const LAS f32x2v*)(lds + 8192);
        const int col0 = u.pn * BM + wc * 32 + 8 * fq;
#pragma unroll
        for (int ai = 0; ai < 2; ++ai)
#pragma unroll
            for (int m = 0; m < 4; ++m) { const size_t off = (size_t)(u.pm * BM + ai * HALF + wr * 64 + m * 16 + fr) * DM + col0;
#pragma unroll
                for (int bj = 0; bj < 2; ++bj) { f32x4 r0, r1;
                    if (RES_F32) { r0 = *(const f32x4*)(resf + off + bj * HALF); r1 = *(const f32x4*)(resf + off + bj * HALF + 4); }
                    else { const h8_t hh = *(const h8_t*)(resh + off + bj * HALF); r0 = (f32x4){(float)hh[0], (float)hh[1], (float)hh[2], (float)hh[3]}; r1 = (f32x4){(float)hh[4], (float)hh[5], (float)hh[6], (float)hh[7]}; }
                    acc[ai][bj][m][0] += r0 * ALPHA; acc[ai][bj][m][1] += r1 * ALPHA; }
                asm volatile("" : "+v"(acc[ai][0][m][0]), "+v"(acc[ai][0][m][1]), "+v"(acc[ai][1][m][0]), "+v"(acc[ai][1][m][1]));
                if (m & 1) asm volatile("" ::: "memory"); }
        const bool bad = st.run(acc, u, wr, wc, fr, fq, lds, wid, lane);
        f32x4 gv[2][2], bv[2][2];
#pragma unroll
        for (int bj = 0; bj < 2; ++bj)
#pragma unroll
            for (int n = 0; n < 2; ++n) { gv[bj][n] = *(const f32x4*)(gam + col0 + bj * HALF + 4 * n); bv[bj][n] = *(const f32x4*)(bet + col0 + bj * HALF + 4 * n); }
#pragma unroll
        for (int ai = 0; ai < 2; ++ai)
#pragma unroll
            for (int m = 0; m < 4; ++m) { const int r = ai * HALF + wr * 64 + m * 16 + fr; const f32x2v sr = S[r]; const size_t off = (size_t)(u.pm * BM + r) * DM + col0;
#pragma unroll
                for (int bj = 0; bj < 2; ++bj) { const f32x4 o0 = (acc[ai][bj][m][0] - sr.x) * sr.y * gv[bj][0] + bv[bj][0], o1 = (acc[ai][bj][m][1] - sr.x) * sr.y * gv[bj][1] + bv[bj][1];
                    u4_t w; w.x = pkh(o0[0], o0[1]); w.y = pkh(o0[2], o0[3]); w.z = pkh(o1[0], o1[1]); w.w = pkh(o1[2], o1[3]);
                    if (bad) { w.x = 0x7e007e00u; w.y = 0x7e007e00u; w.z = 0x7e007e00u; w.w = 0x7e007e00u; }
                    *(u4_t*)(out + off + bj * HALF) = w; } }
    }
};

struct EpiSoftmax {
    static constexpr bool PERM = true, AFTER_DRAIN = false;
    half_t* PXo; LAS unsigned char* xl;
    static constexpr int NVM = 16; __device__ __forceinline__ bool nvm_ok(const Unit&) const { return true; }
    __device__ __forceinline__ void operator()(f32x4 (&acc)[2][2][4][2], const Unit& u, int wr, int wc, int fr, int fq) const {
        typedef float f32x2v __attribute__((ext_vector_type(2)));
        LAS f32x2v* X = (LAS f32x2v*)xl;
        float mxs[2][4];
#pragma unroll
        for (int ai = 0; ai < 2; ++ai)
#pragma unroll
            for (int m = 0; m < 4; ++m) {
                float mx = -INFINITY;
#pragma unroll
                for (int bj = 0; bj < 2; ++bj)
#pragma unroll
                    for (int n = 0; n < 2; ++n) { const f32x4 x = acc[ai][bj][m][n]; mx = fmaxf(mx, fmaxf(fmaxf(x[0], x[1]), fmaxf(x[2], x[3]))); }
                mx = fmaxf(mx, __shfl_xor(mx, 16)); mx = fmaxf(mx, __shfl_xor(mx, 32));
                float sm = 0.f;
#pragma unroll
                for (int bj = 0; bj < 2; ++bj)
#pragma unroll
                    for (int n = 0; n < 2; ++n) { f32x4 x = acc[ai][bj][m][n];
#pragma unroll
                        for (int i = 0; i < 4; ++i) { x[i] = __builtin_amdgcn_exp2f(x[i] - mx); sm += x[i]; }
                        acc[ai][bj][m][n] = x; }
                sm += __shfl_xor(sm, 16); sm += __shfl_xor(sm, 32);
                mxs[ai][m] = mx;
                if (fq == 0) X[(ai * HALF + wr * 64 + m * 16 + fr) * 4 + wc] = (f32x2v){mx, sm};
            }
        asm volatile("s_waitcnt lgkmcnt(0)" ::: "memory"); __builtin_amdgcn_s_barrier(); asm volatile("" ::: "memory");
        const int row0 = u.pm * BM + wr * 64 + fr, col0 = u.pn * BM + wc * 32 + 8 * fq;
#pragma unroll
        for (int ai = 0; ai < 2; ++ai)
#pragma unroll
            for (int m = 0; m < 4; ++m) { const int r = ai * HALF + wr * 64 + m * 16 + fr;
                const f32x2v a = X[r * 4 + 0], b = X[r * 4 + 1], c = X[r * 4 + 2], d = X[r * 4 + 3];
                const float M = fmaxf(fmaxf(a.x, b.x), fmaxf(c.x, d.x));
                const float tot = a.y * __builtin_amdgcn_exp2f(a.x - M) + b.y * __builtin_amdgcn_exp2f(b.x - M) + c.y * __builtin_amdgcn_exp2f(c.x - M) + d.y * __builtin_amdgcn_exp2f(d.x - M);
                const float f = __builtin_amdgcn_exp2f(mxs[ai][m] - M) / tot;
                half_t* rowp = PXo + (size_t)(row0 + ai * HALF + m * 16) * DM + col0;
#pragma unroll
                for (int bj = 0; bj < 2; ++bj) { const f32x4 v0 = acc[ai][bj][m][0] * f, v1 = acc[ai][bj][m][1] * f;
                    u4_t w; w.x = pkh(v0[0], v0[1]); w.y = pkh(v0[2], v0[3]); w.z = pkh(v1[0], v1[1]); w.w = pkh(v1[2], v1[3]);
                    *(u4_t*)(rowp + bj * HALF) = w; } }
        asm volatile("s_waitcnt lgkmcnt(0)" ::: "memory"); __builtin_amdgcn_s_barrier(); asm volatile("" ::: "memory");
    }
};

struct GTProb {
    static constexpr bool GATHER = false;
    const half_t* KXp; const half_t* WQSp; int K, pad;
    __device__ __forceinline__ const char* a_ptr(const Unit& u) const { return (const char*)(KXp + (size_t)(u.pm >> 2) * 256 * 1024 + (u.pm & 3) * 256); }
    __device__ __forceinline__ const char* b_ptr(const Unit& u) const { return (const char*)(WQSp + (size_t)u.pn * 256 * 1024 + (u.pm & 3) * 256); }
    __device__ __forceinline__ unsigned a_row_off(const Unit&, int r) const { return (unsigned)(r * 1024) * 2u; }
    __device__ __forceinline__ int ldb_of() const { return 1024; }
};
struct VWProb {
    static constexpr bool GATHER = false;
    const half_t* WXOp; const half_t* VXp; int K, pad;
    __device__ __forceinline__ const char* a_ptr(const Unit& u) const { return (const char*)(WXOp + (size_t)u.pm * 256 * 1024 + (u.pn & 3) * 256); }
    __device__ __forceinline__ const char* b_ptr(const Unit& u) const { return (const char*)(VXp + (size_t)(u.pn >> 2) * 256 * 1024 + (u.pn & 3) * 256); }
    __device__ __forceinline__ unsigned a_row_off(const Unit&, int r) const { return (unsigned)(r * 1024) * 2u; }
    __device__ __forceinline__ int ldb_of() const { return 1024; }
};
struct EpiSoftmaxFold {
    static constexpr bool PERM = true, AFTER_DRAIN = false, PREFETCH = true;
    half_t* PXo; LAS unsigned char* xl; const float* UB; LAS unsigned char* mr; LAS unsigned char* side; float scale; int pad;
    static constexpr int NVM = 16; __device__ __forceinline__ bool nvm_ok(const Unit&) const { return true; }
    __device__ __forceinline__ void prefetch(const Unit& u, int tid, int wid) const {
        const int bh = (u.pm >> 4) * 4 + u.pn; const float* uc = (tid < 256) ? UB + bh * 256 + tid : UB + 16384 + bh * 256 + (tid - 256);
        __builtin_amdgcn_global_load_lds((const unsigned*)uc, (LAS unsigned*)(side + wid * 256), 4, 0, 0); }
    __device__ __forceinline__ void operator()(f32x4 (&acc)[2][2][4][2], const Unit& u, int wr, int wc, int fr, int fq) const {
        typedef float f32x2v __attribute__((ext_vector_type(2)));
        LAS f32x2v* X = (LAS f32x2v*)xl;
        f32x4 uv[2][2], cv[2][2];
#pragma unroll
        for (int bj = 0; bj < 2; ++bj)
#pragma unroll
            for (int n = 0; n < 2; ++n) { const int cl = wc * 32 + 8 * fq + bj * HALF + 4 * n; uv[bj][n] = *(const LAS f32x4*)(side + cl * 4); cv[bj][n] = *(const LAS f32x4*)(side + 1024 + cl * 4); }
        float mxs[2][4];
#pragma unroll
        for (int ai = 0; ai < 2; ++ai)
#pragma unroll
            for (int m = 0; m < 4; ++m) { const int r = ai * HALF + wr * 64 + m * 16 + fr; const f32x2v t = ((const LAS f32x2v*)mr)[u.rb * 256 + r];
                const float a = t.y * scale, bc = -t.y * t.x * scale;
                float mx = -INFINITY;
#pragma unroll
                for (int bj = 0; bj < 2; ++bj)
#pragma unroll
                    for (int n = 0; n < 2; ++n) { const f32x4 x = acc[ai][bj][m][n] * a + uv[bj][n] * bc + cv[bj][n] * scale; acc[ai][bj][m][n] = x; mx = fmaxf(mx, fmaxf(fmaxf(x[0], x[1]), fmaxf(x[2], x[3]))); }
                mx = fmaxf(mx, __shfl_xor(mx, 16)); mx = fmaxf(mx, __shfl_xor(mx, 32));
                float sm = 0.f;
#pragma unroll
                for (int bj = 0; bj < 2; ++bj)
#pragma unroll
                    for (int n = 0; n < 2; ++n) { f32x4 x = acc[ai][bj][m][n];
#pragma unroll
                        for (int i = 0; i < 4; ++i) { x[i] = __builtin_amdgcn_exp2f(x[i] - mx); sm += x[i]; }
                        acc[ai][bj][m][n] = x; }
                sm += __shfl_xor(sm, 16); sm += __shfl_xor(sm, 32);
                mxs[ai][m] = mx;
                if (fq == 0) X[r * 4 + wc] = (f32x2v){mx, sm};
            }
        asm volatile("s_waitcnt lgkmcnt(0)" ::: "memory"); __builtin_amdgcn_s_barrier(); asm volatile("" ::: "memory");
        const int row0 = u.pm * BM + wr * 64 + fr, col0 = u.pn * BM + wc * 32 + 8 * fq;
#pragma unroll
        for (int ai = 0; ai < 2; ++ai)
#pragma unroll
            for (int m = 0; m < 4; ++m) { const int r = ai * HALF + wr * 64 + m * 16 + fr;
                const f32x2v a = X[r * 4 + 0], b = X[r * 4 + 1], c = X[r * 4 + 2], d = X[r * 4 + 3];
                const float M = fmaxf(fmaxf(a.x, b.x), fmaxf(c.x, d.x));
                const float tot = a.y * __builtin_amdgcn_exp2f(a.x - M) + b.y * __builtin_amdgcn_exp2f(b.x - M) + c.y * __builtin_amdgcn_exp2f(c.x - M) + d.y * __builtin_amdgcn_exp2f(d.x - M);
                const float f = __builtin_amdgcn_exp2f(mxs[ai][m] - M) / tot;
                half_t* rowp = PXo + (size_t)(row0 + ai * HALF + m * 16) * DM + col0;
#pragma unroll
                for (int bj = 0; bj < 2; ++bj) { const f32x4 v0 = acc[ai][bj][m][0] * f, v1 = acc[ai][bj][m][1] * f;
                    u4_t w; w.x = pkh(v0[0], v0[1]); w.y = pkh(v0[2], v0[3]); w.z = pkh(v1[0], v1[1]); w.w = pkh(v1[2], v1[3]);
                    *(u4_t*)(rowp + bj * HALF) = w; } }
        asm volatile("s_waitcnt lgkmcnt(0)" ::: "memory"); __builtin_amdgcn_s_barrier(); asm volatile("" ::: "memory");
    }
};

struct MoeOrder {
    LAS int* tab; int nun, total;
    __device__ __forceinline__ void init(const unsigned* cnt, int G, int c, LAS unsigned char* lds_tab) {
        tab = (LAS int*)lds_tab;
        if (threadIdx.x == 0) {
            int tot = 0; for (int e = 0; e < NEXP; ++e) tot += (((int)cnt[e] + 255) >> 8) * 4;
            int n = 0;
            for (int i = 0; i < 12; ++i) { const long L = (long)i * G + c; if (L >= tot) break;
                int wgid = (int)L; { const int q = tot / NXCD, r = tot % NXCD, xcd = wgid % NXCD, off = wgid / NXCD; wgid = (xcd < r ? xcd * (q + 1) : r * (q + 1) + (xcd - r) * q) + off; }
                int e = 0, start = 0, rb = 0;
                for (; e < NEXP; ++e) { const int nt = (((int)cnt[e] + 255) >> 8); if (wgid < start + nt * 4) break; start += nt * 4; rb += nt * 256; }
                const int r = wgid - start; tab[i * 8 + 0] = r >> 2; tab[i * 8 + 1] = r & 3; tab[i * 8 + 2] = e; tab[i * 8 + 3] = rb + (r >> 2) * 256; tab[i * 8 + 4] = (int)cnt[e]; n = i + 1; }
            tab[126] = n; tab[127] = tot; }
        __syncthreads();
        nun = __builtin_amdgcn_readfirstlane(tab[126]); total = __builtin_amdgcn_readfirstlane(tab[127]);
    }
    __device__ __forceinline__ bool next(int i, Unit& u) const {
        if (i >= nun) return false;
        u.pm = __builtin_amdgcn_readfirstlane(tab[i * 8 + 0]); u.pn = __builtin_amdgcn_readfirstlane(tab[i * 8 + 1]); u.z = __builtin_amdgcn_readfirstlane(tab[i * 8 + 2]);
        u.rb = __builtin_amdgcn_readfirstlane(tab[i * 8 + 3]); u.aux = __builtin_amdgcn_readfirstlane(tab[i * 8 + 4]); return true;
    }
};
struct GUProb {
    static constexpr bool GATHER = true;
    const half_t* H2p; const half_t* W; const unsigned* cnt; const int* ltok; LAS unsigned char* itab; int K, pad;
    __device__ __forceinline__ void prefetch_idx(const Unit& u, int tid, int wid) const { if (wid < 4) __builtin_amdgcn_global_load_lds((const unsigned*)(ltok + (size_t)u.z * LCAP + u.pm * BM) + tid, (LAS unsigned*)(itab + wid * 256), 4, 0, 0); }
    __device__ __forceinline__ unsigned a_row_off_lds(const Unit& u, int r) const { const int idx = u.pm * BM + r; const int tk = (idx < u.aux) ? (((const LAS int*)itab)[r] >> 1) : 0; return (unsigned)tk * 2048u; }
    __device__ __forceinline__ const char* a_ptr(const Unit&) const { return (const char*)H2p; }
    __device__ __forceinline__ const char* b_ptr(const Unit& u) const { return (const char*)(W + ((size_t)u.z * 1024 + (size_t)u.pn * BM) * 1024); }
    __device__ __forceinline__ unsigned a_row_off(const Unit& u, int r) const { const int idx = u.pm * BM + r; const int tk = (idx < u.aux) ? (ltok[(size_t)u.z * LCAP + idx] >> 1) : 0; return (unsigned)tk * 2048u; }
    __device__ __forceinline__ int ldb_of() const { return 1024; }
};
struct EpiGU {
    static constexpr bool PERM = true, AFTER_DRAIN = false;
    static constexpr bool PREFETCH = true;
    half_t* ACTo; const float* U; const float* Cc; const float* lmr; LAS unsigned char* side;
    static constexpr int NVM = 16; __device__ __forceinline__ bool nvm_ok(const Unit&) const { return true; }
    __device__ __forceinline__ void prefetch(const Unit& u, int tid, int wid) const {
        __builtin_amdgcn_global_load_lds((const unsigned*)(lmr + ((size_t)u.z * LCAP + u.pm * BM) * 2) + tid, (LAS unsigned*)(side + wid * 256), 4, 0, 0);
        const float* uc = (tid < 256) ? U + u.z * 1024 + u.pn * BM + tid : Cc + u.z * 1024 + u.pn * BM + (tid - 256);
        __builtin_amdgcn_global_load_lds((const unsigned*)uc, (LAS unsigned*)(side + 2048 + wid * 256), 4, 0, 0); }
    __device__ __forceinline__ void operator()(f32x4 (&acc)[2][2][4][2], const Unit& u, int wr, int wc, int fr, int fq) const {
        typedef float f32x2v __attribute__((ext_vector_type(2)));
        asm volatile("" : "+v"(fr), "+v"(fq));
        const int row0 = u.rb + wr * 64 + fr, colI = u.pn * BM + wc * 32 + 8 * fq, col0 = colI >> 1;
        f32x4 uv[2][2], cv[2][2];
#pragma unroll
        for (int bj = 0; bj < 2; ++bj)
#pragma unroll
            for (int n = 0; n < 2; ++n) { const int cl = wc * 32 + 8 * fq + bj * HALF + 4 * n; uv[bj][n] = *(const LAS f32x4*)(side + 2048 + cl * 4); cv[bj][n] = *(const LAS f32x4*)(side + 3072 + cl * 4); }
#pragma unroll
        for (int ai = 0; ai < 2; ++ai)
#pragma unroll
            for (int m = 0; m < 4; ++m) { const int rl = wr * 64 + fr + ai * HALF + m * 16; half_t* rowp = ACTo + (size_t)(u.rb + rl) * DEXP + col0;
                const f32x2v t = ((const LAS f32x2v*)side)[rl];
                const float a = t.y, bc = -t.y * t.x;
#pragma unroll
                for (int bj = 0; bj < 2; ++bj) { const f32x4 v0 = acc[ai][bj][m][0] * a + uv[bj][0] * bc + cv[bj][0], v1 = acc[ai][bj][m][1] * a + uv[bj][1] * bc + cv[bj][1];
                    const float a0 = v0[0] * __builtin_amdgcn_rcpf(1.f + __builtin_amdgcn_exp2f(-LOG2E * v0[0])) * v0[1], a1 = v0[2] * __builtin_amdgcn_rcpf(1.f + __builtin_amdgcn_exp2f(-LOG2E * v0[2])) * v0[3];
                    const float a2 = v1[0] * __builtin_amdgcn_rcpf(1.f + __builtin_amdgcn_exp2f(-LOG2E * v1[0])) * v1[1], a3 = v1[2] * __builtin_amdgcn_rcpf(1.f + __builtin_amdgcn_exp2f(-LOG2E * v1[2])) * v1[3];
                    *(unsigned long long*)(rowp + bj * (HALF / 2)) = (unsigned long long)pkh(a0, a1) | ((unsigned long long)pkh(a2, a3) << 32); } }
        (void)row0;
    }
};
struct DownProb {
    static constexpr bool GATHER = false;
    const half_t* ACTp; const half_t* W; int K, pad;
    __device__ __forceinline__ const char* a_ptr(const Unit& u) const { return (const char*)(ACTp + (size_t)u.rb * DEXP); }
    __device__ __forceinline__ const char* b_ptr(const Unit& u) const { return (const char*)(W + ((size_t)u.z * 1024 + (size_t)u.pn * BM) * DEXP); }
    __device__ __forceinline__ unsigned a_row_off(const Unit&, int r) const { return (unsigned)(r * DEXP) * 2u; }
    __device__ __forceinline__ int ldb_of() const { return DEXP; }
};
struct EpiDown {
    static constexpr bool PERM = true, AFTER_DRAIN = false;
    static constexpr bool PREFETCH = true;
    half_t* Yo; const unsigned* cnt; const int* ltok; const float* lw; LAS unsigned char* side;
    static constexpr int NVM = 16; __device__ __forceinline__ bool nvm_ok(const Unit& u) const { return (u.pm + 1) * BM <= u.aux; }
    __device__ __forceinline__ void prefetch(const Unit& u, int tid, int wid) const {
        const unsigned* src = (tid < 256) ? (const unsigned*)(ltok + (size_t)u.z * LCAP + u.pm * BM) + tid : (const unsigned*)(lw + (size_t)u.z * LCAP + u.pm * BM) + (tid - 256);
        __builtin_amdgcn_global_load_lds(src, (LAS unsigned*)(side + wid * 256), 4, 0, 0); }
    __device__ __forceinline__ void operator()(f32x4 (&acc)[2][2][4][2], const Unit& u, int wr, int wc, int fr, int fq) const {
        const int idx0 = u.pm * BM + wr * 64 + fr, col0 = u.pn * BM + wc * 32 + 8 * fq, ce = u.aux;
#pragma unroll
        for (int ai = 0; ai < 2; ++ai)
#pragma unroll
            for (int m = 0; m < 4; ++m) { const int idx = idx0 + ai * HALF + m * 16;
                if (idx < ce) { const int rl = idx - u.pm * BM; const int t2 = ((const LAS int*)side)[rl]; const float g = ((const LAS float*)(side + 1024))[rl]; half_t* rowp = Yo + (size_t)t2 * DM + col0;
#pragma unroll
                    for (int bj = 0; bj < 2; ++bj) { const f32x4 v0 = acc[ai][bj][m][0] * g, v1 = acc[ai][bj][m][1] * g;
                        u4_t w; w.x = pkh(v0[0], v0[1]); w.y = pkh(v0[2], v0[3]); w.z = pkh(v1[0], v1[1]); w.w = pkh(v1[2], v1[3]);
                        *(u4_t*)(rowp + bj * HALF) = w; } } }
    }
};

template <int RESM>
struct EpiV {
    static constexpr bool PERM = true, AFTER_DRAIN = false;
    const half_t* res; half_t* V; float* ST; const float* g; const float* b; LAS unsigned char* mr;
    static constexpr int NVM = 40; __device__ __forceinline__ bool nvm_ok(const Unit&) const { return true; }
    __device__ __forceinline__ void operator()(f32x4 (&acc)[2][2][4][2], const Unit& u, int wr, int wc, int fr, int fq) const {
        typedef float f32x2v __attribute__((ext_vector_type(2)));
        const int col0 = u.pn * BM + wc * 32 + 8 * fq;
        f32x4 gv[2][2], bv[2][2];
        if (RESM == 1) {
#pragma unroll
            for (int bj = 0; bj < 2; ++bj)
#pragma unroll
                for (int n = 0; n < 2; ++n) { gv[bj][n] = *(const f32x4*)(g + col0 + bj * HALF + 4 * n); bv[bj][n] = *(const f32x4*)(b + col0 + bj * HALF + 4 * n); } }
#pragma unroll
        for (int ai = 0; ai < 2; ++ai) {
            h8_t hh[4][2];
#pragma unroll
            for (int m = 0; m < 4; ++m)
#pragma unroll
                for (int bj = 0; bj < 2; ++bj) hh[m][bj] = *(const h8_t*)(res + (size_t)(u.pm * BM + ai * HALF + wr * 64 + m * 16 + fr) * DM + col0 + bj * HALF);
#pragma unroll
            for (int m = 0; m < 4; ++m) { const int r = ai * HALF + wr * 64 + m * 16 + fr; const int row = u.pm * BM + r; const size_t off = (size_t)row * DM + col0;
                float mean = 0.f, rstd = 1.f;
                if (RESM == 1) { const f32x2v t = ((const LAS f32x2v*)mr)[u.rb * 256 + r]; mean = t.x; rstd = t.y; }
                float sm = 0.f, sq = 0.f;
#pragma unroll
                for (int bj = 0; bj < 2; ++bj) { const h8_t h = hh[m][bj];
                    f32x4 r0 = (f32x4){(float)h[0], (float)h[1], (float)h[2], (float)h[3]}, r1 = (f32x4){(float)h[4], (float)h[5], (float)h[6], (float)h[7]};
                    if (RESM == 1) { r0 = (r0 - mean) * rstd * gv[bj][0] + bv[bj][0]; r1 = (r1 - mean) * rstd * gv[bj][1] + bv[bj][1]; }
                    const f32x4 v0 = acc[ai][bj][m][0] + r0 * ALPHA, v1 = acc[ai][bj][m][1] + r1 * ALPHA;
                    u4_t w; w.x = pkh(v0[0], v0[1]); w.y = pkh(v0[2], v0[3]); w.z = pkh(v1[0], v1[1]); w.w = pkh(v1[2], v1[3]);
                    *(u4_t*)(V + off + bj * HALF) = w;
                    sm += (v0[0] + v0[1]) + (v0[2] + v0[3]) + (v1[0] + v1[1]) + (v1[2] + v1[3]);
                    sq += (v0[0] * v0[0] + v0[1] * v0[1]) + (v0[2] * v0[2] + v0[3] * v0[3]) + (v1[0] * v1[0] + v1[1] * v1[1]) + (v1[2] * v1[2] + v1[3] * v1[3]); }
                sm += __shfl_xor(sm, 16); sm += __shfl_xor(sm, 32); sq += __shfl_xor(sq, 16); sq += __shfl_xor(sq, 32);
                if (fq == 0) *(f32x2v*)(ST + ((size_t)row * 16 + u.pn * 4 + wc) * 2) = (f32x2v){sm, sq}; }
            asm volatile("" ::: "memory"); }
    }
};
struct EpiFold {
    static constexpr bool PERM = true, AFTER_DRAIN = false;
    static constexpr bool PREFETCH = true;
    half_t* C; const float* U; const float* Cc; LAS unsigned char* mr; LAS unsigned char* side; float scale; int pad;
    static constexpr int NVM = 16; __device__ __forceinline__ bool nvm_ok(const Unit&) const { return true; }
    __device__ __forceinline__ void prefetch(const Unit& u, int tid, int wid) const {
        const float* uc = (tid < 256) ? U + u.pn * BM + tid : Cc + u.pn * BM + (tid - 256);
        __builtin_amdgcn_global_load_lds((const unsigned*)uc, (LAS unsigned*)(side + wid * 256), 4, 0, 0); }
    __device__ __forceinline__ void operator()(f32x4 (&acc)[2][2][4][2], const Unit& u, int wr, int wc, int fr, int fq) const {
        typedef float f32x2v __attribute__((ext_vector_type(2)));
        const int col0 = u.pn * BM + wc * 32 + 8 * fq;
        f32x4 uv[2][2], cv[2][2];
#pragma unroll
        for (int bj = 0; bj < 2; ++bj)
#pragma unroll
            for (int n = 0; n < 2; ++n) { const int cl = wc * 32 + 8 * fq + bj * HALF + 4 * n; uv[bj][n] = *(const LAS f32x4*)(side + cl * 4); cv[bj][n] = *(const LAS f32x4*)(side + 1024 + cl * 4); }
#pragma unroll
        for (int ai = 0; ai < 2; ++ai)
#pragma unroll
            for (int m = 0; m < 4; ++m) { const int r = ai * HALF + wr * 64 + m * 16 + fr; const f32x2v t = ((const LAS f32x2v*)mr)[u.rb * 256 + r];
                const float a = t.y, bc = -t.y * t.x; half_t* rowp = C + (size_t)(u.pm * BM + r) * DM + col0;
#pragma unroll
                for (int bj = 0; bj < 2; ++bj) { const f32x4 v0 = (acc[ai][bj][m][0] * a + uv[bj][0] * bc + cv[bj][0]) * scale, v1 = (acc[ai][bj][m][1] * a + uv[bj][1] * bc + cv[bj][1]) * scale;
                    u4_t w; w.x = pkh(v0[0], v0[1]); w.y = pkh(v0[2], v0[3]); w.z = pkh(v1[0], v1[1]); w.w = pkh(v1[2], v1[3]);
                    *(u4_t*)(rowp + bj * HALF) = w; } }
    }
};
template <class Sched>
__device__ __forceinline__ void row_tables(const Sched& S, const float* ST, LAS unsigned char* mr) {
    typedef float f32x2v __attribute__((ext_vector_type(2)));
    const int tid = threadIdx.x, i = tid >> 8, r = tid & 255; Unit u;
    if (S.next(i, u)) { const f32x4* p = (const f32x4*)(ST + ((size_t)(u.pm * BM + r) * 16) * 2); float sm = 0.f, sq = 0.f;
#pragma unroll
        for (int k = 0; k < 8; ++k) { const f32x4 t = p[k]; sm += t[0] + t[2]; sq += t[1] + t[3]; }
        const float mean = sm * (1.f / DM), var = sq * (1.f / DM) - mean * mean;
        ((LAS f32x2v*)mr)[i * 256 + r] = (f32x2v){mean, 1.0f / sqrtf(var + LN_EPS)}; }
    __syncthreads();
}

template <class E, class = void> struct has_prefetch { static constexpr bool value = false; };
template <class E> struct has_prefetch<E, decltype((void)E::PREFETCH)> { static constexpr bool value = E::PREFETCH; };
template <class Prob, class Epi, class Sched, bool ALIGN_EPI, bool RELAX = true>
__device__ __forceinline__ void gemm_phase(LAS unsigned char* lds, const Prob& g, const Sched& S, const Epi& E) {
    const int tid = threadIdx.x, wid = __builtin_amdgcn_readfirstlane(tid >> 6), lane = tid & 63, wr = wid >> 2, wc = wid & 3, fr = lane & 15, fq = lane >> 4;
    const int K = g.K, nt = K / BK;
    int sR[2], sC[2], sRb[2];
#pragma unroll
    for (int i = 0; i < 2; ++i) { stage_rc(tid * 16 + i * 8192, sR[i], sC[i]); sRb[i] = Epi::PERM ? ((sR[i] & ~31) + perm32(sR[i] & 31)) : sR[i]; }
    unsigned voffB[2];
#pragma unroll
    for (int i = 0; i < 2; ++i) voffB[i] = (unsigned)(sRb[i] * g.ldb_of() + sC[i]) * 2u;
    const size_t kstep = (size_t)(BK * 2);
    const size_t hstepB = (size_t)HALF * g.ldb_of() * 2;
    const unsigned ldsw = (unsigned)wid * 1024u;
    const int aoff = lds_byte(wr * 64 + fr, fq * 8), boff = lds_byte(wc * 32 + fr, fq * 8);
#define PG_SA(b, h) (((b) * 2 + (h)) * HTB)
#define PG_SB(b, h) ((4 + (b) * 2 + (h)) * HTB)
#define PG_STAGE(bufoff, gbase, voff) do { _Pragma("unroll") for (int _i = 0; _i < 2; ++_i) \
        __builtin_amdgcn_global_load_lds((const unsigned*)((const char*)(gbase) + (voff)[_i]), (LAS unsigned*)(lds + (bufoff) + ldsw + _i * 8192), 16, 0, 0); } while (0)
#define PG_LDA(dst, b, h) do { _Pragma("unroll") for (int m = 0; m < 4; ++m) _Pragma("unroll") for (int k = 0; k < 2; ++k) dst[m][k] = *(const LAS h8_t*)(lds + PG_SA(b, h) + aoff + m * 2048 + k * 1024); } while (0)
#define PG_LDB(dst, b, h) do { _Pragma("unroll") for (int n = 0; n < 2; ++n) _Pragma("unroll") for (int k = 0; k < 2; ++k) dst[n][k] = *(const LAS h8_t*)(lds + PG_SB(b, h) + boff + n * 2048 + k * 1024); } while (0)
#define PG_MMA(ai, bj, At, Bt) do { __builtin_amdgcn_s_setprio(1); _Pragma("unroll") for (int m = 0; m < 4; ++m) _Pragma("unroll") for (int n = 0; n < 2; ++n) _Pragma("unroll") for (int k = 0; k < 2; ++k) \
        acc[ai][bj][m][n] = __builtin_amdgcn_mfma_f32_16x16x32_f16(Bt[n][k], At[m][k], acc[ai][bj][m][n], 0, 0, 0); __builtin_amdgcn_s_setprio(0); } while (0)
#define PG_WAIT_V(n) asm volatile("s_waitcnt vmcnt(" #n ")" ::: "memory")
#define PG_WAIT_F() do { if constexpr (RELAX) asm volatile("s_cmp_lg_u32 %0, 0\n\ts_cbranch_scc1 1f\n\ts_waitcnt vmcnt(8)\n1:\n\ts_waitcnt vmcnt(%1)" :: "s"(__builtin_amdgcn_readfirstlane(wf)), "n"(8 + Epi::NVM) : "memory", "scc"); else PG_WAIT_V(8); } while (0)
#define PG_WAIT_L(n) asm volatile("s_waitcnt lgkmcnt(" #n ")" ::: "memory")
#define PG_BAR __builtin_amdgcn_s_barrier()
#define PG_SCHED __builtin_amdgcn_sched_barrier(0)
#define PG_VOFFA(dst, u) do { _Pragma("unroll") for (int _h = 0; _h < 2; ++_h) _Pragma("unroll") for (int _i = 0; _i < 2; ++_i) dst[_h][_i] = g.a_row_off(u, _h * HALF + sR[_i]) + (unsigned)sC[_i] * 2u; } while (0)
    Unit cur, nxt; int ui = 0, pnv = 0;
    if (!S.next(0, cur)) return;
    f32x4 acc[2][2][4][2];
#pragma unroll
    for (int a = 0; a < 2; ++a)
#pragma unroll
        for (int b = 0; b < 2; ++b)
#pragma unroll
            for (int m = 0; m < 4; ++m)
#pragma unroll
                for (int n = 0; n < 2; ++n) acc[a][b][m][n] = (f32x4){0.f, 0.f, 0.f, 0.f};
    h8_t At[4][2], B0[2][2], B1[2][2];
    const char* cA = g.a_ptr(cur); const char* cB = g.b_ptr(cur);
    unsigned vA[2][2], nvA[2][2];
    PG_VOFFA(vA, cur);
    PG_STAGE(PG_SB(0, 0), cB, voffB); PG_STAGE(PG_SB(0, 1), cB + hstepB, voffB); PG_STAGE(PG_SA(0, 0), cA, vA[0]); PG_STAGE(PG_SA(0, 1), cA, vA[1]);
    if (wr == 1) PG_BAR;
    PG_WAIT_V(2); PG_BAR;
    PG_STAGE(PG_SB(1, 0), cB + kstep, voffB); PG_STAGE(PG_SA(1, 0), cA + kstep, vA[0]); PG_STAGE(PG_SB(1, 1), cB + hstepB + kstep, voffB); PG_STAGE(PG_SA(1, 1), cA + kstep, vA[1]);
    PG_WAIT_V(8); PG_BAR;
    for (;;) {
        const bool has_next = S.next(ui + 1, nxt);
        const char* nA = has_next ? g.a_ptr(nxt) : cA; const char* nB = has_next ? g.b_ptr(nxt) : cB;
        if constexpr (Prob::GATHER) { if (has_next) g.prefetch_idx(nxt, tid, wid); }
        int wf = (ui > 0) ? pnv : 0;
        for (int t = 0; t < nt; t += 2) {
            const bool last = (t == nt - 2);
            if constexpr (Prob::GATHER) { if (last) {
#pragma unroll
                for (int _h = 0; _h < 2; ++_h)
#pragma unroll
                    for (int _i = 0; _i < 2; ++_i) nvA[_h][_i] = has_next ? g.a_row_off_lds(nxt, _h * HALF + sR[_i]) + (unsigned)sC[_i] * 2u : vA[_h][_i]; } }
            const char* a2 = last ? nA : cA + (size_t)(t + 2) * kstep; const char* b2 = last ? nB : cB + (size_t)(t + 2) * kstep;
            const char* a3 = a2 + kstep; const char* b3 = b2 + kstep;
            unsigned wA[2][2];
#pragma unroll
            for (int _h = 0; _h < 2; ++_h)
#pragma unroll
                for (int _i = 0; _i < 2; ++_i) wA[_h][_i] = (Prob::GATHER && last) ? nvA[_h][_i] : vA[_h][_i];
            if constexpr (has_prefetch<Epi>::value) { if (last) E.prefetch(cur, tid, wid); }
            PG_LDB(B0, 0, 0); PG_LDB(B1, 0, 1); PG_SCHED; PG_LDA(At, 0, 0);
            PG_WAIT_F(); PG_WAIT_L(0); PG_BAR; PG_MMA(0, 0, At, B0); PG_MMA(0, 1, At, B1); PG_BAR; PG_SCHED;
            PG_LDA(At, 0, 1); PG_STAGE(PG_SB(0, 0), b2, voffB); PG_STAGE(PG_SB(0, 1), b2 + hstepB, voffB); PG_STAGE(PG_SA(0, 0), a2, wA[0]);
            PG_WAIT_F(); PG_WAIT_L(0); PG_BAR; PG_MMA(1, 0, At, B0); PG_MMA(1, 1, At, B1); PG_BAR; PG_SCHED;
            PG_LDB(B0, 1, 0); PG_LDB(B1, 1, 1); PG_SCHED; PG_LDA(At, 1, 0); PG_STAGE(PG_SA(0, 1), a2, wA[1]);
            PG_WAIT_F(); PG_WAIT_L(0); PG_BAR; PG_MMA(0, 0, At, B0); PG_MMA(0, 1, At, B1); PG_BAR; PG_SCHED;
            PG_LDA(At, 1, 1); PG_STAGE(PG_SB(1, 0), b3, voffB); PG_STAGE(PG_SB(1, 1), b3 + hstepB, voffB); PG_STAGE(PG_SA(1, 0), a3, wA[0]);
            PG_WAIT_V(8); PG_WAIT_L(0); PG_BAR; PG_MMA(1, 0, At, B0); PG_MMA(1, 1, At, B1); PG_BAR; PG_SCHED;
            PG_STAGE(PG_SA(1, 1), a3, wA[1]);
            if constexpr (RELAX) { wf = 0; asm volatile("" : "+s"(wf)); }
        }
        if constexpr (ALIGN_EPI) { if (wr == 0) PG_BAR; }
        if constexpr (!Epi::AFTER_DRAIN) { E(acc, cur, wr, wc, fr, fq); pnv = E.nvm_ok(cur) ? 1 : 0; }
        if (!has_next) break;
#pragma unroll
        for (int a = 0; a < 2; ++a)
#pragma unroll
            for (int b = 0; b < 2; ++b)
#pragma unroll
                for (int m = 0; m < 4; ++m)
#pragma unroll
                    for (int n = 0; n < 2; ++n) acc[a][b][m][n] = (f32x4){0.f, 0.f, 0.f, 0.f};
        cur = nxt; cA = nA; cB = nB; ++ui;
        if (Prob::GATHER) {
#pragma unroll
            for (int _h = 0; _h < 2; ++_h)
#pragma unroll
                for (int _i = 0; _i < 2; ++_i) vA[_h][_i] = nvA[_h][_i]; }
        if constexpr (ALIGN_EPI) { if (wr == 1) PG_BAR; }
    }
    PG_WAIT_V(0);
    if constexpr (!ALIGN_EPI) { if (wr == 0) PG_BAR; }
    PG_BAR;
    if constexpr (Epi::AFTER_DRAIN) { E.fused(acc, cur, wr, wc, fr, fq, lds, wid, lane); asm volatile("s_waitcnt lgkmcnt(0)" ::: "memory"); PG_BAR; }
#undef PG_SA
#undef PG_SB
#undef PG_STAGE
#undef PG_LDA
#undef PG_LDB
#undef PG_MMA
#undef PG_WAIT_V
#undef PG_WAIT_F
#undef PG_WAIT_L
#undef PG_BAR
#undef PG_SCHED
#undef PG_VOFFA
}
}

namespace attn {
typedef short s16x4 __attribute__((ext_vector_type(4)));
typedef short s16x8 __attribute__((ext_vector_type(8)));
typedef float f32x16 __attribute__((ext_vector_type(16)));
constexpr int NW = 8, QBLK = 32, QB = QBLK * NW, KVBLK = 64;
__device__ __forceinline__ int crow(int r, int hi) { return (r & 3) + 8 * (r >> 2) + 4 * hi; }
#define SBAR() __builtin_amdgcn_sched_barrier(0)
constexpr int NSLOT = 3, SLOTB = 9216;
constexpr int LDS_K = 0, LDS_V = NSLOT * SLOTB, LDS_WS = 2 * NSLOT * SLOTB, LDS_OST = LDS_WS + NW * 64 * 4, LDS_BYTES = LDS_OST + NW * 4096;
constexpr float NEGS = -8192.f;
__device__ __forceinline__ void glds16s(const void* sbase, unsigned voff, unsigned lds_dst) { unsigned keep;
  asm volatile("s_mov_b32 %0, m0\n\ts_mov_b32 m0, %3\n\ts_nop 4\n\tglobal_load_lds_dwordx4 %1, %2\n\ts_mov_b32 m0, %0" : "=&s"(keep) : "v"(voff), "s"(sbase), "s"(lds_dst) : "memory"); }
__device__ __forceinline__ float max3f(float a, float b, float c) { float r; asm("v_max3_f32 %0, %1, %2, %3" : "=v"(r) : "v"(a), "v"(b), "v"(c)); return r; }
__device__ __forceinline__ float max2f(float a, float b) { float r; asm("v_max_f32_e32 %0, %1, %2" : "=v"(r) : "v"(a), "v"(b)); return r; }
__device__ __forceinline__ float fadd_s(float a, float b) { float r; asm("v_add_f32_e32 %0, %1, %2" : "=v"(r) : "v"(a), "v"(b)); return r; }
__device__ __forceinline__ float fsub_s(float a, float b) { float r; asm("v_sub_f32_e32 %0, %1, %2" : "=v"(r) : "v"(a), "v"(b)); return r; }
#define WAIT_BAR(N) asm volatile("s_waitcnt vmcnt(" #N ") lgkmcnt(0)\n\ts_barrier" ::: "memory")
#define MF16(a, b, c) __builtin_amdgcn_mfma_f32_32x32x16_f16(a, b, c, 0, 0, 0)
typedef __attribute__((address_space(3))) const char* lds_cptr;
typedef short v4i16_t __attribute__((ext_vector_type(4)));
__device__ __forceinline__ void kload2(h8_t* kf, lds_cptr kp, int j) { kf[2 * j] = *(const LAS h8_t*)(kp + j * 2048); kf[2 * j + 1] = *(const LAS h8_t*)(kp + j * 2048 + 512); }
__device__ __forceinline__ s16x4 vtr(lds_cptr p) { return __builtin_bit_cast(s16x4, __builtin_amdgcn_ds_read_tr16_b64_v4i16((LAS v4i16_t*)p)); }
__device__ __forceinline__ float rowmax(const f32x16& p0, const f32x16& p1) {
  float a = max3f(p0[0], p0[1], p1[0]), b = max3f(p0[2], p0[3], p1[1]); a = max3f(a, p1[2], p1[3]);
#pragma unroll
  for (int r = 4; r < 16; r += 4) { a = max3f(a, p0[r], p0[r + 1]); b = max3f(b, p0[r + 2], p0[r + 3]); a = max3f(a, p1[r], p1[r + 1]); b = max3f(b, p1[r + 2], p1[r + 3]); }
  const float m = max2f(a, b);
  auto rr = __builtin_amdgcn_permlane32_swap(__float_as_uint(m), __float_as_uint(m), false, false);
  return max2f(__uint_as_float(rr[0]), __uint_as_float(rr[1]));
}
__device__ __forceinline__ void cmask(f32x16& p0, f32x16& p1, int jb, int qrel, int hi) {
  const float NEG = -INFINITY; const int kb = 64 * jb + 4 * hi;
#pragma unroll
  for (int r = 0; r < 16; ++r) { const int kv = kb + (r & 3) + 8 * (r >> 2); if (kv > qrel) p0[r] = NEG; if (kv + 32 > qrel) p1[r] = NEG; }
}
__device__ __forceinline__ void smask(f32x16& p0, f32x16& p1, int kb0, int qrel, int hi) {
  const int kb = kb0 + 4 * hi;
#pragma unroll
  for (int r = 0; r < 16; ++r) { const int kv = kb + (r & 3) + 8 * (r >> 2); if (kv > qrel || qrel - kv > 127) p0[r] = NEGS; if (kv + 32 > qrel || qrel - kv - 32 > 127) p1[r] = NEGS; }
}
__device__ __forceinline__ void pv(f32x16* o, int vb, h8_t pa0, h8_t pa1, h8_t pa2, h8_t pa3) {
#pragma unroll
  for (int d0 = 0; d0 < 2; ++d0) { s16x4 lo[4], hi[4];
#pragma unroll
    for (int ks = 0; ks < 4; ++ks) {
      asm volatile("ds_read_b64_tr_b16 %0,%1 offset:%c2" : "=&v"(lo[ks]) : "v"(vb), "i"(d0 * 4096 + ks * 1024) : "memory");
      asm volatile("ds_read_b64_tr_b16 %0,%1 offset:%c2" : "=&v"(hi[ks]) : "v"(vb), "i"(d0 * 4096 + ks * 1024 + 512) : "memory"); }
    asm volatile("s_waitcnt lgkmcnt(0)" ::: "memory"); SBAR();
#define PK(k) __builtin_bit_cast(h8_t, (s16x8){lo[k][0], lo[k][1], lo[k][2], lo[k][3], hi[k][0], hi[k][1], hi[k][2], hi[k][3]})
    o[d0] = MF16(pa0, PK(0), o[d0]); o[d0] = MF16(pa1, PK(1), o[d0]); o[d0] = MF16(pa2, PK(2), o[d0]); o[d0] = MF16(pa3, PK(3), o[d0]);
#undef PK
  }
}

template <int MODE, int THRL>
__device__ __forceinline__ void attn_unit(int b, int h, int qb, const half_t* Zp, const half_t* BKp, int ts0, const float* CUMp, const float* sinks, half_t* Op, char* shm) {
  int lane; asm volatile("v_mbcnt_lo_u32_b32 %0, -1, 0\n\tv_mbcnt_hi_u32_b32 %0, -1, %0" : "=v"(lane));
  const int r32 = lane & 31, hi = lane >> 5; const int wid = __builtin_amdgcn_readfirstlane(threadIdx.x >> 6);
  const long rowbase = (long)b * SEQ; const int q0 = (MODE == 0) ? qb * QB : qb * 64;
  const int hq = (MODE == 0) ? h : 4 * h + (wid & 3), wrow = (MODE == 0) ? wid * QBLK : (wid >> 2) * QBLK;
  const int qcol = (MODE == 0) ? ZQF + h * 64 : ZQS + hq * 64, kcol = (MODE == 0) ? ZKF + h * 64 : ZKS + h * 64, vcol = (MODE == 0) ? ZVF + h * 64 : ZVS + h * 64;
  const int ocol = (MODE == 0) ? h * 64 : 512 + hq * 64;
  const int tile0 = (MODE == 0) ? ts0 : ((qb - 2 < 0) ? 0 : (qb - 2 > 60) ? 60 : qb - 2);
  const int NT = (MODE == 0) ? 4 * qb + 4 - tile0 : 4;
  const int krel0 = (MODE == 0) ? (tile0 - 4 * qb) * 64 : (tile0 - qb) * 64;
  const half_t* Qw = Zp + (rowbase + q0 + wrow) * ZW + qcol;
  const half_t* Kh = Zp + (rowbase + (long)tile0 * KVBLK) * ZW + kcol; const half_t* Vh = Zp + (rowbase + (long)tile0 * KVBLK) * ZW + vcol;
  const unsigned lds0 = (unsigned)(uintptr_t)shm;
  float* wsf = (float*)(shm + LDS_WS) + wid * 64;
  const unsigned koff = (unsigned)(lane * ZW + wid * 8) * 2u;
  const unsigned voff = (unsigned)((16 * (wid & 3) + (lane >> 2)) * ZW + (wid >> 2) * 32 + (lane & 3) * 8) * 2u;
  const unsigned boff = (unsigned)lane * 16u;
  const half_t* Bh = BKp + ((long)(b * 8 + h) * SEQ + (long)tile0 * KVBLK) * 8;
  const unsigned kdst = lds0 + LDS_K + wid * 1024, vdst = lds0 + LDS_V + wid * 1024, bdst = lds0 + LDS_K + 8192;
#define DMA_K(t, slot) do { glds16s(Kh + (long)(t) * KVBLK * ZW, koff, (unsigned)__builtin_amdgcn_readfirstlane(kdst + (slot))); \
    if (MODE == 0 && wid == 0) glds16s(Bh + (long)(t) * KVBLK * 8, boff, (unsigned)__builtin_amdgcn_readfirstlane(bdst + (slot))); } while (0)
#define DMA_V(t, slot) glds16s(Vh + (long)(t) * KVBLK * ZW, voff, (unsigned)__builtin_amdgcn_readfirstlane(vdst + (slot)))
#define WAITB(N, NB) do { if (MODE == 0 && wid == 0) { WAIT_BAR_N(N + NB); } else { WAIT_BAR_N(N); } } while (0)
#define WAIT_BAR_N(n) do { if ((n) == 0) WAIT_BAR(0); else if ((n) == 1) WAIT_BAR(1); else if ((n) == 2) WAIT_BAR(2); else if ((n) == 3) WAIT_BAR(3); else if ((n) == 4) WAIT_BAR(4); else WAIT_BAR(5); } while (0)
  h8_t kf[10];
  const lds_cptr shm3 = (lds_cptr)shm; const lds_cptr kp0 = shm3 + LDS_K + hi * 1024 + r32 * 16; const lds_cptr kpe = shm3 + LDS_K + 8192 + r32 * 16;
  const lds_cptr vp0 = shm3 + LDS_V + ((lane >> 4) & 1) * 32 + (lane & 3) * 8 + (4 * hi + ((lane & 15) >> 2)) * 64;
  if (MODE == 1 && wid == 0) { const u4_t one_ = (u4_t){0x3C003C00u, 0u, 0u, 0u};
#pragma unroll
    for (int sl = 0; sl < NSLOT; ++sl) *(LAS u4_t*)(shm3 + LDS_K + sl * SLOTB + 8192 + lane * 16) = one_; }
  DMA_K(0, 0); DMA_V(0, 0); DMA_K(1, SLOTB);
  h8_t qr[4];
#pragma unroll
  for (int d0 = 0; d0 < 4; ++d0) qr[d0] = *reinterpret_cast<const h8_t*>(&Qw[(long)r32 * ZW + d0 * 16 + hi * 8]);
  h8_t qe; float mhat = 0.f, l_reg = 0.f; f32x16 o[2]; o[0] = f32x16{}; o[1] = f32x16{};
#define SETQE(TARGET) do { const float nt_ = -(TARGET); const half_t mh_ = (half_t)nt_; const half_t ml_ = (half_t)(nt_ - (float)mh_); mhat = -((float)mh_ + (float)ml_); \
    const unsigned mw_ = (unsigned)__builtin_bit_cast(unsigned short, mh_) | ((unsigned)__builtin_bit_cast(unsigned short, ml_) << 16); \
    u4_t w_; w_.x = (MODE == 0) ? 0x3C003C00u : mw_; w_.y = (MODE == 0) ? mw_ : 0u; w_.z = 0u; w_.w = 0u; if (hi != 0) { w_.x = 0u; w_.y = 0u; } qe = __builtin_bit_cast(h8_t, w_); } while (0)
  if (MODE == 0) { const float bq = -CUMp[(long)(b * 8 + h) * SEQ + q0 + wid * QBLK + r32] * LOG2E; SETQE(bq); } else { SETQE(0.f); }
  const f32x16 zero16 = f32x16{};
  const int qrel = wrow + r32;
#define CMASK(P0, P1, t) do { if (MODE == 0) { int jb_ = (t) - (NT - 4); if (jb_ >= 0) cmask(P0, P1, jb_, qrel, hi); } else smask(P0, P1, krel0 + 64 * (t), qrel, hi); } while (0)
  bool resc = false;
#define START(P0, P1) do { const float rm = rowmax(P0, P1); resc = false; \
    if (MODE == 1 || __any(rm > (float)THRL)) { const float mold_ = mhat; SETQE(mold_ + ((MODE == 1) ? rm : __builtin_fmaxf(rm, 0.f))); const float dl = mhat - mold_; \
      _Pragma("unroll") for (int r = 0; r < 16; ++r) { P0[r] = fsub_s(P0[r], dl); P1[r] = fsub_s(P1[r], dl); } } \
    _Pragma("unroll") for (int r = 0; r < 16; ++r) P0[r] = __builtin_amdgcn_exp2f(P0[r]); } while (0)
#define RESC() do { if (resc) { asm volatile("s_waitcnt lgkmcnt(0)" ::: "memory"); \
      _Pragma("unroll") for (int d_ = 0; d_ < 2; ++d_) _Pragma("unroll") for (int r = 0; r < 16; ++r) o[d_][r] *= wsf[crow(r, hi)]; } } while (0)
  f32x16 pA0, pA1, pB0, pB1;
  int sl_prev = 0, sl_cur = 0, sl_next = SLOTB;
#define ROT() do { sl_prev = sl_cur; sl_cur = sl_next; sl_next = (sl_next == (NSLOT - 1) * SLOTB) ? 0 : sl_next + SLOTB; } while (0)
  DMA_K(2, 2 * SLOTB);
  WAITB(3, 2);
  { const lds_cptr kb = kp0;
#pragma unroll
    for (int d0 = 0; d0 < 4; ++d0) { const h8_t b0 = *(const LAS h8_t*)(kb + d0 * 2048), b1 = *(const LAS h8_t*)(kb + d0 * 2048 + 512);
      if (d0 == 0) { pA0 = MF16(b0, qr[0], zero16); pA1 = MF16(b1, qr[0], zero16); } else { pA0 = MF16(b0, qr[d0], pA0); pA1 = MF16(b1, qr[d0], pA1); } }
    { const h8_t e0 = *(const LAS h8_t*)(kpe), e1 = *(const LAS h8_t*)(kpe + 512); pA0 = MF16(e0, qe, pA0); pA1 = MF16(e1, qe, pA1); } }
  asm volatile("s_nop 15\n\ts_nop 7" : "+v"(pA0), "+v"(pA1)); CMASK(pA0, pA1, 0);
  START(pA0, pA1);
  _Pragma("unroll") for (int r = 0; r < 16; ++r) pA1[r] = __builtin_amdgcn_exp2f(pA1[r]);
  WAIT_BAR(0);
  DMA_K(3, 0); DMA_V(1, SLOTB);
  ROT();
  kload2(kf, kp0 + sl_cur, 0); kload2(kf, kp0 + sl_cur, 1); kload2(kf, kp0 + sl_cur, 2); kload2(kf, kp0 + sl_cur, 3);
  kf[8] = *(const LAS h8_t*)(kpe + sl_cur); kf[9] = *(const LAS h8_t*)(kpe + sl_cur + 512);
  WAITB(2, 1);
  s16x4 vlo[8], vhi[8]; u4_t pw0, pw1, pw2, pw3;
#define PKW(P, B) pkh(P[B], P[B + 1])
#define PAF(k) __builtin_bit_cast(h8_t, pw##k)
#define VFR(i) __builtin_bit_cast(h8_t, (s16x8){vlo[i][0], vlo[i][1], vlo[i][2], vlo[i][3], vhi[i][0], vhi[i][1], vhi[i][2], vhi[i][3]})
#define PIN(x) asm volatile("" : "+v"(x))
#define MX3(a, b, c) __builtin_fmaxf(__builtin_fmaxf((a), (b)), (c))
#define GAPA(MF, A0, A1, A2, A3, W0, W1, PW) do { MF; sacc += A0; sacc += A1; sacc += A2; sacc += A3; PIN(sacc); W0; W1; PIN(PW); SBAR(); } while (0)
#define EX(v) __builtin_amdgcn_exp2f(v)
#define GAPB(MF, X, B) do { MF; X[B] = EX(X[B]); X[B + 1] = EX(X[B + 1]); X[B + 2] = EX(X[B + 2]); X[B + 3] = EX(X[B + 3]); PIN(X); SBAR(); } while (0)
#define VRD(i) do { vlo[i] = vtr(vp_ + (((i) >> 2) * 4096 + ((i) & 3) * 1024)); vhi[i] = vtr(vp_ + (((i) >> 2) * 4096 + ((i) & 3) * 1024 + 512)); } while (0)
#define KRD(G, j) do { if (G) { kload2(kf, kp0 + sl_next, j); SBAR(); } } while (0)
#define KRDE(G) do { if (G) { kf[8] = *(const LAS h8_t*)(kpe + sl_next); kf[9] = *(const LAS h8_t*)(kpe + sl_next + 512); SBAR(); } } while (0)
#define STEP(C0, C1, P0, P1, t, GK, GV, GL) do { SBAR(); \
    const lds_cptr vp_ = vp0 + sl_prev; \
    VRD(0); SBAR(); float sacc = (P0[0] + P0[1]); \
    GAPA(C0 = MF16(kf[0], qr[0], zero16), P0[2], P0[3], P0[4], P0[5],     pw0[0] = PKW(P0, 0), pw0[1] = PKW(P0, 2), pw0); \
    VRD(4); SBAR(); GAPA(C1 = MF16(kf[1], qr[0], zero16), P0[6], P0[7], P0[8], P0[9],     pw0[2] = PKW(P0, 4), pw0[3] = PKW(P0, 6), pw0); \
    VRD(1); SBAR(); GAPA(C0 = MF16(kf[2], qr[1], C0),   P0[10], P0[11], P0[12], P0[13], pw1[0] = PKW(P0, 8), pw1[1] = PKW(P0, 10), pw1); \
    VRD(5); SBAR(); GAPA(C1 = MF16(kf[3], qr[1], C1),   P0[14], P0[15], P1[0], P1[1],   pw1[2] = PKW(P0, 12), pw1[3] = PKW(P0, 14), pw1); \
    VRD(2); SBAR(); GAPA(C0 = MF16(kf[4], qr[2], C0),   P1[2], P1[3], P1[4], P1[5],     pw2[0] = PKW(P1, 0), pw2[1] = PKW(P1, 2), pw2); \
    VRD(6); SBAR(); GAPA(C1 = MF16(kf[5], qr[2], C1),   P1[6], P1[7], P1[8], P1[9],     pw2[2] = PKW(P1, 4), pw2[3] = PKW(P1, 6), pw2); \
    VRD(3); SBAR(); GAPA(C0 = MF16(kf[6], qr[3], C0),   P1[10], P1[11], P1[12], P1[13], pw3[0] = PKW(P1, 8), pw3[1] = PKW(P1, 10), pw3); \
    VRD(7); SBAR(); GAPA(C1 = MF16(kf[7], qr[3], C1),   P1[14], P1[15], 0.f, 0.f,       pw3[2] = PKW(P1, 12), pw3[3] = PKW(P1, 14), pw3); \
    C0 = MF16(kf[8], qe, C0); C1 = MF16(kf[9], qe, C1); SBAR(); \
    l_reg += sacc; \
    if (GK) { DMA_K((t) + 3, sl_cur); } if (GV) { DMA_V((t) + 1, sl_next); } \
    CMASK(C0, C1, t); \
    { float a = MX3(C0[0], C0[1], C1[0]), b = MX3(C0[2], C0[3], C1[1]); a = MX3(a, C1[2], C1[3]); \
      _Pragma("unroll") for (int r = 4; r < 16; r += 4) { a = MX3(a, C0[r], C0[r + 1]); b = MX3(b, C0[r + 2], C0[r + 3]); a = MX3(a, C1[r], C1[r + 1]); b = MX3(b, C1[r + 2], C1[r + 3]); } \
      float rm = __builtin_fmaxf(a, b); { auto rr = __builtin_amdgcn_permlane32_swap(__float_as_uint(rm), __float_as_uint(rm), false, false); rm = __builtin_fmaxf(__uint_as_float(rr[0]), __uint_as_float(rr[1])); } \
      resc = false; \
      if (__builtin_expect(__any(rm > (float)THRL), 0)) { const float mold_ = mhat; SETQE(mold_ + __builtin_fmaxf(rm, 0.f)); const float dl = mhat - mold_; \
        _Pragma("unroll") for (int r = 0; r < 16; ++r) { C0[r] -= dl; C1[r] -= dl; } \
        const float f = __builtin_amdgcn_exp2f(-dl); l_reg *= f; if (hi == 0) wsf[r32] = f; resc = true; } } \
    SBAR(); \
    GAPB(o[0] = MF16(PAF(0), VFR(0), o[0]), C0, 0); \
    GAPB(o[1] = MF16(PAF(0), VFR(4), o[1]), C0, 4); \
    KRD(GL, 0); GAPB(o[0] = MF16(PAF(1), VFR(1), o[0]), C0, 8); \
    KRD(GL, 1); GAPB(o[1] = MF16(PAF(1), VFR(5), o[1]), C0, 12); \
    KRD(GL, 2); GAPB(o[0] = MF16(PAF(2), VFR(2), o[0]), C1, 0); \
    KRD(GL, 3); GAPB(o[1] = MF16(PAF(2), VFR(6), o[1]), C1, 4); \
    KRDE(GL); GAPB(o[0] = MF16(PAF(3), VFR(3), o[0]), C1, 8); \
    GAPB(o[1] = MF16(PAF(3), VFR(7), o[1]), C1, 12); \
    } while (0)
  int t = 1;
  if (MODE == 0) {
#undef CMASK
#define CMASK(P0, P1, t) do { } while (0)
    for (; t + 5 < NT; t += 2) {
      STEP(pB0, pB1, pA0, pA1, t, true, true, true);     WAITB(2, 1); RESC(); ROT();
      STEP(pA0, pA1, pB0, pB1, t + 1, true, true, true); WAITB(2, 1); RESC(); ROT();
    }
#undef CMASK
#define CMASK(P0, P1, t) do { if (MODE == 0) { int jb_ = (t) - (NT - 4); if (jb_ >= 0) cmask(P0, P1, jb_, qrel, hi); } else smask(P0, P1, krel0 + 64 * (t), qrel, hi); } while (0)
  }
#define ENDW(tt) do { if ((tt) + 3 < NT) { WAITB(2, 1); } else if ((tt) + 2 < NT) { WAITB(1, 0); } else { WAIT_BAR(0); } } while (0)
  for (; t + 1 < NT; t += 2) {
    STEP(pB0, pB1, pA0, pA1, t, (t + 3 < NT), (t + 1 < NT), (t + 1 < NT));         ENDW(t);     RESC(); ROT();
    STEP(pA0, pA1, pB0, pB1, t + 1, (t + 4 < NT), (t + 2 < NT), (t + 2 < NT));     ENDW(t + 1); RESC(); ROT();
  }
  STEP(pB0, pB1, pA0, pA1, NT - 1, false, false, false); RESC();
  { float sacc = pB0[0] + pB0[1]; _Pragma("unroll") for (int r = 2; r < 16; ++r) sacc += pB0[r]; _Pragma("unroll") for (int r = 0; r < 16; ++r) sacc += pB1[r]; l_reg += sacc;
    pw0 = (u4_t){PKW(pB0, 0), PKW(pB0, 2), PKW(pB0, 4), PKW(pB0, 6)}; pw1 = (u4_t){PKW(pB0, 8), PKW(pB0, 10), PKW(pB0, 12), PKW(pB0, 14)};
    pw2 = (u4_t){PKW(pB1, 0), PKW(pB1, 2), PKW(pB1, 4), PKW(pB1, 6)}; pw3 = (u4_t){PKW(pB1, 8), PKW(pB1, 10), PKW(pB1, 12), PKW(pB1, 14)};
    SBAR(); pv(o, (int)(unsigned)(uintptr_t)(vp0 + sl_cur), PAF(0), PAF(1), PAF(2), PAF(3)); }
#undef PKW
#undef PAF
#undef VFR
#undef PIN
#undef MX3
#undef GAPA
#undef GAPB
#undef EX
#undef VRD
#undef KRD
#undef KRDE
#undef STEP
#undef ENDW
  { auto rr = __builtin_amdgcn_permlane32_swap(__float_as_uint(l_reg), __float_as_uint(l_reg), false, false); l_reg = __uint_as_float(rr[0]) + __uint_as_float(rr[1]); }
  if (MODE == 1) l_reg += __builtin_amdgcn_exp2f(sinks[hq] * LOG2E - mhat);
  if (hi == 0) wsf[32 + r32] = l_reg; asm volatile("s_waitcnt lgkmcnt(0)" ::: "memory");
  float rli[16];
#pragma unroll
  for (int r = 0; r < 16; ++r) rli[r] = __builtin_amdgcn_rcpf(wsf[32 + crow(r, hi)]);
  half_t* Ow = Op + (rowbase + q0 + wrow) * DM + ocol;
  { half_t* stg = (half_t*)(shm + LDS_OST) + wid * 2048;
#pragma unroll
    for (int r = 0; r < 16; ++r) { const int orow = crow(r, hi);
#pragma unroll
      for (int d0 = 0; d0 < 2; ++d0) stg[orow * 64 + d0 * 32 + r32] = (half_t)(o[d0][r] * rli[r]); }
    asm volatile("s_waitcnt lgkmcnt(0)" ::: "memory");
#pragma unroll
    for (int i = 0; i < 4; ++i) { const int row = i * 8 + (lane >> 3), ch = lane & 7; const u4_t v = *(const u4_t*)(stg + row * 64 + ch * 8); *(u4_t*)(Ow + (long)row * DM + ch * 8) = v; } }
  asm volatile("s_waitcnt lgkmcnt(0)\n\ts_barrier" ::: "memory");
#undef DMA_K
#undef DMA_V
#undef WAITB
#undef WAIT_BAR_N
#undef CMASK
#undef START
#undef RESC
#undef SETQE
#undef ROT
}

template <int NU>
__device__ __forceinline__ void swa_units(int b, int h, int qb0, const half_t* Zp, const float* sinks, half_t* Op, char* shm, LAS unsigned char* wsx) {
  int lane; asm volatile("v_mbcnt_lo_u32_b32 %0, -1, 0\n\tv_mbcnt_hi_u32_b32 %0, -1, %0" : "=v"(lane));
  const int r32 = lane & 31, hi = lane >> 5; const int wid = __builtin_amdgcn_readfirstlane(threadIdx.x >> 6);
  const long rowbase = (long)b * SEQ;
  const int hq = 4 * h + (wid & 3), wrow = (wid >> 2) * QBLK;
  const int qcol = ZQS + hq * 64, kcol = ZKS + h * 64, vcol = ZVS + h * 64, ocol = 512 + hq * 64;
  const unsigned lds0 = (unsigned)(uintptr_t)shm; const lds_cptr shm3 = (lds_cptr)shm;
  const unsigned koff = (unsigned)(lane * ZW + wid * 8) * 2u;
  const unsigned voff = (unsigned)((16 * (wid & 3) + (lane >> 2)) * ZW + (wid >> 2) * 32 + (lane & 3) * 8) * 2u;
  const int vlane = ((lane >> 4) & 1) * 32 + (lane & 3) * 8 + (4 * hi + ((lane & 15) >> 2)) * 64;
  LAS float* wsf = (LAS float*)(wsx + wid * 256);
  const float sinkl = sinks[hq] * LOG2E;
#define SW_T0(qb) (((qb) - 2 < 0) ? 0 : ((qb) - 2 > 61) ? 61 : (qb) - 2)
#define SW_ISSUE(qb, u) do { const int t0_ = SW_T0(qb); _Pragma("unroll") for (int t_ = 0; t_ < 3; ++t_) { \
      glds16s(Zp + (rowbase + (long)(t0_ + t_) * KVBLK) * ZW + kcol, koff, (unsigned)__builtin_amdgcn_readfirstlane(lds0 + ((u) * 6 + t_) * 8192 + wid * 1024)); \
      glds16s(Zp + (rowbase + (long)(t0_ + t_) * KVBLK) * ZW + vcol, voff, (unsigned)__builtin_amdgcn_readfirstlane(lds0 + ((u) * 6 + 3 + t_) * 8192 + wid * 1024)); } } while (0)
#define SW_QLOAD(dst, qb) do { const half_t* qw_ = Zp + (rowbase + (qb) * 64 + wrow) * ZW + qcol; _Pragma("unroll") for (int d0 = 0; d0 < 4; ++d0) dst[d0] = *reinterpret_cast<const h8_t*>(&qw_[(long)r32 * ZW + d0 * 16 + hi * 8]); } while (0)
  h8_t qc[4], qn[4];
  SW_QLOAD(qc, qb0); SW_ISSUE(qb0, 0);
#pragma unroll
  for (int i = 0; i < NU; ++i) {
    const int qb = qb0 + i, u = i & 1;
    if (i + 1 < NU) { SW_QLOAD(qn, qb + 1); SW_ISSUE(qb + 1, u ^ 1); asm volatile("s_waitcnt vmcnt(10)\n\ts_barrier" ::: "memory"); }
    else asm volatile("s_waitcnt vmcnt(0)\n\ts_barrier" ::: "memory");
    const int tile0 = SW_T0(qb), krel0 = (tile0 - qb) * 64, qrel = wrow + r32;
    f32x16 s0[3], s1[3];
#pragma unroll
    for (int t = 0; t < 3; ++t) { const lds_cptr kb = shm3 + (u * 6 + t) * 8192 + hi * 1024 + r32 * 16;
#pragma unroll
      for (int d0 = 0; d0 < 4; ++d0) { const h8_t b0 = *(const LAS h8_t*)(kb + d0 * 2048), b1 = *(const LAS h8_t*)(kb + d0 * 2048 + 512);
        if (d0 == 0) { s0[t] = MF16(b0, qc[0], f32x16{}); s1[t] = MF16(b1, qc[0], f32x16{}); } else { s0[t] = MF16(b0, qc[d0], s0[t]); s1[t] = MF16(b1, qc[d0], s1[t]); } } }
    float m = -INFINITY;
#pragma unroll
    for (int t = 0; t < 3; ++t) { smask(s0[t], s1[t], krel0 + 64 * t, qrel, hi); m = __builtin_fmaxf(m, rowmax(s0[t], s1[t])); }
    float l = 0.f; f32x16 o[2]; o[0] = f32x16{}; o[1] = f32x16{};
#pragma unroll
    for (int t = 0; t < 3; ++t) {
#pragma unroll
      for (int r = 0; r < 16; ++r) { s0[t][r] = __builtin_amdgcn_exp2f(s0[t][r] - m); s1[t][r] = __builtin_amdgcn_exp2f(s1[t][r] - m); l += s0[t][r] + s1[t][r]; }
      const u4_t pw0 = (u4_t){pkh(s0[t][0], s0[t][1]), pkh(s0[t][2], s0[t][3]), pkh(s0[t][4], s0[t][5]), pkh(s0[t][6], s0[t][7])};
      const u4_t pw1 = (u4_t){pkh(s0[t][8], s0[t][9]), pkh(s0[t][10], s0[t][11]), pkh(s0[t][12], s0[t][13]), pkh(s0[t][14], s0[t][15])};
      const u4_t pw2 = (u4_t){pkh(s1[t][0], s1[t][1]), pkh(s1[t][2], s1[t][3]), pkh(s1[t][4], s1[t][5]), pkh(s1[t][6], s1[t][7])};
      const u4_t pw3 = (u4_t){pkh(s1[t][8], s1[t][9]), pkh(s1[t][10], s1[t][11]), pkh(s1[t][12], s1[t][13]), pkh(s1[t][14], s1[t][15])};
      pv(o, (int)(unsigned)(uintptr_t)(shm3 + (u * 6 + 3 + t) * 8192 + vlane), __builtin_bit_cast(h8_t, pw0), __builtin_bit_cast(h8_t, pw1), __builtin_bit_cast(h8_t, pw2), __builtin_bit_cast(h8_t, pw3)); }
    { auto rr = __builtin_amdgcn_permlane32_swap(__float_as_uint(l), __float_as_uint(l), false, false); l = __uint_as_float(rr[0]) + __uint_as_float(rr[1]); }
    l += __builtin_amdgcn_exp2f(sinkl - m);
    if (hi == 0) wsf[32 + r32] = l; asm volatile("s_waitcnt lgkmcnt(0)" ::: "memory");
    float rli[16];
#pragma unroll
    for (int r = 0; r < 16; ++r) rli[r] = __builtin_amdgcn_rcpf(wsf[32 + crow(r, hi)]);
    half_t* Ow = Op + (rowbase + qb * 64 + wrow) * DM + ocol;
    { half_t* stg = (half_t*)(shm + 98304) + wid * 2048;
#pragma unroll
      for (int r = 0; r < 16; ++r) { const int orow = crow(r, hi);
#pragma unroll
        for (int d0 = 0; d0 < 2; ++d0) stg[orow * 64 + d0 * 32 + r32] = (half_t)(o[d0][r] * rli[r]); }
      asm volatile("s_waitcnt lgkmcnt(0)" ::: "memory");
#pragma unroll
      for (int k = 0; k < 4; ++k) { const int row = k * 8 + (lane >> 3), ch = lane & 7; const u4_t v = *(const u4_t*)(stg + row * 64 + ch * 8); *(u4_t*)(Ow + (long)row * DM + ch * 8) = v; } }
    asm volatile("s_waitcnt lgkmcnt(0)\n\ts_barrier" ::: "memory");
#pragma unroll
    for (int d0 = 0; d0 < 4; ++d0) qc[d0] = qn[d0];
  }
#undef SW_T0
#undef SW_ISSUE
#undef SW_QLOAD
}
#undef SBAR
#undef WAIT_BAR
#undef MF16
}

#define GAS __attribute__((address_space(1)))
typedef GAS unsigned gu32;
#define RLX_AGENT __ATOMIC_RELAXED, __HIP_MEMORY_SCOPE_AGENT
constexpr int CW_TMO = 0, CW_CODE = 1;
constexpr int CW_BAR = 4096;
constexpr int CW_SEAM = 16384, SEAM_BANK = 128 * 64;
constexpr int LDS_BYTES = 147456;
constexpr int MISC_OFF = 131072 + 320;
constexpr int MR_OFF = 131072 + 1024 + 8192;
constexpr int SD_OFF = 131072 + 1024 + 8192 + 4096;
constexpr int XL_OFF = 131072 + 1024;

#define XB_TMO      128
#define XB_XCNT(j)  (256  + 64 * (j))
#define XB_XSUB(j)  (1280 + 64 * (j))
#define XB_XGEN(j)  (2304 + 64 * (j))
#define XB_TOP      3328
#define XB_TOPGEN   3392
#define XCD_BAR_WORDS 3456
#define XB_LSUB(j)  (3520 + 64 * (j))
#define XB_LGEN(j)  (4544 + 64 * (j))
#define XB_SPIN_CAP (1u << 22)
__device__ __forceinline__ unsigned xb_ld(unsigned* p)              { return __hip_atomic_load(p, __ATOMIC_RELAXED, __HIP_MEMORY_SCOPE_AGENT); }
__device__ __forceinline__ unsigned xb_add(unsigned* p, unsigned v) { return __hip_atomic_fetch_add(p, v, __ATOMIC_RELAXED, __HIP_MEMORY_SCOPE_AGENT); }
__device__ __forceinline__ unsigned xb_xcc_id() { return (unsigned)__builtin_amdgcn_s_getreg((3 << 11) | 20) & 0xFu; }
#define XB_SPIN(cond, bar) do { unsigned _sp = 0; while (cond) { __builtin_amdgcn_s_sleep(1); \
    if ((++_sp & 255u) == 0u) { if (xb_ld(&(bar)[XB_TMO])) break; if (_sp > XB_SPIN_CAP) { atomicAdd(&(bar)[XB_TMO], 1u); break; } } } } while (0)
struct XcdBarrier { unsigned* bar; unsigned x; volatile LAS unsigned* st; };
__device__ __forceinline__ XcdBarrier xcd_barrier_post(unsigned* bar, volatile LAS unsigned* st) {
    XcdBarrier b; b.bar = bar; b.x = xb_xcc_id(); b.st = st;
    if (threadIdx.x == 0) st[3] = xb_add(&bar[XB_XCNT(b.x)], 1u);
    return b;
}
__device__ __forceinline__ void xcd_barrier_complete(unsigned* bar, unsigned x, unsigned& nloc, unsigned& nx, unsigned& even) {
    const unsigned G = gridDim.x * gridDim.y * gridDim.z;
    unsigned sum, cnt, mine, ev, sp = 0u;
    for (;;) {
        sum = 0u; cnt = 0u; mine = 0u; ev = 1u;
#pragma unroll
        for (unsigned j = 0; j < 16; ++j) { const unsigned c = xb_ld(&bar[XB_XCNT(j)]); sum += c; cnt += (c > 0u) ? 1u : 0u; mine = (j == x) ? c : mine; ev &= (c == ((j < 8u) ? G / 8u : 0u)) ? 1u : 0u; }
        if (sum == G) break;
        __builtin_amdgcn_s_sleep(1);
        if ((++sp & 255u) == 0u) { if (xb_ld(&bar[XB_TMO])) break; if (sp > XB_SPIN_CAP) { atomicAdd(&bar[XB_TMO], 1u); break; } }
    }
    nloc = mine > 0u ? mine : 1u; nx = cnt > 0u ? cnt : 1u; even = (sum == G) ? ev : 0u;
}
__device__ __forceinline__ void xcd_barrier(const XcdBarrier& b) {
    asm volatile("s_waitcnt vmcnt(0)" ::: "memory");
    __syncthreads();
    if (threadIdx.x == 0) {
        unsigned* bar = b.bar;
        __builtin_amdgcn_s_waitcnt(0);
        unsigned nloc = b.st[0], nx = b.st[1];
        if (nloc == 0u) { unsigned even; xcd_barrier_complete(bar, b.x, nloc, nx, even); b.st[0] = nloc; b.st[1] = nx; b.st[2] = even; }
        const unsigned old = xb_add(&bar[XB_XSUB(b.x)], 1u);
        const unsigned gen = old / nloc;
        if (old + 1u == (gen + 1u) * nloc) {
            __builtin_amdgcn_fence(__ATOMIC_RELEASE, "agent");
            asm volatile("s_waitcnt vmcnt(0)" ::: "memory");
            const unsigned og = xb_add(&bar[XB_TOP], 1u);
            const unsigned tg = og / nx;
            if (og + 1u == (tg + 1u) * nx) xb_add(&bar[XB_TOPGEN], 1u);
            else XB_SPIN(xb_ld(&bar[XB_TOPGEN]) == tg, bar);
            __builtin_amdgcn_fence(__ATOMIC_ACQUIRE, "agent");
            xb_add(&bar[XB_XGEN(b.x)], 1u);
            asm volatile("s_waitcnt vmcnt(0)" ::: "memory");
        } else {
            XB_SPIN(xb_ld(&bar[XB_XGEN(b.x)]) == gen, bar);
            __builtin_amdgcn_fence(__ATOMIC_ACQUIRE, "agent");
            asm volatile("s_waitcnt vmcnt(0)" ::: "memory");
        }
    }
    __syncthreads();
}

__device__ __forceinline__ void xcd_barrier_local(const XcdBarrier& b) {
    asm volatile("s_waitcnt vmcnt(0)" ::: "memory");
    __syncthreads();
    if (threadIdx.x == 0) {
        unsigned* bar = b.bar;
        __builtin_amdgcn_s_waitcnt(0);
        const unsigned nloc = b.st[0];
        const unsigned old = __hip_atomic_fetch_add(&bar[XB_LSUB(b.x)], 1u, __ATOMIC_RELAXED, __HIP_MEMORY_SCOPE_WORKGROUP);
        const unsigned gen = old / nloc;
        if (old + 1u == (gen + 1u) * nloc) (void)__hip_atomic_fetch_add(&bar[XB_LGEN(b.x)], 1u, __ATOMIC_RELAXED, __HIP_MEMORY_SCOPE_WORKGROUP);
        else XB_SPIN(xb_ld(&bar[XB_LGEN(b.x)]) == gen, bar);
        __builtin_amdgcn_fence(__ATOMIC_ACQUIRE, "agent");
        asm volatile("s_waitcnt vmcnt(0)" ::: "memory");
    }
    __syncthreads();
}

#ifndef REPEAT_MASK
#define REPEAT_MASK 0
#endif
#ifndef PROBE_PHASE
#define PROBE_PHASE -1
#endif
#ifndef PROBE_MODE
#define PROBE_MODE 0
#endif
constexpr int NPHASE = 14;
struct Args { Params P; int ph_lo, ph_hi, mode, pad; };
static_assert(sizeof(Args) == sizeof(Params) + 16 && sizeof(Params) == 25 * 8, "Args has no padding");

__global__ void __launch_bounds__(512, 2) mega(Args a) {
    extern __shared__ __attribute__((aligned(16))) unsigned char lds_raw[];
    LAS unsigned char* lds = (LAS unsigned char*)lds_raw;
    const Params& P = a.P;
    const int tid = threadIdx.x, wave = __builtin_amdgcn_readfirstlane(tid >> 6);
    const int G = gridDim.x, wg = blockIdx.x, gw = wg * 8 + wave, ngw = G * 8;
#define LANE_NOW() ((int)(threadIdx.x & 63u))
    unsigned char* ws = P.ws;
    volatile LAS unsigned* MISC = (volatile LAS unsigned*)(lds + MISC_OFF);
    for (int u = tid; u < (LDS_BYTES - 131072) / 4; u += 512) ((LAS unsigned*)(lds + 131072))[u] = 0u;
    __syncthreads();
    unsigned* ctl = (unsigned*)(ws + WS_CTL);
    XcdBarrier bar = xcd_barrier_post(ctl + CW_BAR, MISC + 8);
    const int lo = a.ph_lo, hi = a.ph_hi;
#define IN(k) (lo <= (k) && (k) < hi)
#define SEAM(k) do { if ((k) + 1 < hi) xcd_barrier(bar); } while (0)
#define REP_BEGIN(k) for (int rep_ = 0; rep_ <= ((REPEAT_MASK >> (k)) & 1); ++rep_) {
#define REP_END(k) if (rep_ < ((REPEAT_MASK >> (k)) & 1)) xcd_barrier(bar); }

    half_t* XH = (half_t*)(ws + WS_XH); half_t* Z = (half_t*)(ws + WS_Z); half_t* O = (half_t*)(ws + WS_O); half_t* H1 = (half_t*)(ws + WS_H1); half_t* H2 = (half_t*)(ws + WS_H2);
    half_t* QX = (half_t*)(ws + WS_QX); half_t* PX = (half_t*)(ws + WS_PX); half_t* OX = (half_t*)(ws + WS_OX); half_t* KX = (half_t*)(ws + WS_KX); half_t* VXT = (half_t*)(ws + WS_VXT);
    half_t* MEMH = (half_t*)(ws + WS_MEMH); half_t* ACT = (half_t*)(ws + WS_ACT); half_t* Y = (half_t*)(ws + WS_Y); float* TMP = (float*)(ws + WS_TMP);
    half_t* WIN = (half_t*)(ws + WS_WIN); half_t* WMO = (half_t*)(ws + WS_WMO); half_t* WXQ = (half_t*)(ws + WS_WXQ); half_t* WXK = (half_t*)(ws + WS_WXK); half_t* WXV = (half_t*)(ws + WS_WXV);
    half_t* WXO = (half_t*)(ws + WS_WXO); half_t* WGU = (half_t*)(ws + WS_WGU); half_t* WD = (half_t*)(ws + WS_WD);
    const unsigned* CNT = (const unsigned*)(ws + WS_CTL) + CW_CNT; const int* LTOK = (const int*)(ws + WS_LTOK); const float* LW = (const float*)(ws + WS_LW);

    if (IN(0)) { REP_BEGIN(0) phase_prep(P, lds, wg, G); REP_END(0) SEAM(0); }
    int vwg = wg; bool loc = false;
    if (lo == 0 && hi == NPHASE && G == 256 && __builtin_amdgcn_readfirstlane((int)MISC[10]) != 0) { loc = true; vwg = __builtin_amdgcn_readfirstlane((int)(MISC[11] * 8u + bar.x)); }
    const int vx = vwg & 7, vr = vwg >> 3;
#define SEAM_L(k) do { if ((k) + 1 < hi) { if (loc) xcd_barrier_local(bar); else xcd_barrier(bar); } } while (0)
    if (IN(1)) { REP_BEGIN(1)
        if (G == 256) { if (vr >= 24) scan_bh(P, (LAS float*)lds, vx * 8 + vr - 24); } else { for (int bh = wg; bh < 64; bh += G) scan_bh(P, (LAS float*)lds, bh); }
        if (G == 256 && vr >= 16 && vr < 20) { const pg::DenseProb g = pg::dense(MEMH, 1024, WXK, 1024, 1024); const pg::OneUnit S{vx, vr & 3}; pg::EpiF16 E{KX, 1024, 1.f, 0, 0};
          pg::gemm_phase<pg::DenseProb, pg::EpiF16, pg::OneUnit, true, false>(lds, g, S, E); }
        if (G == 256 && vr >= 20 && vr < 24) { const pg::DenseProb g = pg::dense(MEMH, 1024, WXV, 1024, 1024); const pg::OneUnit S{vx, vr & 3}; pg::EpiF16 E{VXT, 1024, 1.f, 0, 0};
          pg::gemm_phase<pg::DenseProb, pg::EpiF16, pg::OneUnit, true, false>(lds, g, S, E); }
        { const pg::DenseProb g = pg::dense(XH, 1024, WIN, 1024, 1024); pg::StaticOrder S; S.init(T / 256, ZW / 256, G, vwg, 0); pg::EpiZ E{Z, P.pos, lds + MR_OFF, a.mode, 0};
          pg::gemm_phase<pg::DenseProb, pg::EpiZ, pg::StaticOrder, true>(lds, g, S, E); }
        if (G != 256) {
          { const pg::DenseProb g = pg::dense(MEMH, 1024, WXK, 1024, 1024); pg::StaticOrder S; S.init(MROWS / 256, 4, G, wg, 0); pg::EpiF16 E{KX, 1024, 1.f, 0, 0};
            pg::gemm_phase<pg::DenseProb, pg::EpiF16, pg::StaticOrder, true>(lds, g, S, E); }
          { const pg::DenseProb g = pg::dense(MEMH, 1024, WXV, 1024, 1024); pg::StaticOrder S; S.init(MROWS / 256, 4, G, wg, 0); pg::EpiF16 E{VXT, 1024, 1.f, 0, 0};
            pg::gemm_phase<pg::DenseProb, pg::EpiF16, pg::StaticOrder, true>(lds, g, S, E); }
        }
        REP_END(1) SEAM_L(1);
    }
    if (IN(2)) { REP_BEGIN(2)
        if (G == 256) {
            const int bb = vx, jj = vr;
            const half_t* BK = (const half_t*)(ws + WS_BK); const int* TS = (const int*)(ws + WS_TS);
            { LAS int* cst = (LAS int*)(lds + 98304); LAS int* ord = cst + 128;
              if (tid < 128) cst[tid] = 4 * (tid & 15) + 4 - TS[(bb * 8 + (tid >> 4)) * 16 + (tid & 15)];
              __syncthreads();
              if (tid < 128) { const int c = cst[tid]; int rk = 0; for (int uu = 0; uu < 128; ++uu) { const int cu = cst[uu]; rk += (cu > c || (cu == c && uu < tid)) ? 1 : 0; } ord[rk] = tid; }
              __syncthreads();
              int us[4];
#pragma unroll
              for (int i = 0; i < 4; ++i) { const int pos = (i == 0) ? jj : (i == 1) ? 63 - jj : (i == 2) ? 64 + jj : 127 - jj; us[i] = __builtin_amdgcn_readfirstlane(ord[pos]); }
              int t0s[4];
#pragma unroll
              for (int i = 0; i < 4; ++i) t0s[i] = __builtin_amdgcn_readfirstlane(TS[(bb * 8 + (us[i] >> 4)) * 16 + (us[i] & 15)]);
              __syncthreads();
              for (int i = 0; i < 4; ++i) { const int ui_ = (i == 0) ? us[0] : (i == 1) ? us[1] : (i == 2) ? us[2] : us[3], ti_ = (i == 0) ? t0s[0] : (i == 1) ? t0s[1] : (i == 2) ? t0s[2] : t0s[3];
                  attn::attn_unit<0, 14>(bb, ui_ >> 4, ui_ & 15, Z, BK, ti_, (const float*)(ws + WS_CUM), P.sinks, O, (char*)lds_raw); } }
            attn::swa_units<4>(bb, (jj * 4) >> 6, (jj * 4) & 63, Z, P.sinks, O, (char*)lds_raw, lds + XL_OFF);
        } else {
            for (int it = gw; it < 2048; it += ngw) { const int bh = it >> 5, j = it & 31; attn_naive_item<0>(P, j, bh, LANE_NOW()); attn_naive_item<0>(P, 63 - j, bh, LANE_NOW()); }
            for (int it = gw; it < 4096; it += ngw) attn_naive_item<1>(P, it & 63, it >> 6, LANE_NOW());
        }
        REP_END(2) SEAM_L(2);
    }
    if (IN(3)) { REP_BEGIN(3)
        {
          const float* U1 = (const float*)ctl + CW_U1; const float* C1 = (const float*)ctl + CW_C1; float* UB = (float*)(ws + WS_UBH); const int lane_ = LANE_NOW();
          for (int mr_ = (G == 256) ? vx * 256 + vr * 8 + wave : gw; mr_ < MROWS; mr_ += (G == 256) ? MROWS : ngw) { float su[4], sc[4];
#pragma unroll
              for (int j = 0; j < 4; ++j) { const h4_t kv = *(const h4_t*)(KX + (size_t)mr_ * DM + 256 * j + 4 * lane_); const f4_t uu = *(const f4_t*)(U1 + 256 * j + 4 * lane_), cc = *(const f4_t*)(C1 + 256 * j + 4 * lane_);
                  su[j] = (float)kv[0] * uu[0] + (float)kv[1] * uu[1] + (float)kv[2] * uu[2] + (float)kv[3] * uu[3]; sc[j] = (float)kv[0] * cc[0] + (float)kv[1] * cc[1] + (float)kv[2] * cc[2] + (float)kv[3] * cc[3]; }
#pragma unroll
              for (int j = 0; j < 4; ++j) { su[j] = wave_sum(su[j]); sc[j] = wave_sum(sc[j]); }
              if (lane_ < 4) { float a = su[0], c = sc[0];
#pragma unroll
                  for (int j = 1; j < 4; ++j) { a = (lane_ == j) ? su[j] : a; c = (lane_ == j) ? sc[j] : c; }
                  const int bh = (mr_ >> 8) * 4 + lane_; UB[bh * 256 + (mr_ & 255)] = a; UB[16384 + bh * 256 + (mr_ & 255)] = c; } }
          constexpr int XSK = (int)((XB_STRIDE - 2 * MiB) / 2);
          if (G == 256) {
            if (vr < 16) { const pg::GTProb g{KX, (const half_t*)(ws + WS_WQS), 256, 0}; const pg::OneUnit S{vx * 4 + (vr >> 2), vr & 3}; pg::EpiF16 E{(half_t*)(ws + WS_GT), 1024, 1.f, 0, XSK};
              pg::gemm_phase<pg::GTProb, pg::EpiF16, pg::OneUnit, true, false>(lds, g, S, E); }
            else { const pg::VWProb g{WXO, VXT, 256, 0}; const pg::OneUnit S{vr & 3, vx * 4 + ((vr - 16) >> 2)}; pg::EpiF16 E{(half_t*)(ws + WS_VWT), 1024, 1.f, 1, XSK};
              pg::gemm_phase<pg::VWProb, pg::EpiF16, pg::OneUnit, true, false>(lds, g, S, E); }
          } else {
            { const pg::GTProb g{KX, (const half_t*)(ws + WS_WQS), 256, 0}; pg::StaticOrder S; S.init(32, 4, G, wg, 0); pg::EpiF16 E{(half_t*)(ws + WS_GT), 1024, 1.f, 0, XSK};
              pg::gemm_phase<pg::GTProb, pg::EpiF16, pg::StaticOrder, true, false>(lds, g, S, E); }
            { const pg::VWProb g{WXO, VXT, 256, 0}; pg::StaticOrder S; S.init(4, 32, G, wg, 0); pg::EpiF16 E{(half_t*)(ws + WS_VWT), 1024, 1.f, 1, XSK};
              pg::gemm_phase<pg::VWProb, pg::EpiF16, pg::StaticOrder, true, false>(lds, g, S, E); } } }
        const pg::DenseProb g = pg::dense(O, 1024, WMO, 1024, 1024); pg::StaticOrder S; S.init(T / 256, 4, G, vwg, 0);
        pg::EpiV<0> E{XH, H1, (float*)(ws + WS_ST1), nullptr, nullptr, lds + MR_OFF};
        pg::gemm_phase<pg::DenseProb, pg::EpiV<0>, pg::StaticOrder, true>(lds, g, S, E);
        REP_END(3) SEAM_L(3);
    }
    if (IN(5)) { REP_BEGIN(5)
        { const pg::DenseProb g{H1, (const half_t*)(ws + WS_GT), (size_t)256 * 1024, 0, (size_t)256 * 1024, XB_STRIDE / 2, 1024, 1024, 1024, 0}; pg::StaticOrder S; S.init(T / 256, 4, G, vwg, 0);
          pg::row_tables(S, (const float*)(ws + WS_ST1), lds + MR_OFF);
          pg::EpiSoftmaxFold E{PX, lds + XL_OFF, (const float*)(ws + WS_UBH), lds + MR_OFF, lds + SD_OFF, C2_256, 0};
          pg::gemm_phase<pg::DenseProb, pg::EpiSoftmaxFold, pg::StaticOrder, true>(lds, g, S, E); }
        REP_END(5) SEAM_L(5);
    }
    if (IN(8)) { REP_BEGIN(8)
        const pg::DenseProb g{PX, (const half_t*)(ws + WS_VWT), (size_t)256 * 1024, 0, (size_t)256 * 1024, XB_STRIDE / 2, 1024, 1024, 1024, 0}; pg::StaticOrder S; S.init(T / 256, 4, G, vwg, 0);
        pg::row_tables(S, (const float*)(ws + WS_ST1), lds + MR_OFF);
        pg::EpiV<1> E{H1, (half_t*)(ws + WS_V2), (float*)(ws + WS_ST2), P.ln_mix_g, P.ln_mix_b, lds + MR_OFF};
        pg::gemm_phase<pg::DenseProb, pg::EpiV<1>, pg::StaticOrder, true>(lds, g, S, E);
        REP_END(8) SEAM_L(8);
    }
    if (IN(10)) { REP_BEGIN(10)
        const bool conv_first = (wg & 1) != 0;
        for (int pass = 0; pass < 2; ++pass) {
            if ((pass == 0) == conv_first) { LAS float* scr = (LAS float*)(lds + 32768 + wave * 8448); const int ln_ = LANE_NOW();
                for (int it = gw; it < NQ_GU; it += ngw) conv_gu_item(P, scr, it, ln_); __syncthreads(); }
            else { for (int it = (G == 256) ? vx * 32 + vr : wg; it < T / 128; it += G) route_tokens_fast(P, lds, it * 128); } }
        REP_END(10) SEAM(10);
    }
    if (IN(11)) { REP_BEGIN(11)
        const pg::GUProb g{(const half_t*)(ws + WS_V2), WGU, CNT, LTOK, lds + XL_OFF, 1024, 0}; pg::MoeOrder S; S.init(CNT, G, wg, lds + SD_OFF);
        pg::EpiGU E{ACT, (const float*)ctl + CW_UGU, (const float*)ctl + CW_CGU, (const float*)(ws + WS_LMR), lds + MR_OFF};
        pg::gemm_phase<pg::GUProb, pg::EpiGU, pg::MoeOrder, true>(lds, g, S, E);
        {
          const int first = (S.total > 4 * G && S.total < 5 * G) ? S.total - 4 * G : 0, nsl = G - first;
          if (wg >= first) { LAS float* scr = (LAS float*)(lds + 32768 + wave * 8448); const int ln_ = LANE_NOW();
              for (int it = (wg - first) * 8 + wave; it < NQ_WD; it += nsl * 8) conv_wd_item(P, scr, it, ln_); } }
        REP_END(11) SEAM(11);
    }
    if (IN(12)) { REP_BEGIN(12)
        const pg::DownProb g{ACT, WD, 512, 0}; pg::MoeOrder S; S.init(CNT, G, wg, lds + SD_OFF); pg::EpiDown E{Y, CNT, LTOK, LW, lds + MR_OFF};
        pg::gemm_phase<pg::DownProb, pg::EpiDown, pg::MoeOrder, true>(lds, g, S, E);
        REP_END(12) SEAM(12);
    }
    if (IN(13)) { REP_BEGIN(13) final_ln_rows(P, gw, ngw, LANE_NOW()); REP_END(13) }
#undef IN
#undef SEAM
#undef SEAM_L
}

extern "C" void kernel_launch(void* const* d_in, const int* in_sizes, int n_in, void* d_out, int out_size, void* d_ws, size_t ws_size, hipStream_t stream) {
    static int grid = 0;
    if (grid == 0) {
        if (n_in != 23 || in_sizes[0] != T * DM || out_size != T * DM || ws_size < WS_END) { fprintf(stderr, "kernel_launch: unexpected shapes (n_in %d, in0 %d, out %d, ws %zu)\n", n_in, n_in > 0 ? in_sizes[0] : -1, out_size, ws_size); grid = -1; return; }
        int dev = 0, cus = 0;
        if (hipGetDevice(&dev) != hipSuccess || hipDeviceGetAttribute(&cus, hipDeviceAttributeMultiprocessorCount, dev) != hipSuccess) { grid = -1; return; }
        if (hipFuncSetAttribute((const void*)mega, hipFuncAttributeMaxDynamicSharedMemorySize, LDS_BYTES) != hipSuccess) { fprintf(stderr, "kernel_launch: hipFuncSetAttribute failed\n"); grid = -1; return; }
        int per_cu = 0;
        if (hipOccupancyMaxActiveBlocksPerMultiprocessor(&per_cu, (const void*)mega, 512, LDS_BYTES) != hipSuccess || per_cu < 1) fprintf(stderr, "kernel_launch: occupancy query reports %d\n", per_cu);
        (void)hipGetLastError();
        grid = cus;
    }
    if (grid < 0) return;
    (void)hipMemsetAsync((char*)d_ws + WS_CTL, 0, CTL_BYTES, stream);
    Args a{};
    Params& P = a.P;
    P.x = (const float*)d_in[0]; P.mem = (const float*)d_in[1]; P.pos = (const int*)d_in[2]; P.w_in = (const float*)d_in[3]; P.b_forget = (const float*)d_in[4];
    P.sinks = (const float*)d_in[5]; P.w_mix_out = (const float*)d_in[6]; P.ln_mix_g = (const float*)d_in[7]; P.ln_mix_b = (const float*)d_in[8];
    P.w_xq = (const float*)d_in[9]; P.w_xkv = (const float*)d_in[10]; P.w_xout = (const float*)d_in[11]; P.ln_x_g = (const float*)d_in[12]; P.ln_x_b = (const float*)d_in[13];
    P.w_rg = (const float*)d_in[14]; P.b_rg = (const float*)d_in[15]; P.w_re = (const float*)d_in[16]; P.b_re = (const float*)d_in[17];
    P.w_gate = (const float*)d_in[18]; P.w_up = (const float*)d_in[19]; P.w_down = (const float*)d_in[20]; P.ln_f_g = (const float*)d_in[21]; P.ln_f_b = (const float*)d_in[22];
    P.out = (float*)d_out; P.ws = (unsigned char*)d_ws;
    a.ph_lo = 0; a.ph_hi = NPHASE;
    hipLaunchKernelGGL(mega, dim3(grid), dim3(512), LDS_BYTES, stream, a);
#if PROBE_PHASE >= 0
    a.ph_lo = PROBE_PHASE; a.ph_hi = PROBE_PHASE + 1; a.mode = PROBE_MODE;
    hipLaunchKernelGGL(mega, dim3(grid), dim3(512), LDS_BYTES, stream, a);
#endif
}
```

```cpp
#include <hip/hip_runtime.h>
#include <cstdio>
#include <cstdint>

typedef _Float16 half_t;
typedef _Float16 h2_t __attribute__((ext_vector_type(2)));
typedef _Float16 h4_t __attribute__((ext_vector_type(4)));
typedef _Float16 h8_t __attribute__((ext_vector_type(8)));
typedef float f2_t __attribute__((ext_vector_type(2)));
typedef float f4_t __attribute__((ext_vector_type(4)));
typedef unsigned u4_t __attribute__((ext_vector_type(4)));
#define LAS __attribute__((address_space(3)))

constexpr int DM = 1024, NB = 8, SEQ = 4096, T = NB * SEQ;
constexpr int NMEM = 256, MROWS = NB * NMEM;
constexpr int INW = 2312, ZW = 2304;
constexpr int NEXP = 32, DEXP = 512, LCAP = T;
constexpr float ALPHA = 1.189207115002721f;
constexpr float LOG2E = 1.4426950408889634f;
constexpr float C2_64 = 0.125f * LOG2E;
constexpr float C2_256 = 0.0625f * LOG2E;
constexpr float LN_EPS = 1e-5f;
constexpr float FOX_CUT = 256.f;
constexpr int ZQF = 0, ZKF = 512, ZVF = 1024, ZQS = 1536, ZKS = 2048, ZVS = 2176;

constexpr size_t MiB = 1u << 20;
constexpr size_t WS_CTL = 0, CTL_BYTES = 1 * MiB;
constexpr size_t WS_WIN = 1 * MiB;
constexpr size_t WS_WMO = 6 * MiB;
constexpr size_t WS_WXQ = 8 * MiB, WS_WXK = 10 * MiB, WS_WXV = 12 * MiB, WS_WXO = 14 * MiB;
constexpr size_t WS_WR = 16 * MiB;
constexpr size_t WS_WGU = 17 * MiB;
constexpr size_t WS_WD = 81 * MiB;
constexpr size_t WS_LOGF = 113 * MiB;
constexpr size_t WS_CUM = 114 * MiB;
constexpr size_t WS_BK = 496 * MiB + 2 * MiB;
constexpr size_t WS_MEMH = 115 * MiB;
constexpr size_t WS_KX = 119 * MiB;
constexpr size_t WS_VXT = 123 * MiB;
constexpr size_t WS_LG = 127 * MiB;
constexpr size_t WS_LMR = 127 * MiB;
constexpr size_t WS_MR2 = 135 * MiB;
constexpr size_t WS_WQS = 136 * MiB;
constexpr size_t WS_UBH = 138 * MiB;
constexpr size_t WS_GT = 224 * MiB;
constexpr size_t WS_VWT = 226 * MiB;
constexpr size_t XB_STRIDE = 18 * MiB;
constexpr size_t WS_LTOK = 151 * MiB;
constexpr size_t WS_LW = 155 * MiB;
constexpr size_t WS_XH = 160 * MiB;
constexpr size_t WS_H2 = WS_XH;
constexpr size_t WS_Z = 224 * MiB;
constexpr size_t WS_QX = 224 * MiB;
constexpr size_t WS_PX = 368 * MiB;
constexpr size_t WS_Y = 224 * MiB;
constexpr size_t WS_TMP = 224 * MiB;
constexpr size_t WS_O = 368 * MiB;
constexpr size_t WS_OX = 368 * MiB;
constexpr size_t WS_ACT = 368 * MiB;
constexpr size_t WS_H1 = 432 * MiB;
constexpr size_t WS_V2 = 160 * MiB;
constexpr size_t WS_XB = 496 * MiB;
constexpr size_t WS_TS = 502 * MiB;
constexpr size_t WS_ST1 = 503 * MiB;
constexpr size_t WS_ST2 = 507 * MiB;
constexpr size_t WS_END = 511 * MiB;
constexpr int CW_CNT = 64;
constexpr int CW_UGU = 131072, CW_CGU = 163840;
constexpr int CW_UR = 196608, CW_CR = 196672;
constexpr int CW_U1 = 65536, CW_C1 = 65536 + 1024;

struct Params {
    const float* x; const float* mem; const int* pos; const float* w_in; const float* b_forget; const float* sinks; const float* w_mix_out;
    const float* ln_mix_g; const float* ln_mix_b; const float* w_xq; const float* w_xkv; const float* w_xout; const float* ln_x_g; const float* ln_x_b;
    const float* w_rg; const float* b_rg; const float* w_re; const float* b_re; const float* w_gate; const float* w_up; const float* w_down;
    const float* ln_f_g; const float* ln_f_b;
    float* out; unsigned char* ws;
};

__device__ __forceinline__ float wave_sum(float v) {
#pragma unroll
    for (int o = 1; o < 64; o <<= 1) v += __shfl_xor(v, o);
    return v;
}
__device__ __forceinline__ unsigned pkh(float lo, float hi) { f2_t v = {lo, hi}; h2_t h = __builtin_convertvector(v, h2_t); return __builtin_bit_cast(unsigned, h); }
__device__ __forceinline__ float inv_freq(int i) { return exp2f(-(float)i * (13.287712379549449f / 32.0f)); }
__device__ __forceinline__ void rope_cs(int pos, int i, float& c, float& s) {
    const float ang = (float)pos * inv_freq(i);
    const float rev = ang * 0.15915494309189535f; const float fr = rev - floorf(rev);
    s = __builtin_amdgcn_sinf(fr); c = __builtin_amdgcn_cosf(fr);
}

__device__ __forceinline__ int win_dest(int c) {
    if (c < 1536) return c;
    if (c < 1544) return -1;
    if (c < 2056) { const int cc = c - 1544, hd = cc >> 6, d = cc & 63; return ZQS + hd * 64 + ((d < 32) ? 2 * d : 2 * (d - 32) + 1); }
    if (c < 2184) { const int cc = c - 2056, hd = cc >> 6, d = cc & 63; return ZKS + hd * 64 + ((d < 32) ? 2 * d : 2 * (d - 32) + 1); }
    if (c < 2312) return ZVS + (c - 2184);
    return -1;
}
template <class DestFn>
__device__ __forceinline__ void tr_item(const float* W, int ldw, int N, half_t* WT, int ldt, LAS float* scr, int k0, int n0, int lane, DestFn dest) {
    float tv[32];
    { const int n = n0 + (lane & 31); const bool ok = n < N; const float* wp = W + (size_t)(k0 + (lane >> 5)) * ldw + (ok ? n : 0);
#pragma unroll
      for (int i = 0; i < 32; ++i) tv[i] = wp[(size_t)(2 * i) * ldw];
#pragma unroll
      for (int i = 0; i < 32; ++i) scr[(2 * i + (lane >> 5)) * 33 + (lane & 31)] = ok ? tv[i] : 0.f; }
    asm volatile("s_waitcnt lgkmcnt(0)" ::: "memory");
    const int c = lane & 7;
#pragma unroll
    for (int j = 0; j < 4; ++j) { const int nl = (lane >> 3) + 8 * j; const LAS float* s = scr + (8 * c) * 33 + nl;
        u4_t o; o.x = pkh(s[0 * 33], s[1 * 33]); o.y = pkh(s[2 * 33], s[3 * 33]); o.z = pkh(s[4 * 33], s[5 * 33]); o.w = pkh(s[6 * 33], s[7 * 33]);
        const int dr = (n0 + nl < N) ? dest(n0 + nl) : -1;
        if (dr >= 0) *(u4_t*)(WT + (size_t)dr * ldt + k0 + 8 * c) = o; }
    asm volatile("s_waitcnt lgkmcnt(0)" ::: "memory");
}
template <class DestFn>
__device__ __forceinline__ void tr_item_ln(const float* W, int ldw, half_t* WT, LAS float* scr, int k0, int n0, int lane, const float* gk, const float* bk, float* U, float* C, DestFn dest) {
    float tv[32];
    { const float* wp = W + (size_t)(k0 + (lane >> 5)) * ldw + n0 + (lane & 31);
#pragma unroll
      for (int i = 0; i < 32; ++i) tv[i] = wp[(size_t)(2 * i) * ldw];
#pragma unroll
      for (int i = 0; i < 32; ++i) scr[(2 * i + (lane >> 5)) * 33 + (lane & 31)] = tv[i]; }
    asm volatile("s_waitcnt lgkmcnt(0)" ::: "memory");
    const int c = lane & 7;
    float gs[8], bs[8];
#pragma unroll
    for (int i = 0; i < 8; ++i) { gs[i] = gk[k0 + 8 * c + i]; bs[i] = bk[k0 + 8 * c + i]; }
#pragma unroll
    for (int j = 0; j < 4; ++j) { const int nl = (lane >> 3) + 8 * j; const LAS float* sp = scr + (8 * c) * 33 + nl; const int dr = dest(n0 + nl);
        float sv[8]; float pu = 0.f, pc = 0.f;
#pragma unroll
        for (int i = 0; i < 8; ++i) { const float v = sp[i * 33]; sv[i] = v * gs[i]; pu += sv[i]; pc += v * bs[i]; }
        u4_t o; o.x = pkh(sv[0], sv[1]); o.y = pkh(sv[2], sv[3]); o.z = pkh(sv[4], sv[5]); o.w = pkh(sv[6], sv[7]);
        *(u4_t*)(WT + (size_t)dr * 1024 + k0 + 8 * c) = o;
        pu += __shfl_xor(pu, 1); pu += __shfl_xor(pu, 2); pu += __shfl_xor(pu, 4);
        pc += __shfl_xor(pc, 1); pc += __shfl_xor(pc, 2); pc += __shfl_xor(pc, 4);
        if (c == 0) { atomicAdd(U + dr, pu); atomicAdd(C + dr, pc); } }
    asm volatile("s_waitcnt lgkmcnt(0)" ::: "memory");
}
constexpr int NQ_GU = NEXP * 512;
__device__ __forceinline__ void conv_gu_item(const Params& P, LAS float* scr, int it, int lane) {
    half_t* WGU = (half_t*)(P.ws + WS_WGU); const int e = it >> 9; int r = it & 511; float* U = (float*)(P.ws + WS_CTL) + CW_UGU + e * 1024; float* C = (float*)(P.ws + WS_CTL) + CW_CGU + e * 1024;
    if (r < 256) tr_item_ln(P.w_gate + (size_t)e * 1024 * 512, 512, WGU + (size_t)e * 1024 * 1024, scr, 64 * (r / 16), 32 * (r % 16), lane, P.ln_x_g, P.ln_x_b, U, C, [](int c) { return 2 * c; });
    else { r -= 256; tr_item_ln(P.w_up + (size_t)e * 1024 * 512, 512, WGU + (size_t)e * 1024 * 1024, scr, 64 * (r / 16), 32 * (r % 16), lane, P.ln_x_g, P.ln_x_b, U, C, [](int c) { return 2 * c + 1; }); }
}
constexpr int NQ_WD = NEXP * 256;
__device__ __forceinline__ void conv_wd_item(const Params& P, LAS float* scr, int it, int lane) {
    half_t* WD = (half_t*)(P.ws + WS_WD); const int e = it >> 8, r = it & 255;
    tr_item(P.w_down + (size_t)e * 512 * 1024, 1024, 1024, WD + (size_t)e * 1024 * 512, 512, scr, 64 * (r / 32), 32 * (r % 32), lane, [](int c) { return c; });
}
constexpr int P0_LDS = 32768 + 8 * 8448;
__device__ __forceinline__ void phase_prep(const Params& P, LAS unsigned char* lds, int wg, int nwg) {
    const int tid = threadIdx.x, lane = tid & 63, wave = __builtin_amdgcn_readfirstlane(tid >> 6);
    constexpr int NXW = 5;
    const bool xw = wave < NXW;
    const int gw = xw ? wg * NXW + wave : wg * (8 - NXW) + (wave - NXW), ngw = xw ? nwg * NXW : nwg * (8 - NXW);
    LAS float* wfT = (LAS float*)lds;
    LAS float* scr = (LAS float*)(lds + 32768 + wave * 8448);
    for (int k = tid; k < 1024; k += 512) { const f4_t a = *(const f4_t*)(P.w_in + (size_t)k * INW + 1536), b = *(const f4_t*)(P.w_in + (size_t)k * INW + 1540);
        wfT[0 * 1024 + k] = a.x; wfT[1 * 1024 + k] = a.y; wfT[2 * 1024 + k] = a.z; wfT[3 * 1024 + k] = a.w; wfT[4 * 1024 + k] = b.x; wfT[5 * 1024 + k] = b.y; wfT[6 * 1024 + k] = b.z; wfT[7 * 1024 + k] = b.w; }
    __syncthreads();
    half_t* XH = (half_t*)(P.ws + WS_XH); float* LOGF = (float*)(P.ws + WS_LOGF);
    if (xw) { f4_t wfr[8][4];
#pragma unroll
      for (int h = 0; h < 8; ++h)
#pragma unroll
          for (int j = 0; j < 4; ++j) wfr[h][j] = *(const LAS f4_t*)(wfT + h * 1024 + 256 * j + 4 * lane);
      const int hsel = ((lane >> 5) & 1) * 4 + ((lane >> 4) & 1) * 2 + ((lane >> 3) & 1);
      const float bfg = P.b_forget[hsel];
      f4_t vc[2][4], vn[2][4];
      int row = 2 * gw;
      if (row < T) {
#pragma unroll
          for (int q = 0; q < 2; ++q) { const f4_t* xr = (const f4_t*)(P.x + (size_t)(row + q) * DM) + lane;
#pragma unroll
              for (int j = 0; j < 4; ++j) vc[q][j] = xr[64 * j]; } }
      for (; row < T; row += 2 * ngw) {
          const int nrow = row + 2 * ngw;
          if (nrow < T) {
#pragma unroll
              for (int q = 0; q < 2; ++q) { const f4_t* xr = (const f4_t*)(P.x + (size_t)(nrow + q) * DM) + lane;
#pragma unroll
                  for (int j = 0; j < 4; ++j) vn[q][j] = xr[64 * j]; } }
#pragma unroll
          for (int q = 0; q < 2; ++q) {
#pragma unroll
              for (int j = 0; j < 4; ++j) { unsigned long long w = (unsigned long long)pkh(vc[q][j].x, vc[q][j].y) | ((unsigned long long)pkh(vc[q][j].z, vc[q][j].w) << 32);
                  *(unsigned long long*)(XH + (size_t)(row + q) * DM + 256 * j + 4 * lane) = w; }
              float a[8];
#pragma unroll
              for (int h = 0; h < 8; ++h) { float t = 0.f;
#pragma unroll
                  for (int j = 0; j < 4; ++j) t += vc[q][j].x * wfr[h][j].x + vc[q][j].y * wfr[h][j].y + vc[q][j].z * wfr[h][j].z + vc[q][j].w * wfr[h][j].w;
                  a[h] = t; }
              float b4[4], b2[2], b1;
              { const bool up = (lane & 32) != 0;
#pragma unroll
                for (int i = 0; i < 4; ++i) { const float keep = up ? a[i + 4] : a[i], send = up ? a[i] : a[i + 4]; b4[i] = keep + __shfl_xor(send, 32); } }
              { const bool up = (lane & 16) != 0;
#pragma unroll
                for (int i = 0; i < 2; ++i) { const float keep = up ? b4[i + 2] : b4[i], send = up ? b4[i] : b4[i + 2]; b2[i] = keep + __shfl_xor(send, 16); } }
              { const bool up = (lane & 8) != 0; const float keep = up ? b2[1] : b2[0], send = up ? b2[0] : b2[1]; b1 = keep + __shfl_xor(send, 8); }
              b1 += __shfl_xor(b1, 4); b1 += __shfl_xor(b1, 2); b1 += __shfl_xor(b1, 1);
              if ((lane & 7) == 0) { const float z = b1 + bfg; const float ls = (z >= 0.f) ? -log1pf(expf(-z)) : (z - log1pf(expf(z))); LOGF[(size_t)(row + q) * 8 + hsel] = ls; }
          }
#pragma unroll
          for (int q = 0; q < 2; ++q)
#pragma unroll
              for (int j = 0; j < 4; ++j) vc[q][j] = vn[q][j];
      }
    }
    if (!xw) {
    half_t* MEMH = (half_t*)(P.ws + WS_MEMH);
    for (int row = gw; row < MROWS; row += ngw) {
        const f4_t* xr = (const f4_t*)(P.mem + (size_t)row * DM) + lane;
#pragma unroll
        for (int j = 0; j < 4; ++j) { const f4_t v = xr[64 * j]; unsigned long long w = (unsigned long long)pkh(v.x, v.y) | ((unsigned long long)pkh(v.z, v.w) << 32);
            *(unsigned long long*)(MEMH + (size_t)row * DM + 256 * j + 4 * lane) = w; }
    }
    { half_t* WRH = (half_t*)(P.ws + WS_WR); half_t* WRL = WRH + 48 * 1024;
      for (int i = gw * 64 + lane; i < 48 * 1024; i += ngw * 64) { const int r = i >> 10, k = i & 1023; float v = 0.f;
          if (r < 4) v = P.w_rg[k * 4 + r]; else if (r < 36) { const int g = (r - 4) >> 3, e = (r - 4) & 7; v = P.w_re[((size_t)g * 1024 + k) * 8 + e]; }
          v *= 32.f * P.ln_x_g[k]; const half_t hi = (half_t)v; const half_t lo = (half_t)(v - (float)hi); WRH[i] = hi; WRL[i] = lo; }
      for (int r = gw; r < 48; r += ngw) { float pu = 0.f, pc = 0.f;
          for (int k = lane; k < 1024; k += 64) { float v = 0.f;
              if (r < 4) v = P.w_rg[k * 4 + r]; else if (r < 36) { const int g = (r - 4) >> 3, e = (r - 4) & 7; v = P.w_re[((size_t)g * 1024 + k) * 8 + e]; }
              pu += 32.f * v * P.ln_x_g[k]; pc += 32.f * v * P.ln_x_b[k]; }
          pu = wave_sum(pu); pc = wave_sum(pc);
          if (lane == 0) { ((float*)(P.ws + WS_CTL))[CW_UR + r] = pu; ((float*)(P.ws + WS_CTL))[CW_CR + r] = pc; } } }
    { half_t* WQS = (half_t*)(P.ws + WS_WQS);
      for (int i = gw * 64 + lane; i < 1024 * 256; i += ngw * 64) { const int k = i >> 8; const f4_t v = *(const f4_t*)(P.w_xq + (size_t)i * 4) * P.ln_mix_g[k];
          *(unsigned long long*)(WQS + (size_t)i * 4) = (unsigned long long)pkh(v.x, v.y) | ((unsigned long long)pkh(v.z, v.w) << 32); } }
    constexpr int I_IN = 16 * 73, I_DD = 16 * 32, I_KV = 16 * 64, I_G = 16 * 16, I_D = 8 * 32;
    constexpr int NIT = I_IN + 3 * I_DD + I_KV;
    half_t* WIN = (half_t*)(P.ws + WS_WIN); half_t* WMO = (half_t*)(P.ws + WS_WMO); half_t* WXQ = (half_t*)(P.ws + WS_WXQ); half_t* WXK = (half_t*)(P.ws + WS_WXK);
    half_t* WXO = (half_t*)(P.ws + WS_WXO); half_t* WGU = (half_t*)(P.ws + WS_WGU); half_t* WD = (half_t*)(P.ws + WS_WD);
    for (int it = gw; it < NIT; it += ngw) {
        int r = it;
        if (r < I_IN) { tr_item(P.w_in, INW, INW, WIN, 1024, scr, 64 * (r / 73), 32 * (r % 73), lane, [](int c) { return win_dest(c); }); continue; } r -= I_IN;
        if (r < I_DD) { tr_item(P.w_mix_out, 1024, 1024, WMO, 1024, scr, 64 * (r / 32), 32 * (r % 32), lane, [](int c) { return c; }); continue; } r -= I_DD;
        if (r < I_DD) { tr_item_ln(P.w_xq, 1024, WXQ, scr, 64 * (r / 32), 32 * (r % 32), lane, P.ln_mix_g, P.ln_mix_b, (float*)(P.ws + WS_CTL) + CW_U1, (float*)(P.ws + WS_CTL) + CW_C1, [](int c) { return c; }); continue; } r -= I_DD;
        if (r < I_DD) { tr_item(P.w_xout, 1024, 1024, WXO, 1024, scr, 64 * (r / 32), 32 * (r % 32), lane, [](int c) { return c; }); continue; } r -= I_DD;
        tr_item(P.w_xkv, 2048, 2048, WXK, 1024, scr, 64 * (r / 64), 32 * (r % 64), lane, [](int c) { return c; });
    }
    }
}

__device__ __forceinline__ void scan_bh(const Params& P, LAS float* sh, int bh) {
    const int tid = threadIdx.x, lane = tid & 63, wave = tid >> 6, b = bh >> 3, h = bh & 7;
    const float* LOGF = (const float*)(P.ws + WS_LOGF); float* CUM = (float*)(P.ws + WS_CUM);
    float v[8]; float run = 0.f;
#pragma unroll
    for (int i = 0; i < 8; ++i) { run += LOGF[((size_t)b * SEQ + tid * 8 + i) * 8 + h]; v[i] = run; }
    float inc = run;
#pragma unroll
    for (int o = 1; o < 64; o <<= 1) { const float t = __shfl_up(inc, o); if (lane >= o) inc += t; }
    if (lane == 63) sh[wave] = inc;
    __syncthreads();
    float base = inc - run;
    for (int w = 0; w < wave; ++w) base += sh[w];
    half_t* BK = (half_t*)(P.ws + WS_BK);
#pragma unroll
    for (int i = 0; i < 8; ++i) { const float c = base + v[i]; CUM[(size_t)bh * SEQ + tid * 8 + i] = c;
        const float bias = -c * LOG2E; const half_t bh_ = (half_t)bias; const half_t bl_ = (half_t)(bias - (float)bh_);
        u4_t w; w.x = (unsigned)__builtin_bit_cast(unsigned short, bh_) | ((unsigned)__builtin_bit_cast(unsigned short, bl_) << 16); w.y = 0x3C003C00u; w.z = 0u; w.w = 0u;
        *(u4_t*)(BK + ((size_t)bh * SEQ + tid * 8 + i) * 8) = w; }
    if ((tid & 7) == 7) sh[16 + (tid >> 3)] = base + v[7];
    if ((tid & 31) == 0) sh[80 + (tid >> 5)] = base + v[0];
    __syncthreads();
    if (tid < 16) { const float cq = sh[80 + tid]; int t = 0; while (t < 4 * tid && (sh[16 + t] - cq) * LOG2E > FOX_CUT) ++t; ((int*)(P.ws + WS_TS))[bh * 16 + tid] = t & ~1; }
    __syncthreads();
}

template <class F>
__device__ __forceinline__ void gemm_naive_phase(const F& f, LAS unsigned char* lds, int wg, int nwg, int nz, int Mmax, int N) {
    LAS float* As = (LAS float*)lds;
    LAS float* Bs = As + 16 * 68;
    const int K = f.K, tid = threadIdx.x;
    const int ntm = Mmax / 64, ntn = N / 128, per = ntm * ntn, total = nz * per;
    const int lr = tid >> 2, lk = (tid & 3) * 4, ty = tid >> 5, tx = tid & 31;
    for (int it = wg; it < total; it += nwg) {
        const int z = it / per, r = it % per, m0 = (r / ntn) * 64, n0 = (r % ntn) * 128;
        if (m0 >= f.mrows(z)) continue;
        const half_t* ap = f.arow(z, m0 + (lr & 63)) + lk; const half_t* bp = f.brow(z, n0 + lr) + lk;
        float acc[4][4];
#pragma unroll
        for (int i = 0; i < 4; ++i)
#pragma unroll
            for (int j = 0; j < 4; ++j) acc[i][j] = 0.f;
        for (int k0 = 0; k0 < K; k0 += 16) {
            const h4_t av = *(const h4_t*)(ap + k0), bv = *(const h4_t*)(bp + k0);
            __syncthreads();
#pragma unroll
            for (int i = 0; i < 4; ++i) { if (tid < 256) As[(lk + i) * 68 + lr] = (float)av[i]; Bs[(lk + i) * 132 + lr] = (float)bv[i]; }
            __syncthreads();
#pragma unroll
            for (int k = 0; k < 16; ++k) { const f4_t a = *(const LAS f4_t*)&As[k * 68 + ty * 4], b = *(const LAS f4_t*)&Bs[k * 132 + tx * 4];
#pragma unroll
                for (int i = 0; i < 4; ++i)
#pragma unroll
                    for (int j = 0; j < 4; ++j) acc[i][j] += a[i] * b[j]; }
        }
#pragma unroll
        for (int i = 0; i < 4; ++i) f.epi(z, m0 + ty * 4 + i, n0 + tx * 4, acc[i]);
    }
    __syncthreads();
}

struct FZ {
    const half_t* XH; const half_t* WIN; half_t* Z; const int* pos; int K, pad;
    __device__ int mrows(int) const { return T; }
    __device__ const half_t* arow(int, int m) const { return XH + (size_t)m * DM; }
    __device__ const half_t* brow(int, int n) const { return WIN + (size_t)n * DM; }
    __device__ void epi(int, int m, int n0, float* v) const {
        float o[4] = {v[0], v[1], v[2], v[3]};
        if (n0 >= ZQS && n0 < ZVS) { const int p = pos[m]; const int i0 = (n0 & 63) >> 1; float c, s;
            rope_cs(p, i0, c, s); o[0] = v[0] * c - v[1] * s; o[1] = v[1] * c + v[0] * s;
            rope_cs(p, i0 + 1, c, s); o[2] = v[2] * c - v[3] * s; o[3] = v[3] * c + v[2] * s; }
        if (n0 < ZKF || (n0 >= ZQS && n0 < ZKS)) { o[0] *= C2_64; o[1] *= C2_64; o[2] *= C2_64; o[3] *= C2_64; }
        unsigned long long w = (unsigned long long)pkh(o[0], o[1]) | ((unsigned long long)pkh(o[2], o[3]) << 32);
        *(unsigned long long*)(Z + (size_t)m * ZW + n0) = w;
    }
};
struct FPlain {
    const half_t* A; const half_t* B; half_t* C; int lda, ldb, ldc, M; float scale; int K;
    __device__ int mrows(int) const { return M; }
    __device__ const half_t* arow(int, int m) const { return A + (size_t)m * lda; }
    __device__ const half_t* brow(int, int n) const { return B + (size_t)n * ldb; }
    __device__ void epi(int, int m, int n0, float* v) const {
        unsigned long long w = (unsigned long long)pkh(v[0] * scale, v[1] * scale) | ((unsigned long long)pkh(v[2] * scale, v[3] * scale) << 32);
        *(unsigned long long*)(C + (size_t)m * ldc + n0) = w;
    }
};
struct FTmp {
    const half_t* A; const half_t* B; float* C; int K, pad;
    __device__ int mrows(int) const { return T; }
    __device__ const half_t* arow(int, int m) const { return A + (size_t)m * DM; }
    __device__ const half_t* brow(int, int n) const { return B + (size_t)n * DM; }
    __device__ void epi(int, int m, int n0, float* v) const { *(f4_t*)(C + (size_t)m * DM + n0) = (f4_t){v[0], v[1], v[2], v[3]}; }
};
struct FPV {
    const half_t* PX; const half_t* VXT; half_t* OX; int K, pad;
    __device__ int mrows(int) const { return SEQ; }
    __device__ const half_t* arow(int z, int m) const { return PX + ((size_t)(z >> 2) * SEQ + m) * DM + (z & 3) * 256; }
    __device__ const half_t* brow(int z, int n) const { return VXT + ((size_t)(z & 3) * 256 + n) * MROWS + (z >> 2) * 256; }
    __device__ void epi(int z, int m, int n0, float* v) const {
        unsigned long long w = (unsigned long long)pkh(v[0], v[1]) | ((unsigned long long)pkh(v[2], v[3]) << 32);
        *(unsigned long long*)(OX + ((size_t)(z >> 2) * SEQ + m) * DM + (z & 3) * 256 + n0) = w;
    }
};
__device__ __forceinline__ int pbase_of(const unsigned* cnt, int e) { int b = 0; for (int i = 0; i < e; ++i) b += ((int)cnt[i] + 255) & ~255; return b; }
struct FGU {
    const half_t* H2; const half_t* WGU; half_t* ACT; const unsigned* cnt; const int* ltok; int K, pad;
    __device__ int mrows(int z) const { return (int)cnt[z]; }
    __device__ const half_t* arow(int z, int m) const { const int c = (int)cnt[z]; const int tk = (m < c) ? (ltok[(size_t)z * LCAP + m] >> 1) : 0; return H2 + (size_t)tk * DM; }
    __device__ const half_t* brow(int z, int n) const { return WGU + ((size_t)z * 1024 + n) * 1024; }
    __device__ void epi(int z, int m, int n0, float* v) const {
        const float a0 = v[0] / (1.f + expf(-v[0])) * v[1], a1 = v[2] / (1.f + expf(-v[2])) * v[3];
        *(unsigned*)(ACT + ((size_t)pbase_of(cnt, z) + m) * DEXP + (n0 >> 1)) = pkh(a0, a1);
    }
};
struct FDown {
    const half_t* ACT; const half_t* WD; half_t* Y; const unsigned* cnt; const int* ltok; const float* lw; int K, pad;
    __device__ int mrows(int z) const { return (int)cnt[z]; }
    __device__ const half_t* arow(int z, int m) const { return ACT + ((size_t)pbase_of(cnt, z) + m) * DEXP; }
    __device__ const half_t* brow(int z, int n) const { return WD + ((size_t)z * 1024 + n) * DEXP; }
    __device__ void epi(int z, int m, int n0, float* v) const {
        if (m >= (int)cnt[z]) return;
        const int t2 = ltok[(size_t)z * LCAP + m]; const float g = lw[(size_t)z * LCAP + m];
        unsigned long long w = (unsigned long long)pkh(v[0] * g, v[1] * g) | ((unsigned long long)pkh(v[2] * g, v[3] * g) << 32);
        *(unsigned long long*)(Y + (size_t)t2 * DM + n0) = w;
    }
};

template <int MODE>
__device__ __forceinline__ void attn_naive_item(const Params& P, int tblk, int bh, int lane) {
    const half_t* Z = (const half_t*)(P.ws + WS_Z); half_t* O = (half_t*)(P.ws + WS_O); const float* CUM = (const float*)(P.ws + WS_CUM);
    const int t0 = tblk * 64, t = t0 + lane, b = bh >> 3, h = bh & 7;
    const int qcol = (MODE == 0) ? ZQF + h * 64 : ZQS + h * 64;
    const int kcol = (MODE == 0) ? ZKF + h * 64 : ZKS + (h >> 2) * 64;
    const int vcol = (MODE == 0) ? ZVF + h * 64 : ZVS + (h >> 2) * 64;
    float q[64], o[64];
    { const half_t* qp = Z + ((size_t)b * SEQ + t) * ZW + qcol;
#pragma unroll
      for (int d = 0; d < 64; ++d) { q[d] = (float)qp[d]; o[d] = 0.f; } }
    float m = -INFINITY, l = 0.f;
    const float ct = (MODE == 0) ? CUM[(size_t)bh * SEQ + t] * LOG2E : 0.f;
    const int s_lo = (MODE == 0) ? 0 : ((t0 - 127 > 0) ? t0 - 127 : 0), s_hi = t0 + 63;
    for (int s = s_lo; s <= s_hi; ++s) {
        const half_t* kp = Z + ((size_t)b * SEQ + s) * ZW + kcol; const half_t* vp = Z + ((size_t)b * SEQ + s) * ZW + vcol;
        float sc = 0.f;
#pragma unroll
        for (int d8 = 0; d8 < 8; ++d8) { const h8_t kv = *(const h8_t*)(kp + d8 * 8);
#pragma unroll
            for (int j = 0; j < 8; ++j) sc += q[d8 * 8 + j] * (float)kv[j]; }
        bool ok = (s <= t);
        if (MODE == 0) sc += ct - CUM[(size_t)bh * SEQ + s] * LOG2E; else ok = ok && (t - s < 128);
        if (ok) {
            const float mn = fmaxf(m, sc), f = exp2f(m - mn), p = exp2f(sc - mn);
            l = l * f + p; m = mn;
#pragma unroll
            for (int d8 = 0; d8 < 8; ++d8) { const h8_t vv = *(const h8_t*)(vp + d8 * 8);
#pragma unroll
                for (int j = 0; j < 8; ++j) o[d8 * 8 + j] = o[d8 * 8 + j] * f + p * (float)vv[j]; }
        }
    }
    if (MODE == 1) l += exp2f(P.sinks[h] * LOG2E - m);
    const float rl = 1.f / l;
    half_t* op = O + ((size_t)b * SEQ + t) * DM + ((MODE == 0) ? 0 : 512) + h * 64;
#pragma unroll
    for (int d = 0; d < 64; d += 2) *(unsigned*)(op + d) = pkh(o[d] * rl, o[d + 1] * rl);
}

__device__ __forceinline__ void xs_naive_item(const Params& P, LAS unsigned char* lds, int item) {
    const half_t* QX = (const half_t*)(P.ws + WS_QX); const half_t* KX = (const half_t*)(P.ws + WS_KX); half_t* PX = (half_t*)(P.ws + WS_PX);
    LAS float (*S)[257] = (LAS float (*)[257])lds;
    const int tid = threadIdx.x, r = tid >> 4, c = tid & 15, t = (item >> 2) * 32 + r, h = item & 3, b = t / SEQ;
    const half_t* qp = QX + (size_t)t * DM + h * 256;
    float acc[16];
#pragma unroll
    for (int j = 0; j < 16; ++j) acc[j] = 0.f;
    for (int d0 = 0; d0 < 256; d0 += 8) { const h8_t qv = *(const h8_t*)(qp + d0);
#pragma unroll
        for (int j = 0; j < 16; ++j) { const h8_t kv = *(const h8_t*)(KX + ((size_t)b * 256 + c + 16 * j) * DM + h * 256 + d0);
#pragma unroll
            for (int i = 0; i < 8; ++i) acc[j] += (float)qv[i] * (float)kv[i]; } }
#pragma unroll
    for (int j = 0; j < 16; ++j) S[r][c + 16 * j] = acc[j];
    __syncthreads();
    float mx = -INFINITY;
    for (int j = 0; j < 16; ++j) mx = fmaxf(mx, S[r][c + 16 * j]);
#pragma unroll
    for (int o = 1; o < 16; o <<= 1) mx = fmaxf(mx, __shfl_xor(mx, o));
    float sum = 0.f;
    for (int j = 0; j < 16; ++j) { const float p = exp2f(S[r][c + 16 * j] - mx); S[r][c + 16 * j] = p; sum += p; }
#pragma unroll
    for (int o = 1; o < 16; o <<= 1) sum += __shfl_xor(sum, o);
    const float rs = 1.f / sum;
    for (int j = 0; j < 16; ++j) PX[(size_t)t * DM + h * 256 + c + 16 * j] = (half_t)(S[r][c + 16 * j] * rs);
    __syncthreads();
}

template <int MODE>
__device__ __forceinline__ void ln_naive_row(const Params& P, int row, int lane) {
    const float* TMP = (const float*)(P.ws + WS_TMP);
    const half_t* H1 = (const half_t*)(P.ws + WS_H1);
    f4_t v[4]; float s = 0.f;
#pragma unroll
    for (int j = 0; j < 4; ++j) { const int c = 256 * j + 4 * lane; f4_t r;
        if (MODE == 0) r = *(const f4_t*)(P.x + (size_t)row * DM + c); else { const h4_t hh = *(const h4_t*)(H1 + (size_t)row * DM + c); r = (f4_t){(float)hh[0], (float)hh[1], (float)hh[2], (float)hh[3]}; }
        v[j] = r * ALPHA + *(const f4_t*)(TMP + (size_t)row * DM + c); s += (v[j].x + v[j].y) + (v[j].z + v[j].w); }
    const float mean = wave_sum(s) * (1.f / DM); float s2 = 0.f;
#pragma unroll
    for (int j = 0; j < 4; ++j) { v[j] = v[j] - mean; s2 += (v[j].x * v[j].x + v[j].y * v[j].y) + (v[j].z * v[j].z + v[j].w * v[j].w); }
    const float rstd = 1.f / sqrtf(wave_sum(s2) * (1.f / DM) + LN_EPS);
    const float* G = (MODE == 0) ? P.ln_mix_g : P.ln_x_g; const float* B = (MODE == 0) ? P.ln_mix_b : P.ln_x_b;
    half_t* OUT = (half_t*)(P.ws + ((MODE == 0) ? WS_H1 : WS_H2));
#pragma unroll
    for (int j = 0; j < 4; ++j) { const int c = 256 * j + 4 * lane; v[j] = v[j] * rstd * *(const f4_t*)(G + c) + *(const f4_t*)(B + c);
        unsigned long long w = (unsigned long long)pkh(v[j].x, v[j].y) | ((unsigned long long)pkh(v[j].z, v[j].w) << 32);
        *(unsigned long long*)(OUT + (size_t)row * DM + c) = w; }
    if (MODE == 1) {
        float* LG = (float*)(P.ws + WS_LG);
        for (int r = 0; r < 36; ++r) { float a = 0.f;
#pragma unroll
            for (int j = 0; j < 4; ++j) { const int c = 256 * j + 4 * lane;
#pragma unroll
                for (int i = 0; i < 4; ++i) { const int k = c + i; const float w = (r < 4) ? P.w_rg[k * 4 + r] : P.w_re[((size_t)((r - 4) >> 3) * 1024 + k) * 8 + ((r - 4) & 7)]; a += v[j][i] * w; } }
            a = wave_sum(a);
            if (lane == 0) { LG[(size_t)row * 48 + r] = a * 32.f; LG[((size_t)T + row) * 48 + r] = 0.f; LG[((size_t)2 * T + row) * 48 + r] = 0.f; LG[((size_t)3 * T + row) * 48 + r] = 0.f; } }
    }
}

__device__ __forceinline__ void route_tokens(const Params& P, LAS unsigned* sh  , int t0) {
    const int tid = threadIdx.x;
    const float* LG = (const float*)(P.ws + WS_LG); unsigned* CNT = (unsigned*)(P.ws + WS_CTL) + CW_CNT;
    int* LTOK = (int*)(P.ws + WS_LTOK); float* LW = (float*)(P.ws + WS_LW);
    if (tid < 64) sh[tid] = 0u;
    __syncthreads();
    int e0 = 0, e1 = 0; float g0 = 0.f, g1 = 0.f; unsigned s0 = 0, s1 = 0;
    if (tid < 128) {
        const int t = t0 + tid;
        float lg[36];
#pragma unroll
        for (int r = 0; r < 36; ++r) lg[r] = (LG[(size_t)t * 48 + r] + LG[((size_t)T + t) * 48 + r] + LG[((size_t)2 * T + t) * 48 + r] + LG[((size_t)3 * T + t) * 48 + r]) * (1.f / 32.f);
        float pg[4]; float mx = -INFINITY;
#pragma unroll
        for (int g = 0; g < 4; ++g) { pg[g] = lg[g] + P.b_rg[g]; mx = fmaxf(mx, pg[g]); }
        float sum = 0.f;
#pragma unroll
        for (int g = 0; g < 4; ++g) { pg[g] = expf(pg[g] - mx); sum += pg[g]; }
        int gi = 0; float gv = pg[0];
#pragma unroll
        for (int g = 1; g < 4; ++g) if (pg[g] > gv) { gv = pg[g]; gi = g; }
        gv /= sum;
        float sel[8];
#pragma unroll
        for (int e = 0; e < 8; ++e) { float a = lg[4 + e];
#pragma unroll
            for (int g = 1; g < 4; ++g) a = (gi == g) ? lg[4 + 8 * g + e] : a;
            sel[e] = a + P.b_re[gi * 8 + e]; }
        int i0 = 0; float v0 = sel[0];
#pragma unroll
        for (int e = 1; e < 8; ++e) if (sel[e] > v0) { v0 = sel[e]; i0 = e; }
        int i1 = -1; float v1 = -INFINITY;
#pragma unroll
        for (int e = 0; e < 8; ++e) if (e != i0 && sel[e] > v1) { v1 = sel[e]; i1 = e; }
        const float p1 = expf(v1 - v0), den = 1.f + p1;
        g0 = gv / den; g1 = gv * p1 / den; e0 = gi * 8 + i0; e1 = gi * 8 + i1;
        s0 = atomicAdd((unsigned*)&sh[e0], 1u); s1 = atomicAdd((unsigned*)&sh[e1], 1u);
    }
    __syncthreads();
    if (tid < 32) { const unsigned c = sh[tid]; sh[32 + tid] = c ? atomicAdd(&CNT[tid], c) : 0u; }
    __syncthreads();
    if (tid < 128) {
        const int t = t0 + tid; const unsigned d0 = sh[32 + e0] + s0, d1 = sh[32 + e1] + s1;
        LTOK[(size_t)e0 * LCAP + d0] = 2 * t; LW[(size_t)e0 * LCAP + d0] = g0;
        LTOK[(size_t)e1 * LCAP + d1] = 2 * t + 1; LW[(size_t)e1 * LCAP + d1] = g1;
    }
    __syncthreads();
}

__device__ __forceinline__ void route_tokens_fast(const Params& P, LAS unsigned char* lds, int t0) {
    typedef float f32x4 __attribute__((ext_vector_type(4)));
    const int tid = threadIdx.x, lane = tid & 63, wave = tid >> 6, fr = lane & 15, fq = lane >> 4;
    const half_t* H2 = (const half_t*)(P.ws + WS_V2); const half_t* WR = (const half_t*)(P.ws + WS_WR);
    LAS float* LGT = (LAS float*)(lds + 102400); LAS unsigned* sh = (LAS unsigned*)(lds + 126976);
    f32x4 acc[3];
#pragma unroll
    for (int et = 0; et < 3; ++et) acc[et] = (f32x4){0.f, 0.f, 0.f, 0.f};
    const half_t* hrow = H2 + (size_t)(t0 + wave * 16 + fr) * DM + 8 * fq;
    h8_t bfr[32];
#pragma unroll
    for (int ks = 0; ks < 32; ++ks) bfr[ks] = *(const h8_t*)(hrow + ks * 32);
#pragma unroll
    for (int kh = 0; kh < 2; ++kh) {
        __syncthreads();
#pragma unroll
        for (int it = 0; it < 12; ++it) { const int i = tid + it * 512; const int p = i / (48 * 64), r = (i / 64) % 48, c = i % 64;
            *(LAS u4_t*)(lds + (p * 48 + r) * 1040 + c * 16) = *(const u4_t*)(WR + (size_t)p * 48 * 1024 + (size_t)r * 1024 + kh * 512 + c * 8); }
        __syncthreads();
#pragma unroll
        for (int ks = 0; ks < 16; ++ks) {
            const h8_t b = bfr[kh * 16 + ks];
#pragma unroll
            for (int et = 0; et < 3; ++et) {
                const h8_t whi = *(const LAS h8_t*)(lds + (et * 16 + fr) * 1040 + ks * 64 + fq * 16);
                const h8_t wlo = *(const LAS h8_t*)(lds + (48 + et * 16 + fr) * 1040 + ks * 64 + fq * 16);
                acc[et] = __builtin_amdgcn_mfma_f32_16x16x32_f16(whi, b, acc[et], 0, 0, 0);
                acc[et] = __builtin_amdgcn_mfma_f32_16x16x32_f16(wlo, b, acc[et], 0, 0, 0);
            }
        }
    }
#pragma unroll
    for (int et = 0; et < 3; ++et)
#pragma unroll
        for (int r = 0; r < 4; ++r) LGT[(wave * 16 + fr) * 48 + et * 16 + 4 * fq + r] = acc[et][r];
    if (tid < 64) sh[tid] = 0u;
    __syncthreads();
    unsigned* CNT = (unsigned*)(P.ws + WS_CTL) + CW_CNT; int* LTOK = (int*)(P.ws + WS_LTOK); float* LW = (float*)(P.ws + WS_LW);
    int e0 = 0, e1 = 0; float g0 = 0.f, g1 = 0.f; unsigned s0 = 0, s1 = 0;
    float rmean = 0.f, rrstd = 0.f;
    if (tid < 128) {
        { const f4_t* p = (const f4_t*)((const float*)(P.ws + WS_ST2) + ((size_t)(t0 + tid) * 16) * 2); float sm = 0.f, sq = 0.f;
#pragma unroll
          for (int k = 0; k < 8; ++k) { const f4_t t = p[k]; sm += t[0] + t[2]; sq += t[1] + t[3]; }
          rmean = sm * (1.f / DM); rrstd = 1.0f / sqrtf(sq * (1.f / DM) - rmean * rmean + LN_EPS);
          *(f2_t*)((float*)(P.ws + WS_MR2) + (size_t)(t0 + tid) * 2) = (f2_t){rmean, rrstd}; }
        const float* UR = (const float*)(P.ws + WS_CTL) + CW_UR; const float* CR = (const float*)(P.ws + WS_CTL) + CW_CR;
        float lg[36];
#pragma unroll
        for (int r = 0; r < 36; ++r) lg[r] = (rrstd * LGT[tid * 48 + r] - rrstd * rmean * UR[r] + CR[r]) * (1.f / 32.f);
        float pg[4]; float mx = -INFINITY;
#pragma unroll
        for (int g = 0; g < 4; ++g) { pg[g] = lg[g] + P.b_rg[g]; mx = fmaxf(mx, pg[g]); }
        float sum = 0.f;
#pragma unroll
        for (int g = 0; g < 4; ++g) { pg[g] = expf(pg[g] - mx); sum += pg[g]; }
        int gi = 0; float gv = pg[0];
#pragma unroll
        for (int g = 1; g < 4; ++g) if (pg[g] > gv) { gv = pg[g]; gi = g; }
        gv /= sum;
        float sel[8];
#pragma unroll
        for (int e = 0; e < 8; ++e) { float a = lg[4 + e];
#pragma unroll
            for (int g = 1; g < 4; ++g) a = (gi == g) ? lg[4 + 8 * g + e] : a;
            sel[e] = a + P.b_re[gi * 8 + e]; }
        int i0 = 0; float v0 = sel[0];
#pragma unroll
        for (int e = 1; e < 8; ++e) if (sel[e] > v0) { v0 = sel[e]; i0 = e; }
        int i1 = -1; float v1 = -INFINITY;
#pragma unroll
        for (int e = 0; e < 8; ++e) if (e != i0 && sel[e] > v1) { v1 = sel[e]; i1 = e; }
        const float p1 = expf(v1 - v0), den = 1.f + p1;
        g0 = gv / den; g1 = gv * p1 / den; e0 = gi * 8 + i0; e1 = gi * 8 + i1;
        s0 = atomicAdd((unsigned*)&sh[e0], 1u); s1 = atomicAdd((unsigned*)&sh[e1], 1u);
    }
    __syncthreads();
    if (tid < 32) { const unsigned c = sh[tid]; sh[32 + tid] = c ? atomicAdd(&CNT[tid], c) : 0u; }
    __syncthreads();
    if (tid < 128) {
        const int t = t0 + tid; const unsigned d0 = sh[32 + e0] + s0, d1 = sh[32 + e1] + s1;
        LTOK[(size_t)e0 * LCAP + d0] = 2 * t; LW[(size_t)e0 * LCAP + d0] = g0;
        LTOK[(size_t)e1 * LCAP + d1] = 2 * t + 1; LW[(size_t)e1 * LCAP + d1] = g1;
        float* LMR = (float*)(P.ws + WS_LMR);
        *(f2_t*)(LMR + ((size_t)e0 * LCAP + d0) * 2) = (f2_t){rmean, rrstd}; *(f2_t*)(LMR + ((size_t)e1 * LCAP + d1) * 2) = (f2_t){rmean, rrstd};
    }
    __syncthreads();
}

__device__ __forceinline__ void final_ln_row(const Params& P, int row, int lane) {
    const half_t* H2 = (const half_t*)(P.ws + WS_H2); const half_t* Y = (const half_t*)(P.ws + WS_Y);
    f4_t v[4]; float s = 0.f;
#pragma unroll
    for (int j = 0; j < 4; ++j) { const int c = 256 * j + 4 * lane;
        const h4_t hh = *(const h4_t*)(H2 + (size_t)row * DM + c), y0 = *(const h4_t*)(Y + (size_t)(2 * row) * DM + c), y1 = *(const h4_t*)(Y + (size_t)(2 * row + 1) * DM + c);
#pragma unroll
        for (int i = 0; i < 4; ++i) v[j][i] = ALPHA * (float)hh[i] + ((float)y0[i] + (float)y1[i]);
        s += (v[j].x + v[j].y) + (v[j].z + v[j].w); }
    const float mean = wave_sum(s) * (1.f / DM); float s2 = 0.f;
#pragma unroll
    for (int j = 0; j < 4; ++j) { v[j] = v[j] - mean; s2 += (v[j].x * v[j].x + v[j].y * v[j].y) + (v[j].z * v[j].z + v[j].w * v[j].w); }
    const float rstd = 1.f / sqrtf(wave_sum(s2) * (1.f / DM) + LN_EPS);
#pragma unroll
    for (int j = 0; j < 4; ++j) { const int c = 256 * j + 4 * lane; *(f4_t*)(P.out + (size_t)row * DM + c) = v[j] * rstd * *(const f4_t*)(P.ln_f_g + c) + *(const f4_t*)(P.ln_f_b + c); }
}

__device__ __forceinline__ void final_ln_row2(const Params& P, int row, int lane) {
    const half_t* H2 = (const half_t*)(P.ws + WS_V2); const half_t* Y = (const half_t*)(P.ws + WS_Y);
    const f2_t mr0 = *(const f2_t*)((const float*)(P.ws + WS_MR2) + (size_t)row * 2), mr1 = *(const f2_t*)((const float*)(P.ws + WS_MR2) + (size_t)(row + 1) * 2);
    f4_t g2v[4], b2v[4];
#pragma unroll
    for (int j = 0; j < 4; ++j) { g2v[j] = *(const f4_t*)(P.ln_x_g + 256 * j + 4 * lane); b2v[j] = *(const f4_t*)(P.ln_x_b + 256 * j + 4 * lane); }
    h4_t hh[2][4], y0[2][4], y1[2][4];
#pragma unroll
    for (int q = 0; q < 2; ++q)
#pragma unroll
        for (int j = 0; j < 4; ++j) { const int c = 256 * j + 4 * lane; hh[q][j] = *(const h4_t*)(H2 + (size_t)(row + q) * DM + c); y0[q][j] = *(const h4_t*)(Y + (size_t)(2 * (row + q)) * DM + c); y1[q][j] = *(const h4_t*)(Y + (size_t)(2 * (row + q) + 1) * DM + c); }
    f4_t gv[4], bv[4];
#pragma unroll
    for (int j = 0; j < 4; ++j) { const int c = 256 * j + 4 * lane; gv[j] = *(const f4_t*)(P.ln_f_g + c); bv[j] = *(const f4_t*)(P.ln_f_b + c); }
#pragma unroll
    for (int q = 0; q < 2; ++q) {
        f4_t v[4]; float s = 0.f;
#pragma unroll
        for (int j = 0; j < 4; ++j) {
#pragma unroll
            for (int i = 0; i < 4; ++i) { const float mean2 = q ? mr1.x : mr0.x, rstd2 = q ? mr1.y : mr0.y; const float h2v = ((float)hh[q][j][i] - mean2) * rstd2 * g2v[j][i] + b2v[j][i];
                v[j][i] = ALPHA * h2v + ((float)y0[q][j][i] + (float)y1[q][j][i]); }
            s += (v[j].x + v[j].y) + (v[j].z + v[j].w); }
        const float mean = wave_sum(s) * (1.f / DM); float s2 = 0.f;
#pragma unroll
        for (int j = 0; j < 4; ++j) { v[j] = v[j] - mean; s2 += (v[j].x * v[j].x + v[j].y * v[j].y) + (v[j].z * v[j].z + v[j].w * v[j].w); }
        const float rstd = 1.f / sqrtf(wave_sum(s2) * (1.f / DM) + LN_EPS);
#pragma unroll
        for (int j = 0; j < 4; ++j) { const int c = 256 * j + 4 * lane; *(f4_t*)(P.out + (size_t)(row + q) * DM + c) = v[j] * rstd * gv[j] + bv[j]; }
    }
}

__device__ __forceinline__ void final_ln_rows(const Params& P, int gw, int ngw, int lane) {
    const half_t* H2 = (const half_t*)(P.ws + WS_V2); const half_t* Y = (const half_t*)(P.ws + WS_Y); const float* MR = (const float*)(P.ws + WS_MR2);
    f4_t g2v[4], b2v[4], gv[4], bv[4];
#pragma unroll
    for (int j = 0; j < 4; ++j) { const int c = 256 * j + 4 * lane; g2v[j] = *(const f4_t*)(P.ln_x_g + c) * ALPHA; b2v[j] = *(const f4_t*)(P.ln_x_b + c) * ALPHA; gv[j] = *(const f4_t*)(P.ln_f_g + c); bv[j] = *(const f4_t*)(P.ln_f_b + c); }
    h4_t hh[2][4], y0[2][4], y1[2][4], nh[2][4], n0[2][4], n1[2][4]; f2_t mr[2], nm[2];
#define FL_LOAD(HH, Y0, Y1, MRR, R) do { _Pragma("unroll") for (int q = 0; q < 2; ++q) { MRR[q] = *(const f2_t*)(MR + (size_t)((R) + q) * 2); \
        _Pragma("unroll") for (int j = 0; j < 4; ++j) { const int c = 256 * j + 4 * lane; HH[q][j] = *(const h4_t*)(H2 + (size_t)((R) + q) * DM + c); \
            Y0[q][j] = *(const h4_t*)(Y + (size_t)(2 * ((R) + q)) * DM + c); Y1[q][j] = *(const h4_t*)(Y + (size_t)(2 * ((R) + q) + 1) * DM + c); } } } while (0)
    int row = 2 * gw;
    if (row < T) FL_LOAD(hh, y0, y1, mr, row);
    for (; row < T; row += 2 * ngw) {
        const int nrow = row + 2 * ngw;
        if (nrow < T) FL_LOAD(nh, n0, n1, nm, nrow);
#pragma unroll
        for (int q = 0; q < 2; ++q) {
            f4_t v[4]; float s = 0.f; const float mean2 = mr[q].x, rstd2 = mr[q].y;
#pragma unroll
            for (int j = 0; j < 4; ++j) {
#pragma unroll
                for (int i = 0; i < 4; ++i) v[j][i] = (((float)hh[q][j][i] - mean2) * rstd2 * g2v[j][i] + b2v[j][i]) + ((float)y0[q][j][i] + (float)y1[q][j][i]);
                s += (v[j].x + v[j].y) + (v[j].z + v[j].w); }
            const float mean = wave_sum(s) * (1.f / DM); float s2 = 0.f;
#pragma unroll
            for (int j = 0; j < 4; ++j) { v[j] = v[j] - mean; s2 += (v[j].x * v[j].x + v[j].y * v[j].y) + (v[j].z * v[j].z + v[j].w * v[j].w); }
            const float rstd = 1.f / sqrtf(wave_sum(s2) * (1.f / DM) + LN_EPS);
#pragma unroll
            for (int j = 0; j < 4; ++j) { const int c = 256 * j + 4 * lane; *(f4_t*)(P.out + (size_t)(row + q) * DM + c) = v[j] * rstd * gv[j] + bv[j]; }
        }
#pragma unroll
        for (int q = 0; q < 2; ++q) { mr[q] = nm[q];
#pragma unroll
            for (int j = 0; j < 4; ++j) { hh[q][j] = nh[q][j]; y0[q][j] = n0[q][j]; y1[q][j] = n1[q][j]; } }
    }
#undef FL_LOAD
}

namespace pg {
typedef float f32x4 __attribute__((ext_vector_type(4)));
constexpr int BM = 256, BK = 64, HALF = 128, HTB = HALF * BK * 2, STAGE_BYTES = 8 * HTB, NXCD = 8, WGM = 8;
__host__ __device__ __forceinline__ int lds_byte(int r, int c) { const int st = (r >> 4) * 2 + (c >> 5), rr = r & 15, cc = c & 31, ob = rr * 64 + cc * 2; return st * 1024 + (ob ^ (((ob >> 9) & 1) << 5)); }
__host__ __device__ __forceinline__ void stage_rc(int b, int& R, int& C) { const int st = b / 1024, sb = b % 1024, swz = sb ^ (((sb >> 9) & 1) << 5); R = (st >> 1) * 16 + swz / 64; C = (st & 1) * 32 + (swz % 64) / 2; }
__host__ __device__ __forceinline__ int perm32(int rho) { const int n = rho >> 4, i = rho & 15; return 8 * (i >> 2) + 4 * n + (i & 3); }
struct Unit { int pm, pn, z, rb, aux; };

struct StaticOrder {
    int nM, nN, nwg, G, c, pm0;
    __device__ void init(int nM_, int nN_, int G_, int c_, int pm0_) { nM = nM_; nN = nN_; nwg = nM * nN; G = G_; c = c_; pm0 = pm0_; }
    __device__ bool next(int i, Unit& u) const {
        const long L = (long)i * G + c; if (L >= nwg) return false;
        int wgid = (int)L; { const int q = nwg / NXCD, r = nwg % NXCD, xcd = wgid % NXCD, off = wgid / NXCD; wgid = (xcd < r ? xcd * (q + 1) : r * (q + 1) + (xcd - r) * q) + off; }
        const int nig = WGM * nN, gid = wgid / nig, fm = gid * WGM, gsz = (nM - fm) < WGM ? (nM - fm) : WGM;
        u.pm = pm0 + fm + ((wgid % nig) % gsz); u.pn = (wgid % nig) / gsz; u.z = 0; u.rb = i; u.aux = 0; return true;
    }
};
struct OneUnit {
    int pm, pn;
    __device__ bool next(int i, Unit& u) const { if (i) return false; u.pm = pm; u.pn = pn; u.z = 0; u.rb = 0; u.aux = 0; return true; }
};
struct DenseProb {
    static constexpr bool GATHER = false;
    const half_t* A; const half_t* B; size_t a_sm, a_sn, b_sn, b_sb; int lda, ldb, K, pad;
    __device__ __forceinline__ const char* a_ptr(const Unit& u) const { return (const char*)(A + (size_t)u.pm * a_sm + (size_t)u.pn * a_sn); }
    __device__ __forceinline__ const char* b_ptr(const Unit& u) const { return (const char*)(B + (size_t)u.pn * b_sn + (size_t)(u.pm >> 4) * b_sb); }
    __device__ __forceinline__ unsigned a_row_off(const Unit&, int r) const { return (unsigned)(r * lda) * 2u; }
    __device__ __forceinline__ int ldb_of() const { return ldb; }
};
__device__ __forceinline__ DenseProb dense(const half_t* A, int lda, const half_t* B, int ldb, int K) { return DenseProb{A, B, (size_t)BM * lda, 0, (size_t)BM * ldb, 0, lda, ldb, K, 0}; }

struct EpiF16 {
    static constexpr bool PERM = true, AFTER_DRAIN = false;
    half_t* C; int ldc; float scale; int rmode, bskip;
    static constexpr int NVM = 16; __device__ __forceinline__ bool nvm_ok(const Unit&) const { return true; }
    __device__ __forceinline__ void operator()(f32x4 (&acc)[2][2][4][2], const Unit& u, int wr, int wc, int fr, int fq) const {
        const int rt = rmode ? (u.pn >> 2) * 4 + u.pm : u.pm, ct = rmode ? (u.pn & 3) : u.pn;
        const int row0 = rt * BM + wr * 64 + fr, col0 = ct * BM + wc * 32 + 8 * fq;
#pragma unroll
        for (int ai = 0; ai < 2; ++ai)
#pragma unroll
            for (int m = 0; m < 4; ++m) { half_t* rowp = C + (size_t)(rt >> 2) * bskip + (size_t)(row0 + ai * HALF + m * 16) * ldc + col0;
#pragma unroll
                for (int bj = 0; bj < 2; ++bj) { const f32x4 v0 = acc[ai][bj][m][0] * scale, v1 = acc[ai][bj][m][1] * scale;
                    u4_t w; w.x = pkh(v0[0], v0[1]); w.y = pkh(v0[2], v0[3]); w.z = pkh(v1[0], v1[1]); w.w = pkh(v1[2], v1[3]);
                    *(u4_t*)(rowp + bj * HALF) = w; } }
    }
};

struct EpiZ {
    static constexpr bool PERM = true, AFTER_DRAIN = false;
    static constexpr bool PREFETCH = true;
    half_t* Z; const int* pos; LAS unsigned char* side; int mode, pad;
    static constexpr int NVM = 16; __device__ __forceinline__ bool nvm_ok(const Unit&) const { return mode == 0; }
    __device__ __forceinline__ void prefetch(const Unit& u, int tid, int wid) const {
        if (u.pn >= 6 && wid < 4) __builtin_amdgcn_global_load_lds((const unsigned*)(pos + u.pm * BM) + tid, (LAS unsigned*)(side + wid * 256), 4, 0, 0); }
    __device__ __forceinline__ void operator()(f32x4 (&acc)[2][2][4][2], const Unit& u, int wr, int wc, int fr, int fq) const {
        if (mode & 2) return;
        const int pn = u.pn, row0 = u.pm * BM + wr * 64 + fr, col0 = pn * BM + wc * 32 + 8 * fq;
        const bool rope0 = (pn >= 6), rope1 = (pn == 6 || pn == 7);
        const float sc = (pn <= 1 || pn == 6 || pn == 7) ? C2_64 : 1.f;
        const int i0 = 16 * (wc & 1) + 4 * fq;
        float invf[4];
#pragma unroll
        for (int j = 0; j < 4; ++j) invf[j] = inv_freq(i0 + j);
#pragma unroll
        for (int ai = 0; ai < 2; ++ai)
#pragma unroll
            for (int m = 0; m < 4; ++m) { const int row = row0 + ai * HALF + m * 16; half_t* rowp = Z + (size_t)row * ZW + col0;
                float cs[4], sn[4];
                if (rope0) { const float p = (float)((const LAS int*)side)[wr * 64 + fr + ai * HALF + m * 16];
#pragma unroll
                    for (int j = 0; j < 4; ++j) { const float rev = p * invf[j] * 0.15915494309189535f; const float fr_ = rev - floorf(rev); sn[j] = __builtin_amdgcn_sinf(fr_); cs[j] = __builtin_amdgcn_cosf(fr_); } }
#pragma unroll
                for (int bj = 0; bj < 2; ++bj) { f32x4 v0 = acc[ai][bj][m][0], v1 = acc[ai][bj][m][1];
                    if (bj == 0 ? rope0 : rope1) {
                        const f32x4 a = v0, b = v1;
                        v0[0] = a[0] * cs[0] - a[1] * sn[0]; v0[1] = a[1] * cs[0] + a[0] * sn[0]; v0[2] = a[2] * cs[1] - a[3] * sn[1]; v0[3] = a[3] * cs[1] + a[2] * sn[1];
                        v1[0] = b[0] * cs[2] - b[1] * sn[2]; v1[1] = b[1] * cs[2] + b[0] * sn[2]; v1[2] = b[2] * cs[3] - b[3] * sn[3]; v1[3] = b[3] * cs[3] + b[2] * sn[3]; }
                    v0 = v0 * sc; v1 = v1 * sc;
                    u4_t w; w.x = pkh(v0[0], v0[1]); w.y = pkh(v0[2], v0[3]); w.z = pkh(v1[0], v1[1]); w.w = pkh(v1[2], v1[3]);
                    if (mode & 1) { asm volatile("" :: "v"(w)); } else *(u4_t*)(rowp + bj * HALF) = w; } }
    }
};

struct PanelStats {
    unsigned* xbuf;
    unsigned* cnt;
    unsigned* tmo;
    int ntn; float eps; unsigned code; int pad;
    __device__ __forceinline__ bool run(const f32x4 (&v)[2][2][4][2], const Unit& u, int wr, int wc, int fr, int fq, LAS unsigned char* lds, int wid, int lane) const {
        typedef float f32x2v __attribute__((ext_vector_type(2)));
        LAS f32x2v* P = (LAS f32x2v*)lds;
        LAS f32x2v* S = (LAS f32x2v*)(lds + 8192);
        LAS unsigned* flag = (LAS unsigned*)(lds + 8192 + 2048);
#pragma unroll
        for (int ai = 0; ai < 2; ++ai)
#pragma unroll
            for (int m = 0; m < 4; ++m) {
                float s = 0.f;
#pragma unroll
                for (int bj = 0; bj < 2; ++bj)
#pragma unroll
                    for (int n = 0; n < 2; ++n) { const f32x4 x = v[ai][bj][m][n]; s += (x[0] + x[1]) + (x[2] + x[3]); }
                s += __shfl_xor(s, 16); s += __shfl_xor(s, 32);
                const float mw = s * (1.0f / 64.0f); float q = 0.f;
#pragma unroll
                for (int bj = 0; bj < 2; ++bj)
#pragma unroll
                    for (int n = 0; n < 2; ++n) { const f32x4 d = v[ai][bj][m][n] - mw; q += (d[0] * d[0] + d[1] * d[1]) + (d[2] * d[2] + d[3] * d[3]); }
                q += __shfl_xor(q, 16); q += __shfl_xor(q, 32);
                if (fq == 0) P[(ai * HALF + wr * 64 + m * 16 + fr) * 4 + wc] = (f32x2v){mw, q};
            }
        asm volatile("s_waitcnt lgkmcnt(0)" ::: "memory"); __builtin_amdgcn_s_barrier(); asm volatile("" ::: "memory");
        const int row = wid * 32 + (lane & 31);
        if (lane < 32) {
            const f32x2v a = P[row * 4 + 0], b = P[row * 4 + 1], c = P[row * 4 + 2], d = P[row * 4 + 3];
            const float mt = (a.x + b.x + c.x + d.x) * 0.25f;
            const float da = a.x - mt, db = b.x - mt, dc = c.x - mt, dd = d.x - mt;
            const float m2 = (a.y + b.y) + (c.y + d.y) + 64.0f * ((da * da + db * db) + (dc * dc + dd * dd));
            unsigned long long* slot = (unsigned long long*)xbuf + ((size_t)(u.pm * BM + row) * 4 + u.pn);
            __hip_atomic_store(slot, ((unsigned long long)__float_as_uint(m2) << 32) | __float_as_uint(mt), __ATOMIC_RELAXED, __HIP_MEMORY_SCOPE_AGENT);
        }
        asm volatile("s_waitcnt vmcnt(0)" ::: "memory");
        if (lane == 0) __hip_atomic_fetch_add(cnt + 64 * u.pm, 1u, __ATOMIC_RELAXED, __HIP_MEMORY_SCOPE_AGENT);
        if (wid == 0) {
            bool dead = false; const unsigned long long t0 = __builtin_amdgcn_s_memrealtime(); const unsigned want = 8u * (unsigned)ntn;
            for (;;) {
                if ((unsigned)__builtin_amdgcn_readfirstlane(__hip_atomic_load(cnt + 64 * u.pm, __ATOMIC_RELAXED, __HIP_MEMORY_SCOPE_AGENT)) >= want) break;
                if (__builtin_amdgcn_s_memrealtime() - t0 > 2000000ull) {
                    if (lane == 0) { unsigned expect = 0u; __hip_atomic_compare_exchange_strong(tmo + 1, &expect, code | (unsigned)(u.pm & 0xff), __ATOMIC_RELAXED, __ATOMIC_RELAXED, __HIP_MEMORY_SCOPE_AGENT);
                                     __hip_atomic_store(tmo, 1u, __ATOMIC_RELAXED, __HIP_MEMORY_SCOPE_AGENT); }
                    dead = true; break; }
                __builtin_amdgcn_s_sleep(2);
            }
            __builtin_amdgcn_fence(__ATOMIC_ACQUIRE, "agent");
            if (lane == 0) flag[0] = dead ? 1u : 0u;
        }
        asm volatile("s_waitcnt vmcnt(0) lgkmcnt(0)" ::: "memory"); __builtin_amdgcn_s_barrier(); asm volatile("" ::: "memory");
        const bool bad = flag[0] != 0u;
        if (lane < 32) {
            const unsigned long long* slot = (const unsigned long long*)xbuf + (size_t)(u.pm * BM + row) * 4; float mt[4], m2[4]; float ms = 0.f;
#pragma unroll
            for (int t = 0; t < 4; ++t) { if (t < ntn) { const unsigned long long w = __hip_atomic_load(slot + t, __ATOMIC_RELAXED, __HIP_MEMORY_SCOPE_AGENT); mt[t] = __uint_as_float((unsigned)w); m2[t] = __uint_as_float((unsigned)(w >> 32)); } else { mt[t] = 0.f; m2[t] = 0.f; } ms += mt[t]; }
            const float mean = ms / (float)ntn; float q = 0.f;
#pragma unroll
            for (int t = 0; t < 4; ++t) if (t < ntn) { const float dm = mt[t] - mean; q += m2[t] + 256.0f * dm * dm; }
            S[row] = (f32x2v){mean, 1.0f / sqrtf(q / (256.0f * (float)ntn) + eps)};
        }
        asm volatile("s_waitcnt lgkmcnt(0)" ::: "memory"); __builtin_amdgcn_s_barrier(); asm volatile("" ::: "memory");
        return bad;
    }
};
template <bool RES_F32>
struct EpiLN {
    static constexpr bool PERM = true, AFTER_DRAIN = true;
    const float* resf; const half_t* resh; half_t* out; const float* gam; const float* bet; PanelStats st;
    __device__ __forceinline__ void fused(f32x4 (&acc)[2][2][4][2], const Unit& u, int wr, int wc, int fr, int fq, LAS unsigned char* lds, int wid, int lane) const {
        typedef float f32x2v __attribute__((ext_vector_type(2)));
        const LAS f32x2v* S = (const LAS f32x2v*)(lds + 8192);
        const int col0 = u.pn * BM + wc * 32 + 8 * fq;
#pragma unroll
        for (int ai = 0; ai < 2; ++ai)
#pragma unroll
            for (int m = 0; m < 4; ++m) { const size_t off = (size_t)(u.pm * BM + ai * HALF + wr * 64 + m * 16 + fr) * DM + col0;
#pragma unroll
                for (int bj = 0; bj < 2; ++bj) { f32x4 r0, r1;
                    if (RES_F32) { r0 = *(const f32x4*)(resf + off + bj * HALF); r1 = *(const f32x4*)(resf + off + bj * HALF + 4); }
                    else { const h8_t hh = *(const h8_t*)(resh + off + bj * HALF); r0 = (f32x4){(float)hh[0], (float)hh[1], (float)hh[2], (float)hh[3]}; r1 = (f32x4){(float)hh[4], (float)hh[5], (float)hh[6], (float)hh[7]}; }
                    acc[ai][bj][m][0] += r0 * ALPHA; acc[ai][bj][m][1] += r1 * ALPHA; }
                asm volatile("" : "+v"(acc[ai][0][m][0]), "+v"(acc[ai][0][m][1]), "+v"(acc[ai][1][m][0]), "+v"(acc[ai][1][m][1]));
                if (m & 1) asm volatile("" ::: "memory"); }
        const bool bad = st.run(acc, u, wr, wc, fr, fq, lds, wid, lane);
        f32x4 gv[2][2], bv[2][2];
#pragma unroll
        for (int bj = 0; bj < 2; ++bj)
#pragma unroll
            for (int n = 0; n < 2; ++n) { gv[bj][n] = *(const f32x4*)(gam + col0 + bj * HALF + 4 * n); bv[bj][n] = *(const f32x4*)(bet + col0 + bj * HALF + 4 * n); }
#pragma unroll
        for (int ai = 0; ai < 2; ++ai)
#pragma unroll
            for (int m = 0; m < 4; ++m) { const int r = ai * HALF + wr * 64 + m * 16 + fr; const f32x2v sr = S[r]; const size_t off = (size_t)(u.pm * BM + r) * DM + col0;
#pragma unroll
                for (int bj = 0; bj < 2; ++bj) { const f32x4 o0 = (acc[ai][bj][m][0] - sr.x) * sr.y * gv[bj][0] + bv[bj][0], o1 = (acc[ai][bj][m][1] - sr.x) * sr.y * gv[bj][1] + bv[bj][1];
                    u4_t w; w.x = pkh(o0[0], o0[1]); w.y = pkh(o0[2], o0[3]); w.z = pkh(o1[0], o1[1]); w.w = pkh(o1[2], o1[3]);
                    if (bad) { w.x = 0x7e007e00u; w.y = 0x7e007e00u; w.z = 0x7e007e00u; w.w = 0x7e007e00u; }
                    *(u4_t*)(out + off + bj * HALF) = w; } }
    }
};

struct EpiSoftmax {
    static constexpr bool PERM = true, AFTER_DRAIN = false;
    half_t* PXo; LAS unsigned char* xl;
    static constexpr int NVM = 16; __device__ __forceinline__ bool nvm_ok(const Unit&) const { return true; }
    __device__ __forceinline__ void operator()(f32x4 (&acc)[2][2][4][2], const Unit& u, int wr, int wc, int fr, int fq) const {
        typedef float f32x2v __attribute__((ext_vector_type(2)));
        LAS f32x2v* X = (LAS f32x2v*)xl;
        float mxs[2][4];
#pragma unroll
        for (int ai = 0; ai < 2; ++ai)
#pragma unroll
            for (int m = 0; m < 4; ++m) {
                float mx = -INFINITY;
#pragma unroll
                for (int bj = 0; bj < 2; ++bj)
#pragma unroll
                    for (int n = 0; n < 2; ++n) { const f32x4 x = acc[ai][bj][m][n]; mx = fmaxf(mx, fmaxf(fmaxf(x[0], x[1]), fmaxf(x[2], x[3]))); }
                mx = fmaxf(mx, __shfl_xor(mx, 16)); mx = fmaxf(mx, __shfl_xor(mx, 32));
                float sm = 0.f;
#pragma unroll
                for (int bj = 0; bj < 2; ++bj)
#pragma unroll
                    for (int n = 0; n < 2; ++n) { f32x4 x = acc[ai][bj][m][n];
#pragma unroll
                        for (int i = 0; i < 4; ++i) { x[i] = __builtin_amdgcn_exp2f(x[i] - mx); sm += x[i]; }
                        acc[ai][bj][m][n] = x; }
                sm += __shfl_xor(sm, 16); sm += __shfl_xor(sm, 32);
                mxs[ai][m] = mx;
                if (fq == 0) X[(ai * HALF + wr * 64 + m * 16 + fr) * 4 + wc] = (f32x2v){mx, sm};
            }
        asm volatile("s_waitcnt lgkmcnt(0)" ::: "memory"); __builtin_amdgcn_s_barrier(); asm volatile("" ::: "memory");
        const int row0 = u.pm * BM + wr * 64 + fr, col0 = u.pn * BM + wc * 32 + 8 * fq;
#pragma unroll
        for (int ai = 0; ai < 2; ++ai)
#pragma unroll
            for (int m = 0; m < 4; ++m) { const int r = ai * HALF + wr * 64 + m * 16 + fr;
                const f32x2v a = X[r * 4 + 0], b = X[r * 4 + 1], c = X[r * 4 + 2], d = X[r * 4 + 3];
                const float M = fmaxf(fmaxf(a.x, b.x), fmaxf(c.x, d.x));
                const float tot = a.y * __builtin_amdgcn_exp2f(a.x - M) + b.y * __builtin_amdgcn_exp2f(b.x - M) + c.y * __builtin_amdgcn_exp2f(c.x - M) + d.y * __builtin_amdgcn_exp2f(d.x - M);
                const float f = __builtin_amdgcn_exp2f(mxs[ai][m] - M) / tot;
                half_t* rowp = PXo + (size_t)(row0 + ai * HALF + m * 16) * DM + col0;
#pragma unroll
                for (int bj = 0; bj < 2; ++bj) { const f32x4 v0 = acc[ai][bj][m][0] * f, v1 = acc[ai][bj][m][1] * f;
                    u4_t w; w.x = pkh(v0[0], v0[1]); w.y = pkh(v0[2], v0[3]); w.z = pkh(v1[0], v1[1]); w.w = pkh(v1[2], v1[3]);
                    *(u4_t*)(rowp + bj * HALF) = w; } }
        asm volatile("s_waitcnt lgkmcnt(0)" ::: "memory"); __builtin_amdgcn_s_barrier(); asm volatile("" ::: "memory");
    }
};

struct GTProb {
    static constexpr bool GATHER = false;
    const half_t* KXp; const half_t* WQSp; int K, pad;
    __device__ __forceinline__ const char* a_ptr(const Unit& u) const { return (const char*)(KXp + (size_t)(u.pm >> 2) * 256 * 1024 + (u.pm & 3) * 256); }
    __device__ __forceinline__ const char* b_ptr(const Unit& u) const { return (const char*)(WQSp + (size_t)u.pn * 256 * 1024 + (u.pm & 3) * 256); }
    __device__ __forceinline__ unsigned a_row_off(const Unit&, int r) const { return (unsigned)(r * 1024) * 2u; }
    __device__ __forceinline__ int ldb_of() const { return 1024; }
};
struct VWProb {
    static constexpr bool GATHER = false;
    const half_t* WXOp; const half_t* VXp; int K, pad;
    __device__ __forceinline__ const char* a_ptr(const Unit& u) const { return (const char*)(WXOp + (size_t)u.pm * 256 * 1024 + (u.pn & 3) * 256); }
    __device__ __forceinline__ const char* b_ptr(const Unit& u) const { return (const char*)(VXp + (size_t)(u.pn >> 2) * 256 * 1024 + (u.pn & 3) * 256); }
    __device__ __forceinline__ unsigned a_row_off(const Unit&, int r) const { return (unsigned)(r * 1024) * 2u; }
    __device__ __forceinline__ int ldb_of() const { return 1024; }
};
struct EpiSoftmaxFold {
    static constexpr bool PERM = true, AFTER_DRAIN = false, PREFETCH = true;
    half_t* PXo; LAS unsigned char* xl; const float* UB; LAS unsigned char* mr; LAS unsigned char* side; float scale; int pad;
    static constexpr int NVM = 16; __device__ __forceinline__ bool nvm_ok(const Unit&) const { return true; }
    __device__ __forceinline__ void prefetch(const Unit& u, int tid, int wid) const {
        const int bh = (u.pm >> 4) * 4 + u.pn; const float* uc = (tid < 256) ? UB + bh * 256 + tid : UB + 16384 + bh * 256 + (tid - 256);
        __builtin_amdgcn_global_load_lds((const unsigned*)uc, (LAS unsigned*)(side + wid * 256), 4, 0, 0); }
    __device__ __forceinline__ void operator()(f32x4 (&acc)[2][2][4][2], const Unit& u, int wr, int wc, int fr, int fq) const {
        typedef float f32x2v __attribute__((ext_vector_type(2)));
        LAS f32x2v* X = (LAS f32x2v*)xl;
        f32x4 uv[2][2], cv[2][2];
#pragma unroll
        for (int bj = 0; bj < 2; ++bj)
#pragma unroll
            for (int n = 0; n < 2; ++n) { const int cl = wc * 32 + 8 * fq + bj * HALF + 4 * n; uv[bj][n] = *(const LAS f32x4*)(side + cl * 4); cv[bj][n] = *(const LAS f32x4*)(side + 1024 + cl * 4); }
        float mxs[2][4];
#pragma unroll
        for (int ai = 0; ai < 2; ++ai)
#pragma unroll
            for (int m = 0; m < 4; ++m) { const int r = ai * HALF + wr * 64 + m * 16 + fr; const f32x2v t = ((const LAS f32x2v*)mr)[u.rb * 256 + r];
                const float a = t.y * scale, bc = -t.y * t.x * scale;
                float mx = -INFINITY;
#pragma unroll
                for (int bj = 0; bj < 2; ++bj)
#pragma unroll
                    for (int n = 0; n < 2; ++n) { const f32x4 x = acc[ai][bj][m][n] * a + uv[bj][n] * bc + cv[bj][n] * scale; acc[ai][bj][m][n] = x; mx = fmaxf(mx, fmaxf(fmaxf(x[0], x[1]), fmaxf(x[2], x[3]))); }
                mx = fmaxf(mx, __shfl_xor(mx, 16)); mx = fmaxf(mx, __shfl_xor(mx, 32));
                float sm = 0.f;
#pragma unroll
                for (int bj = 0; bj < 2; ++bj)
#pragma unroll
                    for (int n = 0; n < 2; ++n) { f32x4 x = acc[ai][bj][m][n];
#pragma unroll
                        for (int i = 0; i < 4; ++i) { x[i] = __builtin_amdgcn_exp2f(x[i] - mx); sm += x[i]; }
                        acc[ai][bj][m][n] = x; }
                sm += __shfl_xor(sm, 16); sm += __shfl_xor(sm, 32);
                mxs[ai][m] = mx;
                if (fq == 0) X[r * 4 + wc] = (f32x2v){mx, sm};
            }
        asm volatile("s_waitcnt lgkmcnt(0)" ::: "memory"); __builtin_amdgcn_s_barrier(); asm volatile("" ::: "memory");
        const int row0 = u.pm * BM + wr * 64 + fr, col0 = u.pn * BM + wc * 32 + 8 * fq;
#pragma unroll
        for (int ai = 0; ai < 2; ++ai)
#pragma unroll
            for (int m = 0; m < 4; ++m) { const int r = ai * HALF + wr * 64 + m * 16 + fr;
                const f32x2v a = X[r * 4 + 0], b = X[r * 4 + 1], c = X[r * 4 + 2], d = X[r * 4 + 3];
                const float M = fmaxf(fmaxf(a.x, b.x), fmaxf(c.x, d.x));
                const float tot = a.y * __builtin_amdgcn_exp2f(a.x - M) + b.y * __builtin_amdgcn_exp2f(b.x - M) + c.y * __builtin_amdgcn_exp2f(c.x - M) + d.y * __builtin_amdgcn_exp2f(d.x - M);
                const float f = __builtin_amdgcn_exp2f(mxs[ai][m] - M) / tot;
                half_t* rowp = PXo + (size_t)(row0 + ai * HALF + m * 16) * DM + col0;
#pragma unroll
                for (int bj = 0; bj < 2; ++bj) { const f32x4 v0 = acc[ai][bj][m][0] * f, v1 = acc[ai][bj][m][1] * f;
                    u4_t w; w.x = pkh(v0[0], v0[1]); w.y = pkh(v0[2], v0[3]); w.z = pkh(v1[0], v1[1]); w.w = pkh(v1[2], v1[3]);
                    *(u4_t*)(rowp + bj * HALF) = w; } }
        asm volatile("s_waitcnt lgkmcnt(0)" ::: "memory"); __builtin_amdgcn_s_barrier(); asm volatile("" ::: "memory");
    }
};

struct MoeOrder {
    LAS int* tab; int nun, total;
    __device__ __forceinline__ void init(const unsigned* cnt, int G, int c, LAS unsigned char* lds_tab) {
        tab = (LAS int*)lds_tab;
        if (threadIdx.x == 0) {
            int tot = 0; for (int e = 0; e < NEXP; ++e) tot += (((int)cnt[e] + 255) >> 8) * 4;
            int n = 0;
            for (int i = 0; i < 12; ++i) { const long L = (long)i * G + c; if (L >= tot) break;
                int wgid = (int)L; { const int q = tot / NXCD, r = tot % NXCD, xcd = wgid % NXCD, off = wgid / NXCD; wgid = (xcd < r ? xcd * (q + 1) : r * (q + 1) + (xcd - r) * q) + off; }
                int e = 0, start = 0, rb = 0;
                for (; e < NEXP; ++e) { const int nt = (((int)cnt[e] + 255) >> 8); if (wgid < start + nt * 4) break; start += nt * 4; rb += nt * 256; }
                const int r = wgid - start; tab[i * 8 + 0] = r >> 2; tab[i * 8 + 1] = r & 3; tab[i * 8 + 2] = e; tab[i * 8 + 3] = rb + (r >> 2) * 256; tab[i * 8 + 4] = (int)cnt[e]; n = i + 1; }
            tab[126] = n; tab[127] = tot; }
        __syncthreads();
        nun = __builtin_amdgcn_readfirstlane(tab[126]); total = __builtin_amdgcn_readfirstlane(tab[127]);
    }
    __device__ __forceinline__ bool next(int i, Unit& u) const {
        if (i >= nun) return false;
        u.pm = __builtin_amdgcn_readfirstlane(tab[i * 8 + 0]); u.pn = __builtin_amdgcn_readfirstlane(tab[i * 8 + 1]); u.z = __builtin_amdgcn_readfirstlane(tab[i * 8 + 2]);
        u.rb = __builtin_amdgcn_readfirstlane(tab[i * 8 + 3]); u.aux = __builtin_amdgcn_readfirstlane(tab[i * 8 + 4]); return true;
    }
};
struct GUProb {
    static constexpr bool GATHER = true;
    const half_t* H2p; const half_t* W; const unsigned* cnt; const int* ltok; LAS unsigned char* itab; int K, pad;
    __device__ __forceinline__ void prefetch_idx(const Unit& u, int tid, int wid) const { if (wid < 4) __builtin_amdgcn_global_load_lds((const unsigned*)(ltok + (size_t)u.z * LCAP + u.pm * BM) + tid, (LAS unsigned*)(itab + wid * 256), 4, 0, 0); }
    __device__ __forceinline__ unsigned a_row_off_lds(const Unit& u, int r) const { const int idx = u.pm * BM + r; const int tk = (idx < u.aux) ? (((const LAS int*)itab)[r] >> 1) : 0; return (unsigned)tk * 2048u; }
    __device__ __forceinline__ const char* a_ptr(const Unit&) const { return (const char*)H2p; }
    __device__ __forceinline__ const char* b_ptr(const Unit& u) const { return (const char*)(W + ((size_t)u.z * 1024 + (size_t)u.pn * BM) * 1024); }
    __device__ __forceinline__ unsigned a_row_off(const Unit& u, int r) const { const int idx = u.pm * BM + r; const int tk = (idx < u.aux) ? (ltok[(size_t)u.z * LCAP + idx] >> 1) : 0; return (unsigned)tk * 2048u; }
    __device__ __forceinline__ int ldb_of() const { return 1024; }
};
struct EpiGU {
    static constexpr bool PERM = true, AFTER_DRAIN = false;
    static constexpr bool PREFETCH = true;
    half_t* ACTo; const float* U; const float* Cc; const float* lmr; LAS unsigned char* side;
    static constexpr int NVM = 16; __device__ __forceinline__ bool nvm_ok(const Unit&) const { return true; }
    __device__ __forceinline__ void prefetch(const Unit& u, int tid, int wid) const {
        __builtin_amdgcn_global_load_lds((const unsigned*)(lmr + ((size_t)u.z * LCAP + u.pm * BM) * 2) + tid, (LAS unsigned*)(side + wid * 256), 4, 0, 0);
        const float* uc = (tid < 256) ? U + u.z * 1024 + u.pn * BM + tid : Cc + u.z * 1024 + u.pn * BM + (tid - 256);
        __builtin_amdgcn_global_load_lds((const unsigned*)uc, (LAS unsigned*)(side + 2048 + wid * 256), 4, 0, 0); }
    __device__ __forceinline__ void operator()(f32x4 (&acc)[2][2][4][2], const Unit& u, int wr, int wc, int fr, int fq) const {
        typedef float f32x2v __attribute__((ext_vector_type(2)));
        asm volatile("" : "+v"(fr), "+v"(fq));
        const int row0 = u.rb + wr * 64 + fr, colI = u.pn * BM + wc * 32 + 8 * fq, col0 = colI >> 1;
        f32x4 uv[2][2], cv[2][2];
#pragma unroll
        for (int bj = 0; bj < 2; ++bj)
#pragma unroll
            for (int n = 0; n < 2; ++n) { const int cl = wc * 32 + 8 * fq + bj * HALF + 4 * n; uv[bj][n] = *(const LAS f32x4*)(side + 2048 + cl * 4); cv[bj][n] = *(const LAS f32x4*)(side + 3072 + cl * 4); }
#pragma unroll
        for (int ai = 0; ai < 2; ++ai)
#pragma unroll
            for (int m = 0; m < 4; ++m) { const int rl = wr * 64 + fr + ai * HALF + m * 16; half_t* rowp = ACTo + (size_t)(u.rb + rl) * DEXP + col0;
                const f32x2v t = ((const LAS f32x2v*)side)[rl];
                const float a = t.y, bc = -t.y * t.x;
#pragma unroll
                for (int bj = 0; bj < 2; ++bj) { const f32x4 v0 = acc[ai][bj][m][0] * a + uv[bj][0] * bc + cv[bj][0], v1 = acc[ai][bj][m][1] * a + uv[bj][1] * bc + cv[bj][1];
                    const float a0 = v0[0] * __builtin_amdgcn_rcpf(1.f + __builtin_amdgcn_exp2f(-LOG2E * v0[0])) * v0[1], a1 = v0[2] * __builtin_amdgcn_rcpf(1.f + __builtin_amdgcn_exp2f(-LOG2E * v0[2])) * v0[3];
                    const float a2 = v1[0] * __builtin_amdgcn_rcpf(1.f + __builtin_amdgcn_exp2f(-LOG2E * v1[0])) * v1[1], a3 = v1[2] * __builtin_amdgcn_rcpf(1.f + __builtin_amdgcn_exp2f(-LOG2E * v1[2])) * v1[3];
                    *(unsigned long long*)(rowp + bj * (HALF / 2)) = (unsigned long long)pkh(a0, a1) | ((unsigned long long)pkh(a2, a3) << 32); } }
        (void)row0;
    }
};
struct DownProb {
    static constexpr bool GATHER = false;
    const half_t* ACTp; const half_t* W; int K, pad;
    __device__ __forceinline__ const char* a_ptr(const Unit& u) const { return (const char*)(ACTp + (size_t)u.rb * DEXP); }
    __device__ __forceinline__ const char* b_ptr(const Unit& u) const { return (const char*)(W + ((size_t)u.z * 1024 + (size_t)u.pn * BM) * DEXP); }
    __device__ __forceinline__ unsigned a_row_off(const Unit&, int r) const { return (unsigned)(r * DEXP) * 2u; }
    __device__ __forceinline__ int ldb_of() const { return DEXP; }
};
struct EpiDown {
    static constexpr bool PERM = true, AFTER_DRAIN = false;
    static constexpr bool PREFETCH = true;
    half_t* Yo; const unsigned* cnt; const int* ltok; const float* lw; LAS unsigned char* side;
    static constexpr int NVM = 16; __device__ __forceinline__ bool nvm_ok(const Unit& u) const { return (u.pm + 1) * BM <= u.aux; }
    __device__ __forceinline__ void prefetch(const Unit& u, int tid, int wid) const {
        const unsigned* src = (tid < 256) ? (const unsigned*)(ltok + (size_t)u.z * LCAP + u.pm * BM) + tid : (const unsigned*)(lw + (size_t)u.z * LCAP + u.pm * BM) + (tid - 256);
        __builtin_amdgcn_global_load_lds(src, (LAS unsigned*)(side + wid * 256), 4, 0, 0); }
    __device__ __forceinline__ void operator()(f32x4 (&acc)[2][2][4][2], const Unit& u, int wr, int wc, int fr, int fq) const {
        const int idx0 = u.pm * BM + wr * 64 + fr, col0 = u.pn * BM + wc * 32 + 8 * fq, ce = u.aux;
#pragma unroll
        for (int ai = 0; ai < 2; ++ai)
#pragma unroll
            for (int m = 0; m < 4; ++m) { const int idx = idx0 + ai * HALF + m * 16;
                if (idx < ce) { const int rl = idx - u.pm * BM; const int t2 = ((const LAS int*)side)[rl]; const float g = ((const LAS float*)(side + 1024))[rl]; half_t* rowp = Yo + (size_t)t2 * DM + col0;
#pragma unroll
                    for (int bj = 0; bj < 2; ++bj) { const f32x4 v0 = acc[ai][bj][m][0] * g, v1 = acc[ai][bj][m][1] * g;
                        u4_t w; w.x = pkh(v0[0], v0[1]); w.y = pkh(v0[2], v0[3]); w.z = pkh(v1[0], v1[1]); w.w = pkh(v1[2], v1[3]);
                        *(u4_t*)(rowp + bj * HALF) = w; } } }
    }
};

template <int RESM>
struct EpiV {
    static constexpr bool PERM = true, AFTER_DRAIN = false;
    const half_t* res; half_t* V; float* ST; const float* g; const float* b; LAS unsigned char* mr;
    static constexpr int NVM = 40; __device__ __forceinline__ bool nvm_ok(const Unit&) const { return true; }
    __device__ __forceinline__ void operator()(f32x4 (&acc)[2][2][4][2], const Unit& u, int wr, int wc, int fr, int fq) const {
        typedef float f32x2v __attribute__((ext_vector_type(2)));
        const int col0 = u.pn * BM + wc * 32 + 8 * fq;
        f32x4 gv[2][2], bv[2][2];
        if (RESM == 1) {
#pragma unroll
            for (int bj = 0; bj < 2; ++bj)
#pragma unroll
                for (int n = 0; n < 2; ++n) { gv[bj][n] = *(const f32x4*)(g + col0 + bj * HALF + 4 * n); bv[bj][n] = *(const f32x4*)(b + col0 + bj * HALF + 4 * n); } }
#pragma unroll
        for (int ai = 0; ai < 2; ++ai) {
            h8_t hh[4][2];
#pragma unroll
            for (int m = 0; m < 4; ++m)
#pragma unroll
                for (int bj = 0; bj < 2; ++bj) hh[m][bj] = *(const h8_t*)(res + (size_t)(u.pm * BM + ai * HALF + wr * 64 + m * 16 + fr) * DM + col0 + bj * HALF);
#pragma unroll
            for (int m = 0; m < 4; ++m) { const int r = ai * HALF + wr * 64 + m * 16 + fr; const int row = u.pm * BM + r; const size_t off = (size_t)row * DM + col0;
                float mean = 0.f, rstd = 1.f;
                if (RESM == 1) { const f32x2v t = ((const LAS f32x2v*)mr)[u.rb * 256 + r]; mean = t.x; rstd = t.y; }
                float sm = 0.f, sq = 0.f;
#pragma unroll
                for (int bj = 0; bj < 2; ++bj) { const h8_t h = hh[m][bj];
                    f32x4 r0 = (f32x4){(float)h[0], (float)h[1], (float)h[2], (float)h[3]}, r1 = (f32x4){(float)h[4], (float)h[5], (float)h[6], (float)h[7]};
                    if (RESM == 1) { r0 = (r0 - mean) * rstd * gv[bj][0] + bv[bj][0]; r1 = (r1 - mean) * rstd * gv[bj][1] + bv[bj][1]; }
                    const f32x4 v0 = acc[ai][bj][m][0] + r0 * ALPHA, v1 = acc[ai][bj][m][1] + r1 * ALPHA;
                    u4_t w; w.x = pkh(v0[0], v0[1]); w.y = pkh(v0[2], v0[3]); w.z = pkh(v1[0], v1[1]); w.w = pkh(v1[2], v1[3]);
                    *(u4_t*)(V + off + bj * HALF) = w;
                    sm += (v0[0] + v0[1]) + (v0[2] + v0[3]) + (v1[0] + v1[1]) + (v1[2] + v1[3]);
                    sq += (v0[0] * v0[0] + v0[1] * v0[1]) + (v0[2] * v0[2] + v0[3] * v0[3]) + (v1[0] * v1[0] + v1[1] * v1[1]) + (v1[2] * v1[2] + v1[3] * v1[3]); }
                sm += __shfl_xor(sm, 16); sm += __shfl_xor(sm, 32); sq += __shfl_xor(sq, 16); sq += __shfl_xor(sq, 32);
                if (fq == 0) *(f32x2v*)(ST + ((size_t)row * 16 + u.pn * 4 + wc) * 2) = (f32x2v){sm, sq}; }
            asm volatile("" ::: "memory"); }
    }
};
struct EpiFold {
    static constexpr bool PERM = true, AFTER_DRAIN = false;
    static constexpr bool PREFETCH = true;
    half_t* C; const float* U; const float* Cc; LAS unsigned char* mr; LAS unsigned char* side; float scale; int pad;
    static constexpr int NVM = 16; __device__ __forceinline__ bool nvm_ok(const Unit&) const { return true; }
    __device__ __forceinline__ void prefetch(const Unit& u, int tid, int wid) const {
        const float* uc = (tid < 256) ? U + u.pn * BM + tid : Cc + u.pn * BM + (tid - 256);
        __builtin_amdgcn_global_load_lds((const unsigned*)uc, (LAS unsigned*)(side + wid * 256), 4, 0, 0); }
    __device__ __forceinline__ void operator()(f32x4 (&acc)[2][2][4][2], const Unit& u, int wr, int wc, int fr, int fq) const {
        typedef float f32x2v __attribute__((ext_vector_type(2)));
        const int col0 = u.pn * BM + wc * 32 + 8 * fq;
        f32x4 uv[2][2], cv[2][2];
#pragma unroll
        for (int bj = 0; bj < 2; ++bj)
#pragma unroll
            for (int n = 0; n < 2; ++n) { const int cl = wc * 32 + 8 * fq + bj * HALF + 4 * n; uv[bj][n] = *(const LAS f32x4*)(side + cl * 4); cv[bj][n] = *(const LAS f32x4*)(side + 1024 + cl * 4); }
#pragma unroll
        for (int ai = 0; ai < 2; ++ai)
#pragma unroll
            for (int m = 0; m < 4; ++m) { const int r = ai * HALF + wr * 64 + m * 16 + fr; const f32x2v t = ((const LAS f32x2v*)mr)[u.rb * 256 + r];
                const float a = t.y, bc = -t.y * t.x; half_t* rowp = C + (size_t)(u.pm * BM + r) * DM + col0;
#pragma unroll
                for (int bj = 0; bj < 2; ++bj) { const f32x4 v0 = (acc[ai][bj][m][0] * a + uv[bj][0] * bc + cv[bj][0]) * scale, v1 = (acc[ai][bj][m][1] * a + uv[bj][1] * bc + cv[bj][1]) * scale;
                    u4_t w; w.x = pkh(v0[0], v0[1]); w.y = pkh(v0[2], v0[3]); w.z = pkh(v1[0], v1[1]); w.w = pkh(v1[2], v1[3]);
                    *(u4_t*)(rowp + bj * HALF) = w; } }
    }
};
template <class Sched>
__device__ __forceinline__ void row_tables(const Sched& S, const float* ST, LAS unsigned char* mr) {
    typedef float f32x2v __attribute__((ext_vector_type(2)));
    const int tid = threadIdx.x, i = tid >> 8, r = tid & 255; Unit u;
    if (S.next(i, u)) { const f32x4* p = (const f32x4*)(ST + ((size_t)(u.pm * BM + r) * 16) * 2); float sm = 0.f, sq = 0.f;
#pragma unroll
        for (int k = 0; k < 8; ++k) { const f32x4 t = p[k]; sm += t[0] + t[2]; sq += t[1] + t[3]; }
        const float mean = sm * (1.f / DM), var = sq * (1.f / DM) - mean * mean;
        ((LAS f32x2v*)mr)[i * 256 + r] = (f32x2v){mean, 1.0f / sqrtf(var + LN_EPS)}; }
    __syncthreads();
}

template <class E, class = void> struct has_prefetch { static constexpr bool value = false; };
template <class E> struct has_prefetch<E, decltype((void)E::PREFETCH)> { static constexpr bool value = E::PREFETCH; };
template <class Prob, class Epi, class Sched, bool ALIGN_EPI, bool RELAX = true>
__device__ __forceinline__ void gemm_phase(LAS unsigned char* lds, const Prob& g, const Sched& S, const Epi& E) {
    const int tid = threadIdx.x, wid = __builtin_amdgcn_readfirstlane(tid >> 6), lane = tid & 63, wr = wid >> 2, wc = wid & 3, fr = lane & 15, fq = lane >> 4;
    const int K = g.K, nt = K / BK;
    int sR[2], sC[2], sRb[2];
#pragma unroll
    for (int i = 0; i < 2; ++i) { stage_rc(tid * 16 + i * 8192, sR[i], sC[i]); sRb[i] = Epi::PERM ? ((sR[i] & ~31) + perm32(sR[i] & 31)) : sR[i]; }
    unsigned voffB[2];
#pragma unroll
    for (int i = 0; i < 2; ++i) voffB[i] = (unsigned)(sRb[i] * g.ldb_of() + sC[i]) * 2u;
    const size_t kstep = (size_t)(BK * 2);
    const size_t hstepB = (size_t)HALF * g.ldb_of() * 2;
    const unsigned ldsw = (unsigned)wid * 1024u;
    const int aoff = lds_byte(wr * 64 + fr, fq * 8), boff = lds_byte(wc * 32 + fr, fq * 8);
#define PG_SA(b, h) (((b) * 2 + (h)) * HTB)
#define PG_SB(b, h) ((4 + (b) * 2 + (h)) * HTB)
#define PG_STAGE(bufoff, gbase, voff) do { _Pragma("unroll") for (int _i = 0; _i < 2; ++_i) \
        __builtin_amdgcn_global_load_lds((const unsigned*)((const char*)(gbase) + (voff)[_i]), (LAS unsigned*)(lds + (bufoff) + ldsw + _i * 8192), 16, 0, 0); } while (0)
#define PG_LDA(dst, b, h) do { _Pragma("unroll") for (int m = 0; m < 4; ++m) _Pragma("unroll") for (int k = 0; k < 2; ++k) dst[m][k] = *(const LAS h8_t*)(lds + PG_SA(b, h) + aoff + m * 2048 + k * 1024); } while (0)
#define PG_LDB(dst, b, h) do { _Pragma("unroll") for (int n = 0; n < 2; ++n) _Pragma("unroll") for (int k = 0; k < 2; ++k) dst[n][k] = *(const LAS h8_t*)(lds + PG_SB(b, h) + boff + n * 2048 + k * 1024); } while (0)
#define PG_MMA(ai, bj, At, Bt) do { __builtin_amdgcn_s_setprio(1); _Pragma("unroll") for (int m = 0; m < 4; ++m) _Pragma("unroll") for (int n = 0; n < 2; ++n) _Pragma("unroll") for (int k = 0; k < 2; ++k) \
        acc[ai][bj][m][n] = __builtin_amdgcn_mfma_f32_16x16x32_f16(Bt[n][k], At[m][k], acc[ai][bj][m][n], 0, 0, 0); __builtin_amdgcn_s_setprio(0); } while (0)
#define PG_WAIT_V(n) asm volatile("s_waitcnt vmcnt(" #n ")" ::: "memory")
#define PG_WAIT_F() do { if constexpr (RELAX) asm volatile("s_cmp_lg_u32 %0, 0\n\ts_cbranch_scc1 1f\n\ts_waitcnt vmcnt(8)\n1:\n\ts_waitcnt vmcnt(%1)" :: "s"(__builtin_amdgcn_readfirstlane(wf)), "n"(8 + Epi::NVM) : "memory", "scc"); else PG_WAIT_V(8); } while (0)
#define PG_WAIT_L(n) asm volatile("s_waitcnt lgkmcnt(" #n ")" ::: "memory")
#define PG_BAR __builtin_amdgcn_s_barrier()
#define PG_SCHED __builtin_amdgcn_sched_barrier(0)
#define PG_VOFFA(dst, u) do { _Pragma("unroll") for (int _h = 0; _h < 2; ++_h) _Pragma("unroll") for (int _i = 0; _i < 2; ++_i) dst[_h][_i] = g.a_row_off(u, _h * HALF + sR[_i]) + (unsigned)sC[_i] * 2u; } while (0)
    Unit cur, nxt; int ui = 0, pnv = 0;
    if (!S.next(0, cur)) return;
    f32x4 acc[2][2][4][2];
#pragma unroll
    for (int a = 0; a < 2; ++a)
#pragma unroll
        for (int b = 0; b < 2; ++b)
#pragma unroll
            for (int m = 0; m < 4; ++m)
#pragma unroll
                for (int n = 0; n < 2; ++n) acc[a][b][m][n] = (f32x4){0.f, 0.f, 0.f, 0.f};
    h8_t At[4][2], B0[2][2], B1[2][2];
    const char* cA = g.a_ptr(cur); const char* cB = g.b_ptr(cur);
    unsigned vA[2][2], nvA[2][2];
    PG_VOFFA(vA, cur);
    PG_STAGE(PG_SB(0, 0), cB, voffB); PG_STAGE(PG_SB(0, 1), cB + hstepB, voffB); PG_STAGE(PG_SA(0, 0), cA, vA[0]); PG_STAGE(PG_SA(0, 1), cA, vA[1]);
    if (wr == 1) PG_BAR;
    PG_WAIT_V(2); PG_BAR;
    PG_STAGE(PG_SB(1, 0), cB + kstep, voffB); PG_STAGE(PG_SA(1, 0), cA + kstep, vA[0]); PG_STAGE(PG_SB(1, 1), cB + hstepB + kstep, voffB); PG_STAGE(PG_SA(1, 1), cA + kstep, vA[1]);
    PG_WAIT_V(8); PG_BAR;
    for (;;) {
        const bool has_next = S.next(ui + 1, nxt);
        const char* nA = has_next ? g.a_ptr(nxt) : cA; const char* nB = has_next ? g.b_ptr(nxt) : cB;
        if constexpr (Prob::GATHER) { if (has_next) g.prefetch_idx(nxt, tid, wid); }
        int wf = (ui > 0) ? pnv : 0;
        for (int t = 0; t < nt; t += 2) {
            const bool last = (t == nt - 2);
            if constexpr (Prob::GATHER) { if (last) {
#pragma unroll
                for (int _h = 0; _h < 2; ++_h)
#pragma unroll
                    for (int _i = 0; _i < 2; ++_i) nvA[_h][_i] = has_next ? g.a_row_off_lds(nxt, _h * HALF + sR[_i]) + (unsigned)sC[_i] * 2u : vA[_h][_i]; } }
            const char* a2 = last ? nA : cA + (size_t)(t + 2) * kstep; const char* b2 = last ? nB : cB + (size_t)(t + 2) * kstep;
            const char* a3 = a2 + kstep; const char* b3 = b2 + kstep;
            unsigned wA[2][2];
#pragma unroll
            for (int _h = 0; _h < 2; ++_h)
#pragma unroll
                for (int _i = 0; _i < 2; ++_i) wA[_h][_i] = (Prob::GATHER && last) ? nvA[_h][_i] : vA[_h][_i];
            if constexpr (has_prefetch<Epi>::value) { if (last) E.prefetch(cur, tid, wid); }
            PG_LDB(B0, 0, 0); PG_LDB(B1, 0, 1); PG_SCHED; PG_LDA(At, 0, 0);
            PG_WAIT_F(); PG_WAIT_L(0); PG_BAR; PG_MMA(0, 0, At, B0); PG_MMA(0, 1, At, B1); PG_BAR; PG_SCHED;
            PG_LDA(At, 0, 1); PG_STAGE(PG_SB(0, 0), b2, voffB); PG_STAGE(PG_SB(0, 1), b2 + hstepB, voffB); PG_STAGE(PG_SA(0, 0), a2, wA[0]);
            PG_WAIT_F(); PG_WAIT_L(0); PG_BAR; PG_MMA(1, 0, At, B0); PG_MMA(1, 1, At, B1); PG_BAR; PG_SCHED;
            PG_LDB(B0, 1, 0); PG_LDB(B1, 1, 1); PG_SCHED; PG_LDA(At, 1, 0); PG_STAGE(PG_SA(0, 1), a2, wA[1]);
            PG_WAIT_F(); PG_WAIT_L(0); PG_BAR; PG_MMA(0, 0, At, B0); PG_MMA(0, 1, At, B1); PG_BAR; PG_SCHED;
            PG_LDA(At, 1, 1); PG_STAGE(PG_SB(1, 0), b3, voffB); PG_STAGE(PG_SB(1, 1), b3 + hstepB, voffB); PG_STAGE(PG_SA(1, 0), a3, wA[0]);
            PG_WAIT_V(8); PG_WAIT_L(0); PG_BAR; PG_MMA(1, 0, At, B0); PG_MMA(1, 1, At, B1); PG_BAR; PG_SCHED;
            PG_STAGE(PG_SA(1, 1), a3, wA[1]);
            if constexpr (RELAX) { wf = 0; asm volatile("" : "+s"(wf)); }
        }
        if constexpr (ALIGN_EPI) { if (wr == 0) PG_BAR; }
        if constexpr (!Epi::AFTER_DRAIN) { E(acc, cur, wr, wc, fr, fq); pnv = E.nvm_ok(cur) ? 1 : 0; }
        if (!has_next) break;
#pragma unroll
        for (int a = 0; a < 2; ++a)
#pragma unroll
            for (int b = 0; b < 2; ++b)
#pragma unroll
                for (int m = 0; m < 4; ++m)
#pragma unroll
                    for (int n = 0; n < 2; ++n) acc[a][b][m][n] = (f32x4){0.f, 0.f, 0.f, 0.f};
        cur = nxt; cA = nA; cB = nB; ++ui;
        if (Prob::GATHER) {
#pragma unroll
            for (int _h = 0; _h < 2; ++_h)
#pragma unroll
                for (int _i = 0; _i < 2; ++_i) vA[_h][_i] = nvA[_h][_i]; }
        if constexpr (ALIGN_EPI) { if (wr == 1) PG_BAR; }
    }
    PG_WAIT_V(0);
    if constexpr (!ALIGN_EPI) { if (wr == 0) PG_BAR; }
    PG_BAR;
    if constexpr (Epi::AFTER_DRAIN) { E.fused(acc, cur, wr, wc, fr, fq, lds, wid, lane); asm volatile("s_waitcnt lgkmcnt(0)" ::: "memory"); PG_BAR; }
#undef PG_SA
#undef PG_SB
#undef PG_STAGE
#undef PG_LDA
#undef PG_LDB
#undef PG_MMA
#undef PG_WAIT_V
#undef PG_WAIT_F
#undef PG_WAIT_L
#undef PG_BAR
#undef PG_SCHED
#undef PG_VOFFA
}
}

namespace attn {
typedef short s16x4 __attribute__((ext_vector_type(4)));
typedef short s16x8 __attribute__((ext_vector_type(8)));
typedef float f32x16 __attribute__((ext_vector_type(16)));
constexpr int NW = 8, QBLK = 32, QB = QBLK * NW, KVBLK = 64;
__device__ __forceinline__ int crow(int r, int hi) { return (r & 3) + 8 * (r >> 2) + 4 * hi; }
#define SBAR() __builtin_amdgcn_sched_barrier(0)
constexpr int NSLOT = 3, SLOTB = 9216;
constexpr int LDS_K = 0, LDS_V = NSLOT * SLOTB, LDS_WS = 2 * NSLOT * SLOTB, LDS_OST = LDS_WS + NW * 64 * 4, LDS_BYTES = LDS_OST + NW * 4096;
constexpr float NEGS = -8192.f;
__device__ __forceinline__ void glds16s(const void* sbase, unsigned voff, unsigned lds_dst) { unsigned keep;
  asm volatile("s_mov_b32 %0, m0\n\ts_mov_b32 m0, %3\n\ts_nop 4\n\tglobal_load_lds_dwordx4 %1, %2\n\ts_mov_b32 m0, %0" : "=&s"(keep) : "v"(voff), "s"(sbase), "s"(lds_dst) : "memory"); }
__device__ __forceinline__ float max3f(float a, float b, float c) { float r; asm("v_max3_f32 %0, %1, %2, %3" : "=v"(r) : "v"(a), "v"(b), "v"(c)); return r; }
__device__ __forceinline__ float max2f(float a, float b) { float r; asm("v_max_f32_e32 %0, %1, %2" : "=v"(r) : "v"(a), "v"(b)); return r; }
__device__ __forceinline__ float fadd_s(float a, float b) { float r; asm("v_add_f32_e32 %0, %1, %2" : "=v"(r) : "v"(a), "v"(b)); return r; }
__device__ __forceinline__ float fsub_s(float a, float b) { float r; asm("v_sub_f32_e32 %0, %1, %2" : "=v"(r) : "v"(a), "v"(b)); return r; }
#define WAIT_BAR(N) asm volatile("s_waitcnt vmcnt(" #N ") lgkmcnt(0)\n\ts_barrier" ::: "memory")
#define MF16(a, b, c) __builtin_amdgcn_mfma_f32_32x32x16_f16(a, b, c, 0, 0, 0)
typedef __attribute__((address_space(3))) const char* lds_cptr;
typedef short v4i16_t __attribute__((ext_vector_type(4)));
__device__ __forceinline__ void kload2(h8_t* kf, lds_cptr kp, int j) { kf[2 * j] = *(const LAS h8_t*)(kp + j * 2048); kf[2 * j + 1] = *(const LAS h8_t*)(kp + j * 2048 + 512); }
__device__ __forceinline__ s16x4 vtr(lds_cptr p) { return __builtin_bit_cast(s16x4, __builtin_amdgcn_ds_read_tr16_b64_v4i16((LAS v4i16_t*)p)); }
__device__ __forceinline__ float rowmax(const f32x16& p0, const f32x16& p1) {
  float a = max3f(p0[0], p0[1], p1[0]), b = max3f(p0[2], p0[3], p1[1]); a = max3f(a, p1[2], p1[3]);
#pragma unroll
  for (int r = 4; r < 16; r += 4) { a = max3f(a, p0[r], p0[r + 1]); b = max3f(b, p0[r + 2], p0[r + 3]); a = max3f(a, p1[r], p1[r + 1]); b = max3f(b, p1[r + 2], p1[r + 3]); }
  const float m = max2f(a, b);
  auto rr = __builtin_amdgcn_permlane32_swap(__float_as_uint(m), __float_as_uint(m), false, false);
  return max2f(__uint_as_float(rr[0]), __uint_as_float(rr[1]));
}
__device__ __forceinline__ void cmask(f32x16& p0, f32x16& p1, int jb, int qrel, int hi) {
  const float NEG = -INFINITY; const int kb = 64 * jb + 4 * hi;
#pragma unroll
  for (int r = 0; r < 16; ++r) { const int kv = kb + (r & 3) + 8 * (r >> 2); if (kv > qrel) p0[r] = NEG; if (kv + 32 > qrel) p1[r] = NEG; }
}
__device__ __forceinline__ void smask(f32x16& p0, f32x16& p1, int kb0, int qrel, int hi) {
  const int kb = kb0 + 4 * hi;
#pragma unroll
  for (int r = 0; r < 16; ++r) { const int kv = kb + (r & 3) + 8 * (r >> 2); if ((unsigned)(qrel - kv) > 127u) p0[r] = NEGS; if ((unsigned)(qrel - kv - 32) > 127u) p1[r] = NEGS; }
}
__device__ __forceinline__ void pv(f32x16* o, int vb, h8_t pa0, h8_t pa1, h8_t pa2, h8_t pa3) {
#pragma unroll
  for (int d0 = 0; d0 < 2; ++d0) { s16x4 lo[4], hi[4];
#pragma unroll
    for (int ks = 0; ks < 4; ++ks) {
      asm volatile("ds_read_b64_tr_b16 %0,%1 offset:%c2" : "=&v"(lo[ks]) : "v"(vb), "i"(d0 * 4096 + ks * 1024) : "memory");
      asm volatile("ds_read_b64_tr_b16 %0,%1 offset:%c2" : "=&v"(hi[ks]) : "v"(vb), "i"(d0 * 4096 + ks * 1024 + 512) : "memory"); }
    asm volatile("s_waitcnt lgkmcnt(0)" ::: "memory"); SBAR();
#define PK(k) __builtin_bit_cast(h8_t, (s16x8){lo[k][0], lo[k][1], lo[k][2], lo[k][3], hi[k][0], hi[k][1], hi[k][2], hi[k][3]})
    o[d0] = MF16(pa0, PK(0), o[d0]); o[d0] = MF16(pa1, PK(1), o[d0]); o[d0] = MF16(pa2, PK(2), o[d0]); o[d0] = MF16(pa3, PK(3), o[d0]);
#undef PK
  }
}

template <int MODE, int THRL>
__device__ __forceinline__ void attn_unit(int b, int h, int qb, const half_t* Zp, const half_t* BKp, const int* TSp, const float* CUMp, const float* sinks, half_t* Op, char* shm) {
  int lane; asm volatile("v_mbcnt_lo_u32_b32 %0, -1, 0\n\tv_mbcnt_hi_u32_b32 %0, -1, %0" : "=v"(lane));
  const int r32 = lane & 31, hi = lane >> 5; const int wid = __builtin_amdgcn_readfirstlane(threadIdx.x >> 6);
  const long rowbase = (long)b * SEQ; const int q0 = (MODE == 0) ? qb * QB : qb * 64;
  const int hq = (MODE == 0) ? h : 4 * h + (wid & 3), wrow = (MODE == 0) ? wid * QBLK : (wid >> 2) * QBLK;
  const int qcol = (MODE == 0) ? ZQF + h * 64 : ZQS + hq * 64, kcol = (MODE == 0) ? ZKF + h * 64 : ZKS + h * 64, vcol = (MODE == 0) ? ZVF + h * 64 : ZVS + h * 64;
  const int ocol = (MODE == 0) ? h * 64 : 512 + hq * 64;
  const int tile0 = (MODE == 0) ? __builtin_amdgcn_readfirstlane(TSp[(b * 8 + h) * 16 + qb]) : ((qb - 2 < 0) ? 0 : (qb - 2 > 60) ? 60 : qb - 2);
  const int NT = (MODE == 0) ? 4 * qb + 4 - tile0 : 4;
  const int krel0 = (MODE == 0) ? (tile0 - 4 * qb) * 64 : (tile0 - qb) * 64;
  const half_t* Qw = Zp + (rowbase + q0 + wrow) * ZW + qcol;
  const half_t* Kh = Zp + (rowbase + (long)tile0 * KVBLK) * ZW + kcol; const half_t* Vh = Zp + (rowbase + (long)tile0 * KVBLK) * ZW + vcol;
  const unsigned lds0 = (unsigned)(uintptr_t)shm;
  float* wsf = (float*)(shm + LDS_WS) + wid * 64;
  const unsigned koff = (unsigned)(lane * ZW + wid * 8) * 2u;
  const unsigned voff = (unsigned)((16 * (wid & 3) + (lane >> 2)) * ZW + (wid >> 2) * 32 + (lane & 3) * 8) * 2u;
  const unsigned boff = (unsigned)lane * 16u;
  const half_t* Bh = BKp + ((long)(b * 8 + h) * SEQ + (long)tile0 * KVBLK) * 8;
  const unsigned kdst = lds0 + LDS_K + wid * 1024, vdst = lds0 + LDS_V + wid * 1024, bdst = lds0 + LDS_K + 8192;
#define DMA_K(t, slot) do { glds16s(Kh + (long)(t) * KVBLK * ZW, koff, (unsigned)__builtin_amdgcn_readfirstlane(kdst + (slot))); \
    if (MODE == 0 && wid == 0) glds16s(Bh + (long)(t) * KVBLK * 8, boff, (unsigned)__builtin_amdgcn_readfirstlane(bdst + (slot))); } while (0)
#define DMA_V(t, slot) glds16s(Vh + (long)(t) * KVBLK * ZW, voff, (unsigned)__builtin_amdgcn_readfirstlane(vdst + (slot)))
#define WAITB(N, NB) do { if (MODE == 0 && wid == 0) { WAIT_BAR_N(N + NB); } else { WAIT_BAR_N(N); } } while (0)
#define WAIT_BAR_N(n) do { if ((n) == 0) WAIT_BAR(0); else if ((n) == 1) WAIT_BAR(1); else if ((n) == 2) WAIT_BAR(2); else if ((n) == 3) WAIT_BAR(3); else if ((n) == 4) WAIT_BAR(4); else WAIT_BAR(5); } while (0)
  h8_t kf[10];
  const lds_cptr shm3 = (lds_cptr)shm; const lds_cptr kp0 = shm3 + LDS_K + hi * 1024 + r32 * 16; const lds_cptr kpe = shm3 + LDS_K + 8192 + r32 * 16;
  const lds_cptr vp0 = shm3 + LDS_V + ((lane >> 4) & 1) * 32 + (lane & 3) * 8 + (4 * hi + ((lane & 15) >> 2)) * 64;
  if (MODE == 1 && wid == 0) { const u4_t one_ = (u4_t){0x3C003C00u, 0u, 0u, 0u};
#pragma unroll
    for (int sl = 0; sl < NSLOT; ++sl) *(LAS u4_t*)(shm3 + LDS_K + sl * SLOTB + 8192 + lane * 16) = one_; }
  DMA_K(0, 0); DMA_V(0, 0); DMA_K(1, SLOTB);
  h8_t qr[4];
#pragma unroll
  for (int d0 = 0; d0 < 4; ++d0) qr[d0] = *reinterpret_cast<const h8_t*>(&Qw[(long)r32 * ZW + d0 * 16 + hi * 8]);
  h8_t qe; float mhat = 0.f, l_reg = 0.f; f32x16 o[2]; o[0] = f32x16{}; o[1] = f32x16{};
#define SETQE(TARGET) do { const float nt_ = -(TARGET); const half_t mh_ = (half_t)nt_; const half_t ml_ = (half_t)(nt_ - (float)mh_); mhat = -((float)mh_ + (float)ml_); \
    const unsigned mw_ = (unsigned)__builtin_bit_cast(unsigned short, mh_) | ((unsigned)__builtin_bit_cast(unsigned short, ml_) << 16); \
    u4_t w_; w_.x = (MODE == 0) ? 0x3C003C00u : mw_; w_.y = (MODE == 0) ? mw_ : 0u; w_.z = 0u; w_.w = 0u; if (hi != 0) { w_.x = 0u; w_.y = 0u; } qe = __builtin_bit_cast(h8_t, w_); } while (0)
  if (MODE == 0) { const float bq = -CUMp[(long)(b * 8 + h) * SEQ + q0 + wid * QBLK + r32] * LOG2E; SETQE(bq); } else { SETQE(0.f); }
  const f32x16 zero16 = f32x16{};
  const int qrel = wrow + r32;
#define CMASK(P0, P1, t) do { if (MODE == 0) { int jb_ = (t) - (NT - 4); if (jb_ >= 0) cmask(P0, P1, jb_, qrel, hi); } else smask(P0, P1, krel0 + 64 * (t), qrel, hi); } while (0)
  bool resc = false;
#define START(P0, P1) do { const float rm = rowmax(P0, P1); resc = false; \
    if (MODE == 1 || __any(rm > (float)THRL)) { const float mold_ = mhat; SETQE(mold_ + ((MODE == 1) ? rm : __builtin_fmaxf(rm, 0.f))); const float dl = mhat - mold_; \
      _Pragma("unroll") for (int r = 0; r < 16; ++r) { P0[r] = fsub_s(P0[r], dl); P1[r] = fsub_s(P1[r], dl); } } \
    _Pragma("unroll") for (int r = 0; r < 16; ++r) P0[r] = __builtin_amdgcn_exp2f(P0[r]); } while (0)
#define RESC() do { if (resc) { asm volatile("s_waitcnt lgkmcnt(0)" ::: "memory"); \
      _Pragma("unroll") for (int d_ = 0; d_ < 2; ++d_) _Pragma("unroll") for (int r = 0; r < 16; ++r) o[d_][r] *= wsf[crow(r, hi)]; } } while (0)
  f32x16 pA0, pA1, pB0, pB1;
  int sl_prev = 0, sl_cur = 0, sl_next = SLOTB;
#define ROT() do { sl_prev = sl_cur; sl_cur = sl_next; sl_next = (sl_next == (NSLOT - 1) * SLOTB) ? 0 : sl_next + SLOTB; } while (0)
  DMA_K(2, 2 * SLOTB);
  WAITB(3, 2);
  { const lds_cptr kb = kp0;
#pragma unroll
    for (int d0 = 0; d0 < 4; ++d0) { const h8_t b0 = *(const LAS h8_t*)(kb + d0 * 2048), b1 = *(const LAS h8_t*)(kb + d0 * 2048 + 512);
      if (d0 == 0) { pA0 = MF16(b0, qr[0], zero16); pA1 = MF16(b1, qr[0], zero16); } else { pA0 = MF16(b0, qr[d0], pA0); pA1 = MF16(b1, qr[d0], pA1); } }
    { const h8_t e0 = *(const LAS h8_t*)(kpe), e1 = *(const LAS h8_t*)(kpe + 512); pA0 = MF16(e0, qe, pA0); pA1 = MF16(e1, qe, pA1); } }
  asm volatile("s_nop 15\n\ts_nop 7" : "+v"(pA0), "+v"(pA1)); CMASK(pA0, pA1, 0);
  START(pA0, pA1);
  _Pragma("unroll") for (int r = 0; r < 16; ++r) pA1[r] = __builtin_amdgcn_exp2f(pA1[r]);
  WAIT_BAR(0);
  DMA_K(3, 0); DMA_V(1, SLOTB);
  ROT();
  kload2(kf, kp0 + sl_cur, 0); kload2(kf, kp0 + sl_cur, 1); kload2(kf, kp0 + sl_cur, 2); kload2(kf, kp0 + sl_cur, 3);
  kf[8] = *(const LAS h8_t*)(kpe + sl_cur); kf[9] = *(const LAS h8_t*)(kpe + sl_cur + 512);
  WAITB(2, 1);
  s16x4 vlo[8], vhi[8]; u4_t pw0, pw1, pw2, pw3;
#define PKW(P, B) pkh(P[B], P[B + 1])
#define PAF(k) __builtin_bit_cast(h8_t, pw##k)
#define VFR(i) __builtin_bit_cast(h8_t, (s16x8){vlo[i][0], vlo[i][1], vlo[i][2], vlo[i][3], vhi[i][0], vhi[i][1], vhi[i][2], vhi[i][3]})
#define PIN(x) asm volatile("" : "+v"(x))
#define MX3(a, b, c) __builtin_fmaxf(__builtin_fmaxf((a), (b)), (c))
#define GAPA(MF, A0, A1, A2, A3, W0, W1, PW) do { MF; sacc += A0; sacc += A1; sacc += A2; sacc += A3; PIN(sacc); W0; W1; PIN(PW); SBAR(); } while (0)
#define EX(v) __builtin_amdgcn_exp2f(v)
#define GAPB(MF, X, B) do { MF; X[B] = EX(X[B]); X[B + 1] = EX(X[B + 1]); X[B + 2] = EX(X[B + 2]); X[B + 3] = EX(X[B + 3]); PIN(X); SBAR(); } while (0)
#define VRD(i) do { vlo[i] = vtr(vp_ + (((i) >> 2) * 4096 + ((i) & 3) * 1024)); vhi[i] = vtr(vp_ + (((i) >> 2) * 4096 + ((i) & 3) * 1024 + 512)); } while (0)
#define KRD(G, j) do { if (G) { kload2(kf, kp0 + sl_next, j); SBAR(); } } while (0)
#define KRDE(G) do { if (G) { kf[8] = *(const LAS h8_t*)(kpe + sl_next); kf[9] = *(const LAS h8_t*)(kpe + sl_next + 512); SBAR(); } } while (0)
#define STEP(C0, C1, P0, P1, t, GK, GV, GL) do { SBAR(); \
    const lds_cptr vp_ = vp0 + sl_prev; \
    VRD(0); SBAR(); float sacc = (P0[0] + P0[1]); \
    GAPA(C0 = MF16(kf[0], qr[0], zero16), P0[2], P0[3], P0[4], P0[5],     pw0[0] = PKW(P0, 0), pw0[1] = PKW(P0, 2), pw0); \
    VRD(4); SBAR(); GAPA(C1 = MF16(kf[1], qr[0], zero16), P0[6], P0[7], P0[8], P0[9],     pw0[2] = PKW(P0, 4), pw0[3] = PKW(P0, 6), pw0); \
    VRD(1); SBAR(); GAPA(C0 = MF16(kf[2], qr[1], C0),   P0[10], P0[11], P0[12], P0[13], pw1[0] = PKW(P0, 8), pw1[1] = PKW(P0, 10), pw1); \
    VRD(5); SBAR(); GAPA(C1 = MF16(kf[3], qr[1], C1),   P0[14], P0[15], P1[0], P1[1],   pw1[2] = PKW(P0, 12), pw1[3] = PKW(P0, 14), pw1); \
    VRD(2); SBAR(); GAPA(C0 = MF16(kf[4], qr[2], C0),   P1[2], P1[3], P1[4], P1[5],     pw2[0] = PKW(P1, 0), pw2[1] = PKW(P1, 2), pw2); \
    VRD(6); SBAR(); GAPA(C1 = MF16(kf[5], qr[2], C1),   P1[6], P1[7], P1[8], P1[9],     pw2[2] = PKW(P1, 4), pw2[3] = PKW(P1, 6), pw2); \
    VRD(3); SBAR(); GAPA(C0 = MF16(kf[6], qr[3], C0),   P1[10], P1[11], P1[12], P1[13], pw3[0] = PKW(P1, 8), pw3[1] = PKW(P1, 10), pw3); \
    VRD(7); SBAR(); GAPA(C1 = MF16(kf[7], qr[3], C1),   P1[14], P1[15], 0.f, 0.f,       pw3[2] = PKW(P1, 12), pw3[3] = PKW(P1, 14), pw3); \
    C0 = MF16(kf[8], qe, C0); C1 = MF16(kf[9], qe, C1); SBAR(); \
    l_reg += sacc; \
    if (GK) { DMA_K((t) + 3, sl_cur); } if (GV) { DMA_V((t) + 1, sl_next); } \
    CMASK(C0, C1, t); \
    { float a = MX3(C0[0], C0[1], C1[0]), b = MX3(C0[2], C0[3], C1[1]); a = MX3(a, C1[2], C1[3]); \
      _Pragma("unroll") for (int r = 4; r < 16; r += 4) { a = MX3(a, C0[r], C0[r + 1]); b = MX3(b, C0[r + 2], C0[r + 3]); a = MX3(a, C1[r], C1[r + 1]); b = MX3(b, C1[r + 2], C1[r + 3]); } \
      float rm = __builtin_fmaxf(a, b); { auto rr = __builtin_amdgcn_permlane32_swap(__float_as_uint(rm), __float_as_uint(rm), false, false); rm = __builtin_fmaxf(__uint_as_float(rr[0]), __uint_as_float(rr[1])); } \
      resc = false; \
      if (__builtin_expect(__any(rm > (float)THRL), 0)) { const float mold_ = mhat; SETQE(mold_ + __builtin_fmaxf(rm, 0.f)); const float dl = mhat - mold_; \
        _Pragma("unroll") for (int r = 0; r < 16; ++r) { C0[r] -= dl; C1[r] -= dl; } \
        const float f = __builtin_amdgcn_exp2f(-dl); l_reg *= f; if (hi == 0) wsf[r32] = f; resc = true; } } \
    SBAR(); \
    GAPB(o[0] = MF16(PAF(0), VFR(0), o[0]), C0, 0); \
    GAPB(o[1] = MF16(PAF(0), VFR(4), o[1]), C0, 4); \
    KRD(GL, 0); GAPB(o[0] = MF16(PAF(1), VFR(1), o[0]), C0, 8); \
    KRD(GL, 1); GAPB(o[1] = MF16(PAF(1), VFR(5), o[1]), C0, 12); \
    KRD(GL, 2); GAPB(o[0] = MF16(PAF(2), VFR(2), o[0]), C1, 0); \
    KRD(GL, 3); GAPB(o[1] = MF16(PAF(2), VFR(6), o[1]), C1, 4); \
    KRDE(GL); GAPB(o[0] = MF16(PAF(3), VFR(3), o[0]), C1, 8); \
    GAPB(o[1] = MF16(PAF(3), VFR(7), o[1]), C1, 12); \
    } while (0)
  int t = 1;
  if (MODE == 0) {
#undef CMASK
#define CMASK(P0, P1, t) do { } while (0)
    for (; t + 5 < NT; t += 2) {
      STEP(pB0, pB1, pA0, pA1, t, true, true, true);     WAITB(2, 1); RESC(); ROT();
      STEP(pA0, pA1, pB0, pB1, t + 1, true, true, true); WAITB(2, 1); RESC(); ROT();
    }
#undef CMASK
#define CMASK(P0, P1, t) do { if (MODE == 0) { int jb_ = (t) - (NT - 4); if (jb_ >= 0) cmask(P0, P1, jb_, qrel, hi); } else smask(P0, P1, krel0 + 64 * (t), qrel, hi); } while (0)
  }
#define ENDW(tt) do { if ((tt) + 3 < NT) { WAITB(2, 1); } else if ((tt) + 2 < NT) { WAITB(1, 0); } else { WAIT_BAR(0); } } while (0)
  for (; t + 1 < NT; t += 2) {
    STEP(pB0, pB1, pA0, pA1, t, (t + 3 < NT), (t + 1 < NT), (t + 1 < NT));         ENDW(t);     RESC(); ROT();
    STEP(pA0, pA1, pB0, pB1, t + 1, (t + 4 < NT), (t + 2 < NT), (t + 2 < NT));     ENDW(t + 1); RESC(); ROT();
  }
  STEP(pB0, pB1, pA0, pA1, NT - 1, false, false, false); RESC();
  { float sacc = pB0[0] + pB0[1]; _Pragma("unroll") for (int r = 2; r < 16; ++r) sacc += pB0[r]; _Pragma("unroll") for (int r = 0; r < 16; ++r) sacc += pB1[r]; l_reg += sacc;
    pw0 = (u4_t){PKW(pB0, 0), PKW(pB0, 2), PKW(pB0, 4), PKW(pB0, 6)}; pw1 = (u4_t){PKW(pB0, 8), PKW(pB0, 10), PKW(pB0, 12), PKW(pB0, 14)};
    pw2 = (u4_t){PKW(pB1, 0), PKW(pB1, 2), PKW(pB1, 4), PKW(pB1, 6)}; pw3 = (u4_t){PKW(pB1, 8), PKW(pB1, 10), PKW(pB1, 12), PKW(pB1, 14)};
    SBAR(); pv(o, (int)(unsigned)(uintptr_t)(vp0 + sl_cur), PAF(0), PAF(1), PAF(2), PAF(3)); }
#undef PKW
#undef PAF
#undef VFR
#undef PIN
#undef MX3
#undef GAPA
#undef GAPB
#undef EX
#undef VRD
#undef KRD
#undef KRDE
#undef STEP
#undef ENDW
  { auto rr = __builtin_amdgcn_permlane32_swap(__float_as_uint(l_reg), __float_as_uint(l_reg), false, false); l_reg = __uint_as_float(rr[0]) + __uint_as_float(rr[1]); }
  if (MODE == 1) l_reg += __builtin_amdgcn_exp2f(sinks[hq] * LOG2E - mhat);
  if (hi == 0) wsf[32 + r32] = l_reg; asm volatile("s_waitcnt lgkmcnt(0)" ::: "memory");
  float rli[16];
#pragma unroll
  for (int r = 0; r < 16; ++r) rli[r] = __builtin_amdgcn_rcpf(wsf[32 + crow(r, hi)]);
  half_t* Ow = Op + (rowbase + q0 + wrow) * DM + ocol;
  { half_t* stg = (half_t*)(shm + LDS_OST) + wid * 2048;
#pragma unroll
    for (int r = 0; r < 16; ++r) { const int orow = crow(r, hi);
#pragma unroll
      for (int d0 = 0; d0 < 2; ++d0) stg[orow * 64 + d0 * 32 + r32] = (half_t)(o[d0][r] * rli[r]); }
    asm volatile("s_waitcnt lgkmcnt(0)" ::: "memory");
#pragma unroll
    for (int i = 0; i < 4; ++i) { const int row = i * 8 + (lane >> 3), ch = lane & 7; const u4_t v = *(const u4_t*)(stg + row * 64 + ch * 8); *(u4_t*)(Ow + (long)row * DM + ch * 8) = v; } }
  asm volatile("s_waitcnt lgkmcnt(0)\n\ts_barrier" ::: "memory");
#undef DMA_K
#undef DMA_V
#undef WAITB
#undef WAIT_BAR_N
#undef CMASK
#undef START
#undef RESC
#undef SETQE
#undef ROT
}

template <int NU>
__device__ __forceinline__ void swa_units(int b, int h, int qb0, const half_t* Zp, const float* sinks, half_t* Op, char* shm, LAS unsigned char* wsx) {
  int lane; asm volatile("v_mbcnt_lo_u32_b32 %0, -1, 0\n\tv_mbcnt_hi_u32_b32 %0, -1, %0" : "=v"(lane));
  const int r32 = lane & 31, hi = lane >> 5; const int wid = __builtin_amdgcn_readfirstlane(threadIdx.x >> 6);
  const long rowbase = (long)b * SEQ;
  const int hq = 4 * h + (wid & 3), wrow = (wid >> 2) * QBLK;
  const int qcol = ZQS + hq * 64, kcol = ZKS + h * 64, vcol = ZVS + h * 64, ocol = 512 + hq * 64;
  const unsigned lds0 = (unsigned)(uintptr_t)shm; const lds_cptr shm3 = (lds_cptr)shm;
  const unsigned koff = (unsigned)(lane * ZW + wid * 8) * 2u;
  const unsigned voff = (unsigned)((16 * (wid & 3) + (lane >> 2)) * ZW + (wid >> 2) * 32 + (lane & 3) * 8) * 2u;
  const int vlane = ((lane >> 4) & 1) * 32 + (lane & 3) * 8 + (4 * hi + ((lane & 15) >> 2)) * 64;
  LAS float* wsf = (LAS float*)(wsx + wid * 256);
  const float sinkl = sinks[hq] * LOG2E;
#define SW_T0(qb) (((qb) - 2 < 0) ? 0 : ((qb) - 2 > 61) ? 61 : (qb) - 2)
#define SW_ISSUE(qb, u) do { const int t0_ = SW_T0(qb); _Pragma("unroll") for (int t_ = 0; t_ < 3; ++t_) { \
      glds16s(Zp + (rowbase + (long)(t0_ + t_) * KVBLK) * ZW + kcol, koff, (unsigned)__builtin_amdgcn_readfirstlane(lds0 + ((u) * 6 + t_) * 8192 + wid * 1024)); \
      glds16s(Zp + (rowbase + (long)(t0_ + t_) * KVBLK) * ZW + vcol, voff, (unsigned)__builtin_amdgcn_readfirstlane(lds0 + ((u) * 6 + 3 + t_) * 8192 + wid * 1024)); } } while (0)
#define SW_QLOAD(dst, qb) do { const half_t* qw_ = Zp + (rowbase + (qb) * 64 + wrow) * ZW + qcol; _Pragma("unroll") for (int d0 = 0; d0 < 4; ++d0) dst[d0] = *reinterpret_cast<const h8_t*>(&qw_[(long)r32 * ZW + d0 * 16 + hi * 8]); } while (0)
  h8_t qc[4], qn[4];
  SW_QLOAD(qc, qb0); SW_ISSUE(qb0, 0);
#pragma unroll
  for (int i = 0; i < NU; ++i) {
    const int qb = qb0 + i, u = i & 1;
    if (i + 1 < NU) { SW_QLOAD(qn, qb + 1); SW_ISSUE(qb + 1, u ^ 1); asm volatile("s_waitcnt vmcnt(10)\n\ts_barrier" ::: "memory"); }
    else asm volatile("s_waitcnt vmcnt(0)\n\ts_barrier" ::: "memory");
    const int tile0 = SW_T0(qb), krel0 = (tile0 - qb) * 64, qrel = wrow + r32;
    f32x16 s0[3], s1[3];
#pragma unroll
    for (int t = 0; t < 3; ++t) { const lds_cptr kb = shm3 + (u * 6 + t) * 8192 + hi * 1024 + r32 * 16;
#pragma unroll
      for (int d0 = 0; d0 < 4; ++d0) { const h8_t b0 = *(const LAS h8_t*)(kb + d0 * 2048), b1 = *(const LAS h8_t*)(kb + d0 * 2048 + 512);
        if (d0 == 0) { s0[t] = MF16(b0, qc[0], f32x16{}); s1[t] = MF16(b1, qc[0], f32x16{}); } else { s0[t] = MF16(b0, qc[d0], s0[t]); s1[t] = MF16(b1, qc[d0], s1[t]); } } }
    float m = -INFINITY;
#pragma unroll
    for (int t = 0; t < 3; ++t) { smask(s0[t], s1[t], krel0 + 64 * t, qrel, hi); m = __builtin_fmaxf(m, rowmax(s0[t], s1[t])); }
    float l = 0.f; f32x16 o[2]; o[0] = f32x16{}; o[1] = f32x16{};
#pragma unroll
    for (int t = 0; t < 3; ++t) {
#pragma unroll
      for (int r = 0; r < 16; ++r) { s0[t][r] = __builtin_amdgcn_exp2f(s0[t][r] - m); s1[t][r] = __builtin_amdgcn_exp2f(s1[t][r] - m); l += s0[t][r] + s1[t][r]; }
      const u4_t pw0 = (u4_t){pkh(s0[t][0], s0[t][1]), pkh(s0[t][2], s0[t][3]), pkh(s0[t][4], s0[t][5]), pkh(s0[t][6], s0[t][7])};
      const u4_t pw1 = (u4_t){pkh(s0[t][8], s0[t][9]), pkh(s0[t][10], s0[t][11]), pkh(s0[t][12], s0[t][13]), pkh(s0[t][14], s0[t][15])};
      const u4_t pw2 = (u4_t){pkh(s1[t][0], s1[t][1]), pkh(s1[t][2], s1[t][3]), pkh(s1[t][4], s1[t][5]), pkh(s1[t][6], s1[t][7])};
      const u4_t pw3 = (u4_t){pkh(s1[t][8], s1[t][9]), pkh(s1[t][10], s1[t][11]), pkh(s1[t][12], s1[t][13]), pkh(s1[t][14], s1[t][15])};
      pv(o, (int)(unsigned)(uintptr_t)(shm3 + (u * 6 + 3 + t) * 8192 + vlane), __builtin_bit_cast(h8_t, pw0), __builtin_bit_cast(h8_t, pw1), __builtin_bit_cast(h8_t, pw2), __builtin_bit_cast(h8_t, pw3)); }
    { auto rr = __builtin_amdgcn_permlane32_swap(__float_as_uint(l), __float_as_uint(l), false, false); l = __uint_as_float(rr[0]) + __uint_as_float(rr[1]); }
    l += __builtin_amdgcn_exp2f(sinkl - m);
    if (hi == 0) wsf[32 + r32] = l; asm volatile("s_waitcnt lgkmcnt(0)" ::: "memory");
    float rli[16];
#pragma unroll
    for (int r = 0; r < 16; ++r) rli[r] = __builtin_amdgcn_rcpf(wsf[32 + crow(r, hi)]);
    half_t* Ow = Op + (rowbase + qb * 64 + wrow) * DM + ocol;
    { half_t* stg = (half_t*)(shm + 98304) + wid * 2048;
#pragma unroll
      for (int r = 0; r < 16; ++r) { const int orow = crow(r, hi);
#pragma unroll
        for (int d0 = 0; d0 < 2; ++d0) stg[orow * 64 + d0 * 32 + r32] = (half_t)(o[d0][r] * rli[r]); }
      asm volatile("s_waitcnt lgkmcnt(0)" ::: "memory");
#pragma unroll
      for (int k = 0; k < 4; ++k) { const int row = k * 8 + (lane >> 3), ch = lane & 7; const u4_t v = *(const u4_t*)(stg + row * 64 + ch * 8); *(u4_t*)(Ow + (long)row * DM + ch * 8) = v; } }
    asm volatile("s_waitcnt lgkmcnt(0)\n\ts_barrier" ::: "memory");
#pragma unroll
    for (int d0 = 0; d0 < 4; ++d0) qc[d0] = qn[d0];
  }
#undef SW_T0
#undef SW_ISSUE
#undef SW_QLOAD
}
#undef SBAR
#undef WAIT_BAR
#undef MF16
}

#define GAS __attribute__((address_space(1)))
typedef GAS unsigned gu32;
#define RLX_AGENT __ATOMIC_RELAXED, __HIP_MEMORY_SCOPE_AGENT
constexpr int CW_TMO = 0, CW_CODE = 1;
constexpr int CW_BAR = 4096;
constexpr int CW_SEAM = 16384, SEAM_BANK = 128 * 64;
constexpr int LDS_BYTES = 147456;
constexpr int MISC_OFF = 131072 + 320;
constexpr int MR_OFF = 131072 + 1024 + 8192;
constexpr int SD_OFF = 131072 + 1024 + 8192 + 4096;
constexpr int XL_OFF = 131072 + 1024;

#define XB_TMO      128
#define XB_XCNT(j)  (256  + 64 * (j))
#define XB_XSUB(j)  (1280 + 64 * (j))
#define XB_XGEN(j)  (2304 + 64 * (j))
#define XB_TOP      3328
#define XB_TOPGEN   3392
#define XCD_BAR_WORDS 3456
#define XB_LSUB(j)  (3520 + 64 * (j))
#define XB_LGEN(j)  (4544 + 64 * (j))
#define XB_SPIN_CAP (1u << 22)
__device__ __forceinline__ unsigned xb_ld(unsigned* p)              { return __hip_atomic_load(p, __ATOMIC_RELAXED, __HIP_MEMORY_SCOPE_AGENT); }
__device__ __forceinline__ unsigned xb_add(unsigned* p, unsigned v) { return __hip_atomic_fetch_add(p, v, __ATOMIC_RELAXED, __HIP_MEMORY_SCOPE_AGENT); }
__device__ __forceinline__ unsigned xb_xcc_id() { return (unsigned)__builtin_amdgcn_s_getreg((3 << 11) | 20) & 0xFu; }
#define XB_SPIN(cond, bar) do { unsigned _sp = 0; while (cond) { __builtin_amdgcn_s_sleep(1); \
    if ((++_sp & 255u) == 0u) { if (xb_ld(&(bar)[XB_TMO])) break; if (_sp > XB_SPIN_CAP) { atomicAdd(&(bar)[XB_TMO], 1u); break; } } } } while (0)
struct XcdBarrier { unsigned* bar; unsigned x; volatile LAS unsigned* st; };
__device__ __forceinline__ XcdBarrier xcd_barrier_post(unsigned* bar, volatile LAS unsigned* st) {
    XcdBarrier b; b.bar = bar; b.x = xb_xcc_id(); b.st = st;
    if (threadIdx.x == 0) st[3] = xb_add(&bar[XB_XCNT(b.x)], 1u);
    return b;
}
__device__ __forceinline__ void xcd_barrier_complete(unsigned* bar, unsigned x, unsigned& nloc, unsigned& nx, unsigned& even) {
    const unsigned G = gridDim.x * gridDim.y * gridDim.z;
    unsigned sum, cnt, mine, ev, sp = 0u;
    for (;;) {
        sum = 0u; cnt = 0u; mine = 0u; ev = 1u;
#pragma unroll
        for (unsigned j = 0; j < 16; ++j) { const unsigned c = xb_ld(&bar[XB_XCNT(j)]); sum += c; cnt += (c > 0u) ? 1u : 0u; mine = (j == x) ? c : mine; ev &= (c == ((j < 8u) ? G / 8u : 0u)) ? 1u : 0u; }
        if (sum == G) break;
        __builtin_amdgcn_s_sleep(1);
        if ((++sp & 255u) == 0u) { if (xb_ld(&bar[XB_TMO])) break; if (sp > XB_SPIN_CAP) { atomicAdd(&bar[XB_TMO], 1u); break; } }
    }
    nloc = mine > 0u ? mine : 1u; nx = cnt > 0u ? cnt : 1u; even = (sum == G) ? ev : 0u;
}
__device__ __forceinline__ void xcd_barrier(const XcdBarrier& b) {
    asm volatile("s_waitcnt vmcnt(0)" ::: "memory");
    __syncthreads();
    if (threadIdx.x == 0) {
        unsigned* bar = b.bar;
        __builtin_amdgcn_s_waitcnt(0);
        unsigned nloc = b.st[0], nx = b.st[1];
        if (nloc == 0u) { unsigned even; xcd_barrier_complete(bar, b.x, nloc, nx, even); b.st[0] = nloc; b.st[1] = nx; b.st[2] = even; }
        const unsigned old = xb_add(&bar[XB_XSUB(b.x)], 1u);
        const unsigned gen = old / nloc;
        if (old + 1u == (gen + 1u) * nloc) {
            __builtin_amdgcn_fence(__ATOMIC_RELEASE, "agent");
            asm volatile("s_waitcnt vmcnt(0)" ::: "memory");
            const unsigned og = xb_add(&bar[XB_TOP], 1u);
            const unsigned tg = og / nx;
            if (og + 1u == (tg + 1u) * nx) xb_add(&bar[XB_TOPGEN], 1u);
            else XB_SPIN(xb_ld(&bar[XB_TOPGEN]) == tg, bar);
            __builtin_amdgcn_fence(__ATOMIC_ACQUIRE, "agent");
            xb_add(&bar[XB_XGEN(b.x)], 1u);
            asm volatile("s_waitcnt vmcnt(0)" ::: "memory");
        } else {
            XB_SPIN(xb_ld(&bar[XB_XGEN(b.x)]) == gen, bar);
            __builtin_amdgcn_fence(__ATOMIC_ACQUIRE, "agent");
            asm volatile("s_waitcnt vmcnt(0)" ::: "memory");
        }
    }
    __syncthreads();
}

__device__ __forceinline__ void xcd_barrier_local(const XcdBarrier& b) {
    asm volatile("s_waitcnt vmcnt(0)" ::: "memory");
    __syncthreads();
    if (threadIdx.x == 0) {
        unsigned* bar = b.bar;
        __builtin_amdgcn_s_waitcnt(0);
        const unsigned nloc = b.st[0];
        const unsigned old = __hip_atomic_fetch_add(&bar[XB_LSUB(b.x)], 1u, __ATOMIC_RELAXED, __HIP_MEMORY_SCOPE_WORKGROUP);
        const unsigned gen = old / nloc;
        if (old + 1u == (gen + 1u) * nloc) (void)__hip_atomic_fetch_add(&bar[XB_LGEN(b.x)], 1u, __ATOMIC_RELAXED, __HIP_MEMORY_SCOPE_WORKGROUP);
        else XB_SPIN(xb_ld(&bar[XB_LGEN(b.x)]) == gen, bar);
        __builtin_amdgcn_fence(__ATOMIC_ACQUIRE, "agent");
        asm volatile("s_waitcnt vmcnt(0)" ::: "memory");
    }
    __syncthreads();
}

#ifndef REPEAT_MASK
#define REPEAT_MASK 0
#endif
#ifndef PROBE_PHASE
#define PROBE_PHASE -1
#endif
#ifndef PROBE_MODE
#define PROBE_MODE 0
#endif
constexpr int NPHASE = 14;
struct Args { Params P; int ph_lo, ph_hi, mode, pad; };
static_assert(sizeof(Args) == sizeof(Params) + 16 && sizeof(Params) == 25 * 8, "Args has no padding");

__global__ void __launch_bounds__(512, 2) mega(Args a) {
    extern __shared__ __attribute__((aligned(16))) unsigned char lds_raw[];
    LAS unsigned char* lds = (LAS unsigned char*)lds_raw;
    const Params& P = a.P;
    const int tid = threadIdx.x, wave = __builtin_amdgcn_readfirstlane(tid >> 6);
    const int G = gridDim.x, wg = blockIdx.x, gw = wg * 8 + wave, ngw = G * 8;
#define LANE_NOW() ((int)(threadIdx.x & 63u))
    unsigned char* ws = P.ws;
    volatile LAS unsigned* MISC = (volatile LAS unsigned*)(lds + MISC_OFF);
    for (int u = tid; u < (LDS_BYTES - 131072) / 4; u += 512) ((LAS unsigned*)(lds + 131072))[u] = 0u;
    __syncthreads();
    unsigned* ctl = (unsigned*)(ws + WS_CTL);
    XcdBarrier bar = xcd_barrier_post(ctl + CW_BAR, MISC + 8);
    const int lo = a.ph_lo, hi = a.ph_hi;
#define IN(k) (lo <= (k) && (k) < hi)
#define SEAM(k) do { if ((k) + 1 < hi) xcd_barrier(bar); } while (0)
#define REP_BEGIN(k) for (int rep_ = 0; rep_ <= ((REPEAT_MASK >> (k)) & 1); ++rep_) {
#define REP_END(k) if (rep_ < ((REPEAT_MASK >> (k)) & 1)) xcd_barrier(bar); }

    half_t* XH = (half_t*)(ws + WS_XH); half_t* Z = (half_t*)(ws + WS_Z); half_t* O = (half_t*)(ws + WS_O); half_t* H1 = (half_t*)(ws + WS_H1); half_t* H2 = (half_t*)(ws + WS_H2);
    half_t* QX = (half_t*)(ws + WS_QX); half_t* PX = (half_t*)(ws + WS_PX); half_t* OX = (half_t*)(ws + WS_OX); half_t* KX = (half_t*)(ws + WS_KX); half_t* VXT = (half_t*)(ws + WS_VXT);
    half_t* MEMH = (half_t*)(ws + WS_MEMH); half_t* ACT = (half_t*)(ws + WS_ACT); half_t* Y = (half_t*)(ws + WS_Y); float* TMP = (float*)(ws + WS_TMP);
    half_t* WIN = (half_t*)(ws + WS_WIN); half_t* WMO = (half_t*)(ws + WS_WMO); half_t* WXQ = (half_t*)(ws + WS_WXQ); half_t* WXK = (half_t*)(ws + WS_WXK); half_t* WXV = (half_t*)(ws + WS_WXV);
    half_t* WXO = (half_t*)(ws + WS_WXO); half_t* WGU = (half_t*)(ws + WS_WGU); half_t* WD = (half_t*)(ws + WS_WD);
    const unsigned* CNT = (const unsigned*)(ws + WS_CTL) + CW_CNT; const int* LTOK = (const int*)(ws + WS_LTOK); const float* LW = (const float*)(ws + WS_LW);

    if (IN(0)) { REP_BEGIN(0) phase_prep(P, lds, wg, G); REP_END(0) SEAM(0); }
    int vwg = wg; bool loc = false;
    if (lo == 0 && hi == NPHASE && G == 256 && __builtin_amdgcn_readfirstlane((int)MISC[10]) != 0) { loc = true; vwg = __builtin_amdgcn_readfirstlane((int)(MISC[11] * 8u + bar.x)); }
    const int vx = vwg & 7, vr = vwg >> 3;
#define SEAM_L(k) do { if ((k) + 1 < hi) { if (loc) xcd_barrier_local(bar); else xcd_barrier(bar); } } while (0)
    if (IN(1)) { REP_BEGIN(1)
        if (G == 256) { if (vr >= 24) scan_bh(P, (LAS float*)lds, vx * 8 + vr - 24); } else { for (int bh = wg; bh < 64; bh += G) scan_bh(P, (LAS float*)lds, bh); }
        if (G == 256 && vr >= 16 && vr < 20) { const pg::DenseProb g = pg::dense(MEMH, 1024, WXK, 1024, 1024); const pg::OneUnit S{vx, vr & 3}; pg::EpiF16 E{KX, 1024, 1.f, 0, 0};
          pg::gemm_phase<pg::DenseProb, pg::EpiF16, pg::OneUnit, true, false>(lds, g, S, E); }
        if (G == 256 && vr >= 20 && vr < 24) { const pg::DenseProb g = pg::dense(MEMH, 1024, WXV, 1024, 1024); const pg::OneUnit S{vx, vr & 3}; pg::EpiF16 E{VXT, 1024, 1.f, 0, 0};
          pg::gemm_phase<pg::DenseProb, pg::EpiF16, pg::OneUnit, true, false>(lds, g, S, E); }
        { const pg::DenseProb g = pg::dense(XH, 1024, WIN, 1024, 1024); pg::StaticOrder S; S.init(T / 256, ZW / 256, G, vwg, 0); pg::EpiZ E{Z, P.pos, lds + MR_OFF, a.mode, 0};
          pg::gemm_phase<pg::DenseProb, pg::EpiZ, pg::StaticOrder, true>(lds, g, S, E); }
        if (G != 256) {
          { const pg::DenseProb g = pg::dense(MEMH, 1024, WXK, 1024, 1024); pg::StaticOrder S; S.init(MROWS / 256, 4, G, wg, 0); pg::EpiF16 E{KX, 1024, 1.f, 0, 0};
            pg::gemm_phase<pg::DenseProb, pg::EpiF16, pg::StaticOrder, true>(lds, g, S, E); }
          { const pg::DenseProb g = pg::dense(MEMH, 1024, WXV, 1024, 1024); pg::StaticOrder S; S.init(MROWS / 256, 4, G, wg, 0); pg::EpiF16 E{VXT, 1024, 1.f, 0, 0};
            pg::gemm_phase<pg::DenseProb, pg::EpiF16, pg::StaticOrder, true>(lds, g, S, E); }
        }
        REP_END(1) SEAM_L(1);
    }
    if (IN(2)) { REP_BEGIN(2)
        if (G == 256) {
            const int bb = vx, jj = vr;
            const half_t* BK = (const half_t*)(ws + WS_BK); const int* TS = (const int*)(ws + WS_TS);
            { LAS int* cst = (LAS int*)(lds + 98304); LAS int* ord = cst + 128;
              if (tid < 128) cst[tid] = 4 * (tid & 15) + 4 - TS[(bb * 8 + (tid >> 4)) * 16 + (tid & 15)];
              __syncthreads();
              if (tid < 128) { const int c = cst[tid]; int rk = 0; for (int uu = 0; uu < 128; ++uu) { const int cu = cst[uu]; rk += (cu > c || (cu == c && uu < tid)) ? 1 : 0; } ord[rk] = tid; }
              __syncthreads();
              int us[4];
#pragma unroll
              for (int i = 0; i < 4; ++i) { const int pos = (i == 0) ? jj : (i == 1) ? 63 - jj : (i == 2) ? 64 + jj : 127 - jj; us[i] = __builtin_amdgcn_readfirstlane(ord[pos]); }
              __syncthreads();
              for (int i = 0; i < 4; ++i) attn::attn_unit<0, 14>(bb, us[i] >> 4, us[i] & 15, Z, BK, TS, (const float*)(ws + WS_CUM), P.sinks, O, (char*)lds_raw); }
            attn::swa_units<4>(bb, (jj * 4) >> 6, (jj * 4) & 63, Z, P.sinks, O, (char*)lds_raw, lds + XL_OFF);
        } else {
            for (int it = gw; it < 2048; it += ngw) { const int bh = it >> 5, j = it & 31; attn_naive_item<0>(P, j, bh, LANE_NOW()); attn_naive_item<0>(P, 63 - j, bh, LANE_NOW()); }
            for (int it = gw; it < 4096; it += ngw) attn_naive_item<1>(P, it & 63, it >> 6, LANE_NOW());
        }
        REP_END(2) SEAM_L(2);
    }
    if (IN(3)) { REP_BEGIN(3)
        {
          const float* U1 = (const float*)ctl + CW_U1; const float* C1 = (const float*)ctl + CW_C1; float* UB = (float*)(ws + WS_UBH); const int lane_ = LANE_NOW();
          for (int mr_ = (G == 256) ? vx * 256 + vr * 8 + wave : gw; mr_ < MROWS; mr_ += (G == 256) ? MROWS : ngw) { float su[4], sc[4];
#pragma unroll
              for (int j = 0; j < 4; ++j) { const h4_t kv = *(const h4_t*)(KX + (size_t)mr_ * DM + 256 * j + 4 * lane_); const f4_t uu = *(const f4_t*)(U1 + 256 * j + 4 * lane_), cc = *(const f4_t*)(C1 + 256 * j + 4 * lane_);
                  su[j] = (float)kv[0] * uu[0] + (float)kv[1] * uu[1] + (float)kv[2] * uu[2] + (float)kv[3] * uu[3]; sc[j] = (float)kv[0] * cc[0] + (float)kv[1] * cc[1] + (float)kv[2] * cc[2] + (float)kv[3] * cc[3]; }
#pragma unroll
              for (int j = 0; j < 4; ++j) { su[j] = wave_sum(su[j]); sc[j] = wave_sum(sc[j]); }
              if (lane_ < 4) { float a = su[0], c = sc[0];
#pragma unroll
                  for (int j = 1; j < 4; ++j) { a = (lane_ == j) ? su[j] : a; c = (lane_ == j) ? sc[j] : c; }
                  const int bh = (mr_ >> 8) * 4 + lane_; UB[bh * 256 + (mr_ & 255)] = a; UB[16384 + bh * 256 + (mr_ & 255)] = c; } }
          constexpr int XSK = (int)((XB_STRIDE - 2 * MiB) / 2);
          if (G == 256) {
            if (vr < 16) { const pg::GTProb g{KX, (const half_t*)(ws + WS_WQS), 256, 0}; const pg::OneUnit S{vx * 4 + (vr >> 2), vr & 3}; pg::EpiF16 E{(half_t*)(ws + WS_GT), 1024, 1.f, 0, XSK};
              pg::gemm_phase<pg::GTProb, pg::EpiF16, pg::OneUnit, true, false>(lds, g, S, E); }
            else { const pg::VWProb g{WXO, VXT, 256, 0}; const pg::OneUnit S{vr & 3, vx * 4 + ((vr - 16) >> 2)}; pg::EpiF16 E{(half_t*)(ws + WS_VWT), 1024, 1.f, 1, XSK};
              pg::gemm_phase<pg::VWProb, pg::EpiF16, pg::OneUnit, true, false>(lds, g, S, E); }
          } else {
            { const pg::GTProb g{KX, (const half_t*)(ws + WS_WQS), 256, 0}; pg::StaticOrder S; S.init(32, 4, G, wg, 0); pg::EpiF16 E{(half_t*)(ws + WS_GT), 1024, 1.f, 0, XSK};
              pg::gemm_phase<pg::GTProb, pg::EpiF16, pg::StaticOrder, true, false>(lds, g, S, E); }
            { const pg::VWProb g{WXO, VXT, 256, 0}; pg::StaticOrder S; S.init(4, 32, G, wg, 0); pg::EpiF16 E{(half_t*)(ws + WS_VWT), 1024, 1.f, 1, XSK};
              pg::gemm_phase<pg::VWProb, pg::EpiF16, pg::StaticOrder, true, false>(lds, g, S, E); } } }
        const pg::DenseProb g = pg::dense(O, 1024, WMO, 1024, 1024); pg::StaticOrder S; S.init(T / 256, 4, G, vwg, 0);
        pg::EpiV<0> E{XH, H1, (float*)(ws + WS_ST1), nullptr, nullptr, lds + MR_OFF};
        pg::gemm_phase<pg::DenseProb, pg::EpiV<0>, pg::StaticOrder, true>(lds, g, S, E);
        REP_END(3) SEAM_L(3);
    }
    if (IN(5)) { REP_BEGIN(5)
        { const pg::DenseProb g{H1, (const half_t*)(ws + WS_GT), (size_t)256 * 1024, 0, (size_t)256 * 1024, XB_STRIDE / 2, 1024, 1024, 1024, 0}; pg::StaticOrder S; S.init(T / 256, 4, G, vwg, 0);
          pg::row_tables(S, (const float*)(ws + WS_ST1), lds + MR_OFF);
          pg::EpiSoftmaxFold E{PX, lds + XL_OFF, (const float*)(ws + WS_UBH), lds + MR_OFF, lds + SD_OFF, C2_256, 0};
          pg::gemm_phase<pg::DenseProb, pg::EpiSoftmaxFold, pg::StaticOrder, true>(lds, g, S, E); }
        REP_END(5) SEAM_L(5);
    }
    if (IN(8)) { REP_BEGIN(8)
        const pg::DenseProb g{PX, (const half_t*)(ws + WS_VWT), (size_t)256 * 1024, 0, (size_t)256 * 1024, XB_STRIDE / 2, 1024, 1024, 1024, 0}; pg::StaticOrder S; S.init(T / 256, 4, G, vwg, 0);
        pg::row_tables(S, (const float*)(ws + WS_ST1), lds + MR_OFF);
        pg::EpiV<1> E{H1, (half_t*)(ws + WS_V2), (float*)(ws + WS_ST2), P.ln_mix_g, P.ln_mix_b, lds + MR_OFF};
        pg::gemm_phase<pg::DenseProb, pg::EpiV<1>, pg::StaticOrder, true>(lds, g, S, E);
        REP_END(8) SEAM_L(8);
    }
    if (IN(10)) { REP_BEGIN(10)
        const bool conv_first = (wg & 1) != 0;
        for (int pass = 0; pass < 2; ++pass) {
            if ((pass == 0) == conv_first) { LAS float* scr = (LAS float*)(lds + 32768 + wave * 8448); const int ln_ = LANE_NOW();
                for (int it = gw; it < NQ_GU; it += ngw) conv_gu_item(P, scr, it, ln_); __syncthreads(); }
            else { for (int it = (G == 256) ? vx * 32 + vr : wg; it < T / 128; it += G) route_tokens_fast(P, lds, it * 128); } }
        REP_END(10) SEAM(10);
    }
    if (IN(11)) { REP_BEGIN(11)
        const pg::GUProb g{(const half_t*)(ws + WS_V2), WGU, CNT, LTOK, lds + XL_OFF, 1024, 0}; pg::MoeOrder S; S.init(CNT, G, wg, lds + SD_OFF);
        pg::EpiGU E{ACT, (const float*)ctl + CW_UGU, (const float*)ctl + CW_CGU, (const float*)(ws + WS_LMR), lds + MR_OFF};
        pg::gemm_phase<pg::GUProb, pg::EpiGU, pg::MoeOrder, true>(lds, g, S, E);
        {
          const int first = (S.total > 4 * G && S.total < 5 * G) ? S.total - 4 * G : 0, nsl = G - first;
          if (wg >= first) { LAS float* scr = (LAS float*)(lds + 32768 + wave * 8448); const int ln_ = LANE_NOW();
              for (int it = (wg - first) * 8 + wave; it < NQ_WD; it += nsl * 8) conv_wd_item(P, scr, it, ln_); } }
        REP_END(11) SEAM(11);
    }
    if (IN(12)) { REP_BEGIN(12)
        const pg::DownProb g{ACT, WD, 512, 0}; pg::MoeOrder S; S.init(CNT, G, wg, lds + SD_OFF); pg::EpiDown E{Y, CNT, LTOK, LW, lds + MR_OFF};
        pg::gemm_phase<pg::DownProb, pg::EpiDown, pg::MoeOrder, true>(lds, g, S, E);
        REP_END(12) SEAM(12);
    }
    if (IN(13)) { REP_BEGIN(13) final_ln_rows(P, gw, ngw, LANE_NOW()); REP_END(13) }
#undef IN
#undef SEAM
#undef SEAM_L
}

extern "C" void kernel_launch(void* const* d_in, const int* in_sizes, int n_in, void* d_out, int out_size, void* d_ws, size_t ws_size, hipStream_t stream) {
    static int grid = 0;
    if (grid == 0) {
        if (n_in != 23 || in_sizes[0] != T * DM || out_size != T * DM || ws_size < WS_END) { fprintf(stderr, "kernel_launch: unexpected shapes (n_in %d, in0 %d, out %d, ws %zu)\n", n_in, n_in > 0 ? in_sizes[0] : -1, out_size, ws_size); grid = -1; return; }
        int dev = 0, cus = 0;
        if (hipGetDevice(&dev) != hipSuccess || hipDeviceGetAttribute(&cus, hipDeviceAttributeMultiprocessorCount, dev) != hipSuccess) { grid = -1; return; }
        if (hipFuncSetAttribute((const void*)mega, hipFuncAttributeMaxDynamicSharedMemorySize, LDS_BYTES) != hipSuccess) { fprintf(stderr, "kernel_launch: hipFuncSetAttribute failed\n"); grid = -1; return; }
        int per_cu = 0;
        if (hipOccupancyMaxActiveBlocksPerMultiprocessor(&per_cu, (const void*)mega, 512, LDS_BYTES) != hipSuccess || per_cu < 1) fprintf(stderr, "kernel_launch: occupancy query reports %d\n", per_cu);
        (void)hipGetLastError();
        grid = cus;
    }
    if (grid < 0) return;
    (void)hipMemsetAsync((char*)d_ws + WS_CTL, 0, CTL_BYTES, stream);
    Args a{};
    Params& P = a.P;
    P.x = (const float*)d_in[0]; P.mem = (const float*)d_in[1]; P.pos = (const int*)d_in[2]; P.w_in = (const float*)d_in[3]; P.b_forget = (const float*)d_in[4];
    P.sinks = (const float*)d_in[5]; P.w_mix_out = (const float*)d_in[6]; P.ln_mix_g = (const float*)d_in[7]; P.ln_mix_b = (const float*)d_in[8];
    P.w_xq = (const float*)d_in[9]; P.w_xkv = (const float*)d_in[10]; P.w_xout = (const float*)d_in[11]; P.ln_x_g = (const float*)d_in[12]; P.ln_x_b = (const float*)d_in[13];
    P.w_rg = (const float*)d_in[14]; P.b_rg = (const float*)d_in[15]; P.w_re = (const float*)d_in[16]; P.b_re = (const float*)d_in[17];
    P.w_gate = (const float*)d_in[18]; P.w_up = (const float*)d_in[19]; P.w_down = (const float*)d_in[20]; P.ln_f_g = (const float*)d_in[21]; P.ln_f_b = (const float*)d_in[22];
    P.out = (float*)d_out; P.ws = (unsigned char*)d_ws;
    a.ph_lo = 0; a.ph_hi = NPHASE;
    hipLaunchKernelGGL(mega, dim3(grid), dim3(512), LDS_BYTES, stream, a);
#if PROBE_PHASE >= 0
    a.ph_lo = PROBE_PHASE; a.ph_hi = PROBE_PHASE + 1; a.mode = PROBE_MODE;
    hipLaunchKernelGGL(mega, dim3(grid), dim3(512), LDS_BYTES, stream, a);
#endif
}
```

```cpp
#include <hip/hip_runtime.h>
#include <cstdio>
#include <cstdint>

typedef _Float16 half_t;
typedef _Float16 h2_t __attribute__((ext_vector_type(2)));
typedef _Float16 h4_t __attribute__((ext_vector_type(4)));
typedef _Float16 h8_t __attribute__((ext_vector_type(8)));
typedef float f2_t __attribute__((ext_vector_type(2)));
typedef float f4_t __attribute__((ext_vector_type(4)));
typedef unsigned u4_t __attribute__((ext_vector_type(4)));
#define LAS __attribute__((address_space(3)))

constexpr int DM = 1024, NB = 8, SEQ = 4096, T = NB * SEQ;
constexpr int NMEM = 256, MROWS = NB * NMEM;
constexpr int INW = 2312, ZW = 2304;
constexpr int NEXP = 32, DEXP = 512, LCAP = T;
constexpr float ALPHA = 1.189207115002721f;
constexpr float LOG2E = 1.4426950408889634f;
constexpr float C2_64 = 0.125f * LOG2E;
constexpr float C2_256 = 0.0625f * LOG2E;
constexpr float LN_EPS = 1e-5f;
constexpr float FOX_CUT = 256.f;
constexpr int ZQF = 0, ZKF = 512, ZVF = 1024, ZQS = 1536, ZKS = 2048, ZVS = 2176;

constexpr size_t MiB = 1u << 20;
constexpr size_t WS_CTL = 0, CTL_BYTES = 1 * MiB;
constexpr size_t WS_WIN = 1 * MiB;
constexpr size_t WS_WMO = 6 * MiB;
constexpr size_t WS_WXQ = 8 * MiB, WS_WXK = 10 * MiB, WS_WXV = 12 * MiB, WS_WXO = 14 * MiB;
constexpr size_t WS_WR = 16 * MiB;
constexpr size_t WS_WGU = 17 * MiB;
constexpr size_t WS_WD = 81 * MiB;
constexpr size_t WS_LOGF = 113 * MiB;
constexpr size_t WS_CUM = 114 * MiB;
constexpr size_t WS_BK = 496 * MiB + 2 * MiB;
constexpr size_t WS_MEMH = 115 * MiB;
constexpr size_t WS_KX = 119 * MiB;
constexpr size_t WS_VXT = 123 * MiB;
constexpr size_t WS_LG = 127 * MiB;
constexpr size_t WS_LMR = 127 * MiB;
constexpr size_t WS_MR2 = 135 * MiB;
constexpr size_t WS_WQS = 136 * MiB;
constexpr size_t WS_UBH = 138 * MiB;
constexpr size_t WS_GT = 224 * MiB;
constexpr size_t WS_VWT = 226 * MiB;
constexpr size_t XB_STRIDE = 18 * MiB;
constexpr size_t WS_LTOK = 151 * MiB;
constexpr size_t WS_LW = 155 * MiB;
constexpr size_t WS_XH = 160 * MiB;
constexpr size_t WS_H2 = WS_XH;
constexpr size_t WS_Z = 224 * MiB;
constexpr size_t WS_QX = 224 * MiB;
constexpr size_t WS_PX = 368 * MiB;
constexpr size_t WS_Y = 224 * MiB;
constexpr size_t WS_TMP = 224 * MiB;
constexpr size_t WS_O = 368 * MiB;
constexpr size_t WS_OX = 368 * MiB;
constexpr size_t WS_ACT = 368 * MiB;
constexpr size_t WS_H1 = 432 * MiB;
constexpr size_t WS_V2 = 160 * MiB;
constexpr size_t WS_XB = 496 * MiB;
constexpr size_t WS_TS = 502 * MiB;
constexpr size_t WS_ST1 = 503 * MiB;
constexpr size_t WS_ST2 = 507 * MiB;
constexpr size_t WS_END = 511 * MiB;
constexpr int CW_CNT = 64;
constexpr int CW_UGU = 131072, CW_CGU = 163840;
constexpr int CW_UR = 196608, CW_CR = 196672;
constexpr int CW_U1 = 65536, CW_C1 = 65536 + 1024;

struct Params {
    const float* x; const float* mem; const int* pos; const float* w_in; const float* b_forget; const float* sinks; const float* w_mix_out;
    const float* ln_mix_g; const float* ln_mix_b; const float* w_xq; const float* w_xkv; const float* w_xout; const float* ln_x_g; const float* ln_x_b;
    const float* w_rg; const float* b_rg; const float* w_re; const float* b_re; const float* w_gate; const float* w_up; const float* w_down;
    const float* ln_f_g; const float* ln_f_b;
    float* out; unsigned char* ws;
};

__device__ __forceinline__ float wave_sum(float v) {
#pragma unroll
    for (int o = 1; o < 64; o <<= 1) v += __shfl_xor(v, o);
    return v;
}
__device__ __forceinline__ unsigned pkh(float lo, float hi) { f2_t v = {lo, hi}; h2_t h = __builtin_convertvector(v, h2_t); return __builtin_bit_cast(unsigned, h); }
__device__ __forceinline__ float inv_freq(int i) { return exp2f(-(float)i * (13.287712379549449f / 32.0f)); }
__device__ __forceinline__ void rope_cs(int pos, int i, float& c, float& s) {
    const float ang = (float)pos * inv_freq(i);
    const float rev = ang * 0.15915494309189535f; const float fr = rev - floorf(rev);
    s = __builtin_amdgcn_sinf(fr); c = __builtin_amdgcn_cosf(fr);
}

__device__ __forceinline__ int win_dest(int c) {
    if (c < 1536) return c;
    if (c < 1544) return -1;
    if (c < 2056) { const int cc = c - 1544, hd = cc >> 6, d = cc & 63; return ZQS + hd * 64 + ((d < 32) ? 2 * d : 2 * (d - 32) + 1); }
    if (c < 2184) { const int cc = c - 2056, hd = cc >> 6, d = cc & 63; return ZKS + hd * 64 + ((d < 32) ? 2 * d : 2 * (d - 32) + 1); }
    if (c < 2312) return ZVS + (c - 2184);
    return -1;
}
template <class DestFn>
__device__ __forceinline__ void tr_item(const float* W, int ldw, int N, half_t* WT, int ldt, LAS float* scr, int k0, int n0, int lane, DestFn dest) {
    float tv[32];
    { const int n = n0 + (lane & 31); const bool ok = n < N; const float* wp = W + (size_t)(k0 + (lane >> 5)) * ldw + (ok ? n : 0);
#pragma unroll
      for (int i = 0; i < 32; ++i) tv[i] = wp[(size_t)(2 * i) * ldw];
#pragma unroll
      for (int i = 0; i < 32; ++i) scr[(2 * i + (lane >> 5)) * 33 + (lane & 31)] = ok ? tv[i] : 0.f; }
    asm volatile("s_waitcnt lgkmcnt(0)" ::: "memory");
    const int c = lane & 7;
#pragma unroll
    for (int j = 0; j < 4; ++j) { const int nl = (lane >> 3) + 8 * j; const LAS float* s = scr + (8 * c) * 33 + nl;
        u4_t o; o.x = pkh(s[0 * 33], s[1 * 33]); o.y = pkh(s[2 * 33], s[3 * 33]); o.z = pkh(s[4 * 33], s[5 * 33]); o.w = pkh(s[6 * 33], s[7 * 33]);
        const int dr = (n0 + nl < N) ? dest(n0 + nl) : -1;
        if (dr >= 0) *(u4_t*)(WT + (size_t)dr * ldt + k0 + 8 * c) = o; }
    asm volatile("s_waitcnt lgkmcnt(0)" ::: "memory");
}
template <class DestFn>
__device__ __forceinline__ void tr_item_ln(const float* W, int ldw, half_t* WT, LAS float* scr, int k0, int n0, int lane, const float* gk, const float* bk, float* U, float* C, DestFn dest) {
    float tv[32];
    { const float* wp = W + (size_t)(k0 + (lane >> 5)) * ldw + n0 + (lane & 31);
#pragma unroll
      for (int i = 0; i < 32; ++i) tv[i] = wp[(size_t)(2 * i) * ldw];
#pragma unroll
      for (int i = 0; i < 32; ++i) scr[(2 * i + (lane >> 5)) * 33 + (lane & 31)] = tv[i]; }
    asm volatile("s_waitcnt lgkmcnt(0)" ::: "memory");
    const int c = lane & 7;
    float gs[8], bs[8];
#pragma unroll
    for (int i = 0; i < 8; ++i) { gs[i] = gk[k0 + 8 * c + i]; bs[i] = bk[k0 + 8 * c + i]; }
#pragma unroll
    for (int j = 0; j < 4; ++j) { const int nl = (lane >> 3) + 8 * j; const LAS float* sp = scr + (8 * c) * 33 + nl; const int dr = dest(n0 + nl);
        float sv[8]; float pu = 0.f, pc = 0.f;
#pragma unroll
        for (int i = 0; i < 8; ++i) { const float v = sp[i * 33]; sv[i] = v * gs[i]; pu += sv[i]; pc += v * bs[i]; }
        u4_t o; o.x = pkh(sv[0], sv[1]); o.y = pkh(sv[2], sv[3]); o.z = pkh(sv[4], sv[5]); o.w = pkh(sv[6], sv[7]);
        *(u4_t*)(WT + (size_t)dr * 1024 + k0 + 8 * c) = o;
        pu += __shfl_xor(pu, 1); pu += __shfl_xor(pu, 2); pu += __shfl_xor(pu, 4);
        pc += __shfl_xor(pc, 1); pc += __shfl_xor(pc, 2); pc += __shfl_xor(pc, 4);
        if (c == 0) { atomicAdd(U + dr, pu); atomicAdd(C + dr, pc); } }
    asm volatile("s_waitcnt lgkmcnt(0)" ::: "memory");
}
constexpr int NQ_GU = NEXP * 512;
__device__ __forceinline__ void conv_gu_item(const Params& P, LAS float* scr, int it, int lane) {
    half_t* WGU = (half_t*)(P.ws + WS_WGU); const int e = it >> 9; int r = it & 511; float* U = (float*)(P.ws + WS_CTL) + CW_UGU + e * 1024; float* C = (float*)(P.ws + WS_CTL) + CW_CGU + e * 1024;
    if (r < 256) tr_item_ln(P.w_gate + (size_t)e * 1024 * 512, 512, WGU + (size_t)e * 1024 * 1024, scr, 64 * (r / 16), 32 * (r % 16), lane, P.ln_x_g, P.ln_x_b, U, C, [](int c) { return 2 * c; });
    else { r -= 256; tr_item_ln(P.w_up + (size_t)e * 1024 * 512, 512, WGU + (size_t)e * 1024 * 1024, scr, 64 * (r / 16), 32 * (r % 16), lane, P.ln_x_g, P.ln_x_b, U, C, [](int c) { return 2 * c + 1; }); }
}
constexpr int NQ_WD = NEXP * 256;
__device__ __forceinline__ void conv_wd_item(const Params& P, LAS float* scr, int it, int lane) {
    half_t* WD = (half_t*)(P.ws + WS_WD); const int e = it >> 8, r = it & 255;
    tr_item(P.w_down + (size_t)e * 512 * 1024, 1024, 1024, WD + (size_t)e * 1024 * 512, 512, scr, 64 * (r / 32), 32 * (r % 32), lane, [](int c) { return c; });
}
constexpr int P0_LDS = 32768 + 8 * 8448;
__device__ __forceinline__ void phase_prep(const Params& P, LAS unsigned char* lds, int wg, int nwg) {
    const int tid = threadIdx.x, lane = tid & 63, wave = __builtin_amdgcn_readfirstlane(tid >> 6);
    constexpr int NXW = 5;
    const bool xw = wave < NXW;
    const int gw = xw ? wg * NXW + wave : wg * (8 - NXW) + (wave - NXW), ngw = xw ? nwg * NXW : nwg * (8 - NXW);
    LAS float* wfT = (LAS float*)lds;
    LAS float* scr = (LAS float*)(lds + 32768 + wave * 8448);
    for (int k = tid; k < 1024; k += 512) { const f4_t a = *(const f4_t*)(P.w_in + (size_t)k * INW + 1536), b = *(const f4_t*)(P.w_in + (size_t)k * INW + 1540);
        wfT[0 * 1024 + k] = a.x; wfT[1 * 1024 + k] = a.y; wfT[2 * 1024 + k] = a.z; wfT[3 * 1024 + k] = a.w; wfT[4 * 1024 + k] = b.x; wfT[5 * 1024 + k] = b.y; wfT[6 * 1024 + k] = b.z; wfT[7 * 1024 + k] = b.w; }
    __syncthreads();
    half_t* XH = (half_t*)(P.ws + WS_XH); float* LOGF = (float*)(P.ws + WS_LOGF);
    if (xw) { f4_t wfr[8][4];
#pragma unroll
      for (int h = 0; h < 8; ++h)
#pragma unroll
          for (int j = 0; j < 4; ++j) wfr[h][j] = *(const LAS f4_t*)(wfT + h * 1024 + 256 * j + 4 * lane);
      const int hsel = ((lane >> 5) & 1) * 4 + ((lane >> 4) & 1) * 2 + ((lane >> 3) & 1);
      const float bfg = P.b_forget[hsel];
      f4_t vc[2][4], vn[2][4];
      int row = 2 * gw;
      if (row < T) {
#pragma unroll
          for (int q = 0; q < 2; ++q) { const f4_t* xr = (const f4_t*)(P.x + (size_t)(row + q) * DM) + lane;
#pragma unroll
              for (int j = 0; j < 4; ++j) vc[q][j] = xr[64 * j]; } }
      for (; row < T; row += 2 * ngw) {
          const int nrow = row + 2 * ngw;
          if (nrow < T) {
#pragma unroll
              for (int q = 0; q < 2; ++q) { const f4_t* xr = (const f4_t*)(P.x + (size_t)(nrow + q) * DM) + lane;
#pragma unroll
                  for (int j = 0; j < 4; ++j) vn[q][j] = xr[64 * j]; } }
#pragma unroll
          for (int q = 0; q < 2; ++q) {
#pragma unroll
              for (int j = 0; j < 4; ++j) { unsigned long long w = (unsigned long long)pkh(vc[q][j].x, vc[q][j].y) | ((unsigned long long)pkh(vc[q][j].z, vc[q][j].w) << 32);
                  *(unsigned long long*)(XH + (size_t)(row + q) * DM + 256 * j + 4 * lane) = w; }
              float a[8];
#pragma unroll
              for (int h = 0; h < 8; ++h) { float t = 0.f;
#pragma unroll
                  for (int j = 0; j < 4; ++j) t += vc[q][j].x * wfr[h][j].x + vc[q][j].y * wfr[h][j].y + vc[q][j].z * wfr[h][j].z + vc[q][j].w * wfr[h][j].w;
                  a[h] = t; }
              float b4[4], b2[2], b1;
              { const bool up = (lane & 32) != 0;
#pragma unroll
                for (int i = 0; i < 4; ++i) { const float keep = up ? a[i + 4] : a[i], send = up ? a[i] : a[i + 4]; b4[i] = keep + __shfl_xor(send, 32); } }
              { const bool up = (lane & 16) != 0;
#pragma unroll
                for (int i = 0; i < 2; ++i) { const float keep = up ? b4[i + 2] : b4[i], send = up ? b4[i] : b4[i + 2]; b2[i] = keep + __shfl_xor(send, 16); } }
              { const bool up = (lane & 8) != 0; const float keep = up ? b2[1] : b2[0], send = up ? b2[0] : b2[1]; b1 = keep + __shfl_xor(send, 8); }
              b1 += __shfl_xor(b1, 4); b1 += __shfl_xor(b1, 2); b1 += __shfl_xor(b1, 1);
              if ((lane & 7) == 0) { const float z = b1 + bfg; const float ls = (z >= 0.f) ? -log1pf(expf(-z)) : (z - log1pf(expf(z))); LOGF[(size_t)(row + q) * 8 + hsel] = ls; }
          }
#pragma unroll
          for (int q = 0; q < 2; ++q)
#pragma unroll
              for (int j = 0; j < 4; ++j) vc[q][j] = vn[q][j];
      }
    }
    if (!xw) {
    half_t* MEMH = (half_t*)(P.ws + WS_MEMH);
    for (int row = gw; row < MROWS; row += ngw) {
        const f4_t* xr = (const f4_t*)(P.mem + (size_t)row * DM) + lane;
#pragma unroll
        for (int j = 0; j < 4; ++j) { const f4_t v = xr[64 * j]; unsigned long long w = (unsigned long long)pkh(v.x, v.y) | ((unsigned long long)pkh(v.z, v.w) << 32);
            *(unsigned long long*)(MEMH + (size_t)row * DM + 256 * j + 4 * lane) = w; }
    }
    { half_t* WRH = (half_t*)(P.ws + WS_WR); half_t* WRL = WRH + 48 * 1024;
      for (int i = gw * 64 + lane; i < 48 * 1024; i += ngw * 64) { const int r = i >> 10, k = i & 1023; float v = 0.f;
          if (r < 4) v = P.w_rg[k * 4 + r]; else if (r < 36) { const int g = (r - 4) >> 3, e = (r - 4) & 7; v = P.w_re[((size_t)g * 1024 + k) * 8 + e]; }
          v *= 32.f * P.ln_x_g[k]; const half_t hi = (half_t)v; const half_t lo = (half_t)(v - (float)hi); WRH[i] = hi; WRL[i] = lo; }
      for (int r = gw; r < 48; r += ngw) { float pu = 0.f, pc = 0.f;
          for (int k = lane; k < 1024; k += 64) { float v = 0.f;
              if (r < 4) v = P.w_rg[k * 4 + r]; else if (r < 36) { const int g = (r - 4) >> 3, e = (r - 4) & 7; v = P.w_re[((size_t)g * 1024 + k) * 8 + e]; }
              pu += 32.f * v * P.ln_x_g[k]; pc += 32.f * v * P.ln_x_b[k]; }
          pu = wave_sum(pu); pc = wave_sum(pc);
          if (lane == 0) { ((float*)(P.ws + WS_CTL))[CW_UR + r] = pu; ((float*)(P.ws + WS_CTL))[CW_CR + r] = pc; } } }
    { half_t* WQS = (half_t*)(P.ws + WS_WQS);
      for (int i = gw * 64 + lane; i < 1024 * 256; i += ngw * 64) { const int k = i >> 8; const f4_t v = *(const f4_t*)(P.w_xq + (size_t)i * 4) * P.ln_mix_g[k];
          *(unsigned long long*)(WQS + (size_t)i * 4) = (unsigned long long)pkh(v.x, v.y) | ((unsigned long long)pkh(v.z, v.w) << 32); } }
    constexpr int I_IN = 16 * 73, I_DD = 16 * 32, I_KV = 16 * 64, I_G = 16 * 16, I_D = 8 * 32;
    constexpr int NIT = I_IN + 3 * I_DD + I_KV;
    half_t* WIN = (half_t*)(P.ws + WS_WIN); half_t* WMO = (half_t*)(P.ws + WS_WMO); half_t* WXQ = (half_t*)(P.ws + WS_WXQ); half_t* WXK = (half_t*)(P.ws + WS_WXK);
    half_t* WXO = (half_t*)(P.ws + WS_WXO); half_t* WGU = (half_t*)(P.ws + WS_WGU); half_t* WD = (half_t*)(P.ws + WS_WD);
    for (int it = gw; it < NIT; it += ngw) {
        int r = it;
        if (r < I_IN) { tr_item(P.w_in, INW, INW, WIN, 1024, scr, 64 * (r / 73), 32 * (r % 73), lane, [](int c) { return win_dest(c); }); continue; } r -= I_IN;
        if (r < I_DD) { tr_item(P.w_mix_out, 1024, 1024, WMO, 1024, scr, 64 * (r / 32), 32 * (r % 32), lane, [](int c) { return c; }); continue; } r -= I_DD;
        if (r < I_DD) { tr_item_ln(P.w_xq, 1024, WXQ, scr, 64 * (r / 32), 32 * (r % 32), lane, P.ln_mix_g, P.ln_mix_b, (float*)(P.ws + WS_CTL) + CW_U1, (float*)(P.ws + WS_CTL) + CW_C1, [](int c) { return c; }); continue; } r -= I_DD;
        if (r < I_DD) { tr_item(P.w_xout, 1024, 1024, WXO, 1024, scr, 64 * (r / 32), 32 * (r % 32), lane, [](int c) { return c; }); continue; } r -= I_DD;
        tr_item(P.w_xkv, 2048, 2048, WXK, 1024, scr, 64 * (r / 64), 32 * (r % 64), lane, [](int c) { return c; });
    }
    }
}

__device__ __forceinline__ void scan_bh(const Params& P, LAS float* sh, int bh) {
    const int tid = threadIdx.x, lane = tid & 63, wave = tid >> 6, b = bh >> 3, h = bh & 7;
    const float* LOGF = (const float*)(P.ws + WS_LOGF); float* CUM = (float*)(P.ws + WS_CUM);
    float v[8]; float run = 0.f;
#pragma unroll
    for (int i = 0; i < 8; ++i) { run += LOGF[((size_t)b * SEQ + tid * 8 + i) * 8 + h]; v[i] = run; }
    float inc = run;
#pragma unroll
    for (int o = 1; o < 64; o <<= 1) { const float t = __shfl_up(inc, o); if (lane >= o) inc += t; }
    if (lane == 63) sh[wave] = inc;
    __syncthreads();
    float base = inc - run;
    for (int w = 0; w < wave; ++w) base += sh[w];
    half_t* BK = (half_t*)(P.ws + WS_BK);
#pragma unroll
    for (int i = 0; i < 8; ++i) { const float c = base + v[i]; CUM[(size_t)bh * SEQ + tid * 8 + i] = c;
        const float bias = -c * LOG2E; const half_t bh_ = (half_t)bias; const half_t bl_ = (half_t)(bias - (float)bh_);
        u4_t w; w.x = (unsigned)__builtin_bit_cast(unsigned short, bh_) | ((unsigned)__builtin_bit_cast(unsigned short, bl_) << 16); w.y = 0x3C003C00u; w.z = 0u; w.w = 0u;
        *(u4_t*)(BK + ((size_t)bh * SEQ + tid * 8 + i) * 8) = w; }
    if ((tid & 7) == 7) sh[16 + (tid >> 3)] = base + v[7];
    if ((tid & 31) == 0) sh[80 + (tid >> 5)] = base + v[0];
    __syncthreads();
    if (tid < 16) { const float cq = sh[80 + tid]; int t = 0; while (t < 4 * tid && (sh[16 + t] - cq) * LOG2E > FOX_CUT) ++t; ((int*)(P.ws + WS_TS))[bh * 16 + tid] = t & ~1; }
    __syncthreads();
}

template <class F>
__device__ __forceinline__ void gemm_naive_phase(const F& f, LAS unsigned char* lds, int wg, int nwg, int nz, int Mmax, int N) {
    LAS float* As = (LAS float*)lds;
    LAS float* Bs = As + 16 * 68;
    const int K = f.K, tid = threadIdx.x;
    const int ntm = Mmax / 64, ntn = N / 128, per = ntm * ntn, total = nz * per;
    const int lr = tid >> 2, lk = (tid & 3) * 4, ty = tid >> 5, tx = tid & 31;
    for (int it = wg; it < total; it += nwg) {
        const int z = it / per, r = it % per, m0 = (r / ntn) * 64, n0 = (r % ntn) * 128;
        if (m0 >= f.mrows(z)) continue;
        const half_t* ap = f.arow(z, m0 + (lr & 63)) + lk; const half_t* bp = f.brow(z, n0 + lr) + lk;
        float acc[4][4];
#pragma unroll
        for (int i = 0; i < 4; ++i)
#pragma unroll
            for (int j = 0; j < 4; ++j) acc[i][j] = 0.f;
        for (int k0 = 0; k0 < K; k0 += 16) {
            const h4_t av = *(const h4_t*)(ap + k0), bv = *(const h4_t*)(bp + k0);
            __syncthreads();
#pragma unroll
            for (int i = 0; i < 4; ++i) { if (tid < 256) As[(lk + i) * 68 + lr] = (float)av[i]; Bs[(lk + i) * 132 + lr] = (float)bv[i]; }
            __syncthreads();
#pragma unroll
            for (int k = 0; k < 16; ++k) { const f4_t a = *(const LAS f4_t*)&As[k * 68 + ty * 4], b = *(const LAS f4_t*)&Bs[k * 132 + tx * 4];
#pragma unroll
                for (int i = 0; i < 4; ++i)
#pragma unroll
                    for (int j = 0; j < 4; ++j) acc[i][j] += a[i] * b[j]; }
        }
#pragma unroll
        for (int i = 0; i < 4; ++i) f.epi(z, m0 + ty * 4 + i, n0 + tx * 4, acc[i]);
    }
    __syncthreads();
}

struct FZ {
    const half_t* XH; const half_t* WIN; half_t* Z; const int* pos; int K, pad;
    __device__ int mrows(int) const { return T; }
    __device__ const half_t* arow(int, int m) const { return XH + (size_t)m * DM; }
    __device__ const half_t* brow(int, int n) const { return WIN + (size_t)n * DM; }
    __device__ void epi(int, int m, int n0, float* v) const {
        float o[4] = {v[0], v[1], v[2], v[3]};
        if (n0 >= ZQS && n0 < ZVS) { const int p = pos[m]; const int i0 = (n0 & 63) >> 1; float c, s;
            rope_cs(p, i0, c, s); o[0] = v[0] * c - v[1] * s; o[1] = v[1] * c + v[0] * s;
            rope_cs(p, i0 + 1, c, s); o[2] = v[2] * c - v[3] * s; o[3] = v[3] * c + v[2] * s; }
        if (n0 < ZKF || (n0 >= ZQS && n0 < ZKS)) { o[0] *= C2_64; o[1] *= C2_64; o[2] *= C2_64; o[3] *= C2_64; }
        unsigned long long w = (unsigned long long)pkh(o[0], o[1]) | ((unsigned long long)pkh(o[2], o[3]) << 32);
        *(unsigned long long*)(Z + (size_t)m * ZW + n0) = w;
    }
};
struct FPlain {
    const half_t* A; const half_t* B; half_t* C; int lda, ldb, ldc, M; float scale; int K;
    __device__ int mrows(int) const { return M; }
    __device__ const half_t* arow(int, int m) const { return A + (size_t)m * lda; }
    __device__ const half_t* brow(int, int n) const { return B + (size_t)n * ldb; }
    __device__ void epi(int, int m, int n0, float* v) const {
        unsigned long long w = (unsigned long long)pkh(v[0] * scale, v[1] * scale) | ((unsigned long long)pkh(v[2] * scale, v[3] * scale) << 32);
        *(unsigned long long*)(C + (size_t)m * ldc + n0) = w;
    }
};
struct FTmp {
    const half_t* A; const half_t* B; float* C; int K, pad;
    __device__ int mrows(int) const { return T; }
    __device__ const half_t* arow(int, int m) const { return A + (size_t)m * DM; }
    __device__ const half_t* brow(int, int n) const { return B + (size_t)n * DM; }
    __device__ void epi(int, int m, int n0, float* v) const { *(f4_t*)(C + (size_t)m * DM + n0) = (f4_t){v[0], v[1], v[2], v[3]}; }
};
struct FPV {
    const half_t* PX; const half_t* VXT; half_t* OX; int K, pad;
    __device__ int mrows(int) const { return SEQ; }
    __device__ const half_t* arow(int z, int m) const { return PX + ((size_t)(z >> 2) * SEQ + m) * DM + (z & 3) * 256; }
    __device__ const half_t* brow(int z, int n) const { return VXT + ((size_t)(z & 3) * 256 + n) * MROWS + (z >> 2) * 256; }
    __device__ void epi(int z, int m, int n0, float* v) const {
        unsigned long long w = (unsigned long long)pkh(v[0], v[1]) | ((unsigned long long)pkh(v[2], v[3]) << 32);
        *(unsigned long long*)(OX + ((size_t)(z >> 2) * SEQ + m) * DM + (z & 3) * 256 + n0) = w;
    }
};
__device__ __forceinline__ int pbase_of(const unsigned* cnt, int e) { int b = 0; for (int i = 0; i < e; ++i) b += ((int)cnt[i] + 255) & ~255; return b; }
struct FGU {
    const half_t* H2; const half_t* WGU; half_t* ACT; const unsigned* cnt; const int* ltok; int K, pad;
    __device__ int mrows(int z) const { return (int)cnt[z]; }
    __device__ const half_t* arow(int z, int m) const { const int c = (int)cnt[z]; const int tk = (m < c) ? (ltok[(size_t)z * LCAP + m] >> 1) : 0; return H2 + (size_t)tk * DM; }
    __device__ const half_t* brow(int z, int n) const { return WGU + ((size_t)z * 1024 + n) * 1024; }
    __device__ void epi(int z, int m, int n0, float* v) const {
        const float a0 = v[0] / (1.f + expf(-v[0])) * v[1], a1 = v[2] / (1.f + expf(-v[2])) * v[3];
        *(unsigned*)(ACT + ((size_t)pbase_of(cnt, z) + m) * DEXP + (n0 >> 1)) = pkh(a0, a1);
    }
};
struct FDown {
    const half_t* ACT; const half_t* WD; half_t* Y; const unsigned* cnt; const int* ltok; const float* lw; int K, pad;
    __device__ int mrows(int z) const { return (int)cnt[z]; }
    __device__ const half_t* arow(int z, int m) const { return ACT + ((size_t)pbase_of(cnt, z) + m) * DEXP; }
    __device__ const half_t* brow(int z, int n) const { return WD + ((size_t)z * 1024 + n) * DEXP; }
    __device__ void epi(int z, int m, int n0, float* v) const {
        if (m >= (int)cnt[z]) return;
        const int t2 = ltok[(size_t)z * LCAP + m]; const float g = lw[(size_t)z * LCAP + m];
        unsigned long long w = (unsigned long long)pkh(v[0] * g, v[1] * g) | ((unsigned long long)pkh(v[2] * g, v[3] * g) << 32);
        *(unsigned long long*)(Y + (size_t)t2 * DM + n0) = w;
    }
};

template <int MODE>
__device__ __forceinline__ void attn_naive_item(const Params& P, int tblk, int bh, int lane) {
    const half_t* Z = (const half_t*)(P.ws + WS_Z); half_t* O = (half_t*)(P.ws + WS_O); const float* CUM = (const float*)(P.ws + WS_CUM);
    const int t0 = tblk * 64, t = t0 + lane, b = bh >> 3, h = bh & 7;
    const int qcol = (MODE == 0) ? ZQF + h * 64 : ZQS + h * 64;
    const int kcol = (MODE == 0) ? ZKF + h * 64 : ZKS + (h >> 2) * 64;
    const int vcol = (MODE == 0) ? ZVF + h * 64 : ZVS + (h >> 2) * 64;
    float q[64], o[64];
    { const half_t* qp = Z + ((size_t)b * SEQ + t) * ZW + qcol;
#pragma unroll
      for (int d = 0; d < 64; ++d) { q[d] = (float)qp[d]; o[d] = 0.f; } }
    float m = -INFINITY, l = 0.f;
    const float ct = (MODE == 0) ? CUM[(size_t)bh * SEQ + t] * LOG2E : 0.f;
    const int s_lo = (MODE == 0) ? 0 : ((t0 - 127 > 0) ? t0 - 127 : 0), s_hi = t0 + 63;
    for (int s = s_lo; s <= s_hi; ++s) {
        const half_t* kp = Z + ((size_t)b * SEQ + s) * ZW + kcol; const half_t* vp = Z + ((size_t)b * SEQ + s) * ZW + vcol;
        float sc = 0.f;
#pragma unroll
        for (int d8 = 0; d8 < 8; ++d8) { const h8_t kv = *(const h8_t*)(kp + d8 * 8);
#pragma unroll
            for (int j = 0; j < 8; ++j) sc += q[d8 * 8 + j] * (float)kv[j]; }
        bool ok = (s <= t);
        if (MODE == 0) sc += ct - CUM[(size_t)bh * SEQ + s] * LOG2E; else ok = ok && (t - s < 128);
        if (ok) {
            const float mn = fmaxf(m, sc), f = exp2f(m - mn), p = exp2f(sc - mn);
            l = l * f + p; m = mn;
#pragma unroll
            for (int d8 = 0; d8 < 8; ++d8) { const h8_t vv = *(const h8_t*)(vp + d8 * 8);
#pragma unroll
                for (int j = 0; j < 8; ++j) o[d8 * 8 + j] = o[d8 * 8 + j] * f + p * (float)vv[j]; }
        }
    }
    if (MODE == 1) l += exp2f(P.sinks[h] * LOG2E - m);
    const float rl = 1.f / l;
    half_t* op = O + ((size_t)b * SEQ + t) * DM + ((MODE == 0) ? 0 : 512) + h * 64;
#pragma unroll
    for (int d = 0; d < 64; d += 2) *(unsigned*)(op + d) = pkh(o[d] * rl, o[d + 1] * rl);
}

__device__ __forceinline__ void xs_naive_item(const Params& P, LAS unsigned char* lds, int item) {
    const half_t* QX = (const half_t*)(P.ws + WS_QX); const half_t* KX = (const half_t*)(P.ws + WS_KX); half_t* PX = (half_t*)(P.ws + WS_PX);
    LAS float (*S)[257] = (LAS float (*)[257])lds;
    const int tid = threadIdx.x, r = tid >> 4, c = tid & 15, t = (item >> 2) * 32 + r, h = item & 3, b = t / SEQ;
    const half_t* qp = QX + (size_t)t * DM + h * 256;
    float acc[16];
#pragma unroll
    for (int j = 0; j < 16; ++j) acc[j] = 0.f;
    for (int d0 = 0; d0 < 256; d0 += 8) { const h8_t qv = *(const h8_t*)(qp + d0);
#pragma unroll
        for (int j = 0; j < 16; ++j) { const h8_t kv = *(const h8_t*)(KX + ((size_t)b * 256 + c + 16 * j) * DM + h * 256 + d0);
#pragma unroll
            for (int i = 0; i < 8; ++i) acc[j] += (float)qv[i] * (float)kv[i]; } }
#pragma unroll
    for (int j = 0; j < 16; ++j) S[r][c + 16 * j] = acc[j];
    __syncthreads();
    float mx = -INFINITY;
    for (int j = 0; j < 16; ++j) mx = fmaxf(mx, S[r][c + 16 * j]);
#pragma unroll
    for (int o = 1; o < 16; o <<= 1) mx = fmaxf(mx, __shfl_xor(mx, o));
    float sum = 0.f;
    for (int j = 0; j < 16; ++j) { const float p = exp2f(S[r][c + 16 * j] - mx); S[r][c + 16 * j] = p; sum += p; }
#pragma unroll
    for (int o = 1; o < 16; o <<= 1) sum += __shfl_xor(sum, o);
    const float rs = 1.f / sum;
    for (int j = 0; j < 16; ++j) PX[(size_t)t * DM + h * 256 + c + 16 * j] = (half_t)(S[r][c + 16 * j] * rs);
    __syncthreads();
}

template <int MODE>
__device__ __forceinline__ void ln_naive_row(const Params& P, int row, int lane) {
    const float* TMP = (const float*)(P.ws + WS_TMP);
    const half_t* H1 = (const half_t*)(P.ws + WS_H1);
    f4_t v[4]; float s = 0.f;
#pragma unroll
    for (int j = 0; j < 4; ++j) { const int c = 256 * j + 4 * lane; f4_t r;
        if (MODE == 0) r = *(const f4_t*)(P.x + (size_t)row * DM + c); else { const h4_t hh = *(const h4_t*)(H1 + (size_t)row * DM + c); r = (f4_t){(float)hh[0], (float)hh[1], (float)hh[2], (float)hh[3]}; }
        v[j] = r * ALPHA + *(const f4_t*)(TMP + (size_t)row * DM + c); s += (v[j].x + v[j].y) + (v[j].z + v[j].w); }
    const float mean = wave_sum(s) * (1.f / DM); float s2 = 0.f;
#pragma unroll
    for (int j = 0; j < 4; ++j) { v[j] = v[j] - mean; s2 += (v[j].x * v[j].x + v[j].y * v[j].y) + (v[j].z * v[j].z + v[j].w * v[j].w); }
    const float rstd = 1.f / sqrtf(wave_sum(s2) * (1.f / DM) + LN_EPS);
    const float* G = (MODE == 0) ? P.ln_mix_g : P.ln_x_g; const float* B = (MODE == 0) ? P.ln_mix_b : P.ln_x_b;
    half_t* OUT = (half_t*)(P.ws + ((MODE == 0) ? WS_H1 : WS_H2));
#pragma unroll
    for (int j = 0; j < 4; ++j) { const int c = 256 * j + 4 * lane; v[j] = v[j] * rstd * *(const f4_t*)(G + c) + *(const f4_t*)(B + c);
        unsigned long long w = (unsigned long long)pkh(v[j].x, v[j].y) | ((unsigned long long)pkh(v[j].z, v[j].w) << 32);
        *(unsigned long long*)(OUT + (size_t)row * DM + c) = w; }
    if (MODE == 1) {
        float* LG = (float*)(P.ws + WS_LG);
        for (int r = 0; r < 36; ++r) { float a = 0.f;
#pragma unroll
            for (int j = 0; j < 4; ++j) { const int c = 256 * j + 4 * lane;
#pragma unroll
                for (int i = 0; i < 4; ++i) { const int k = c + i; const float w = (r < 4) ? P.w_rg[k * 4 + r] : P.w_re[((size_t)((r - 4) >> 3) * 1024 + k) * 8 + ((r - 4) & 7)]; a += v[j][i] * w; } }
            a = wave_sum(a);
            if (lane == 0) { LG[(size_t)row * 48 + r] = a * 32.f; LG[((size_t)T + row) * 48 + r] = 0.f; LG[((size_t)2 * T + row) * 48 + r] = 0.f; LG[((size_t)3 * T + row) * 48 + r] = 0.f; } }
    }
}

__device__ __forceinline__ void route_tokens(const Params& P, LAS unsigned* sh  , int t0) {
    const int tid = threadIdx.x;
    const float* LG = (const float*)(P.ws + WS_LG); unsigned* CNT = (unsigned*)(P.ws + WS_CTL) + CW_CNT;
    int* LTOK = (int*)(P.ws + WS_LTOK); float* LW = (float*)(P.ws + WS_LW);
    if (tid < 64) sh[tid] = 0u;
    __syncthreads();
    int e0 = 0, e1 = 0; float g0 = 0.f, g1 = 0.f; unsigned s0 = 0, s1 = 0;
    if (tid < 128) {
        const int t = t0 + tid;
        float lg[36];
#pragma unroll
        for (int r = 0; r < 36; ++r) lg[r] = (LG[(size_t)t * 48 + r] + LG[((size_t)T + t) * 48 + r] + LG[((size_t)2 * T + t) * 48 + r] + LG[((size_t)3 * T + t) * 48 + r]) * (1.f / 32.f);
        float pg[4]; float mx = -INFINITY;
#pragma unroll
        for (int g = 0; g < 4; ++g) { pg[g] = lg[g] + P.b_rg[g]; mx = fmaxf(mx, pg[g]); }
        float sum = 0.f;
#pragma unroll
        for (int g = 0; g < 4; ++g) { pg[g] = expf(pg[g] - mx); sum += pg[g]; }
        int gi = 0; float gv = pg[0];
#pragma unroll
        for (int g = 1; g < 4; ++g) if (pg[g] > gv) { gv = pg[g]; gi = g; }
        gv /= sum;
        float sel[8];
#pragma unroll
        for (int e = 0; e < 8; ++e) { float a = lg[4 + e];
#pragma unroll
            for (int g = 1; g < 4; ++g) a = (gi == g) ? lg[4 + 8 * g + e] : a;
            sel[e] = a + P.b_re[gi * 8 + e]; }
        int i0 = 0; float v0 = sel[0];
#pragma unroll
        for (int e = 1; e < 8; ++e) if (sel[e] > v0) { v0 = sel[e]; i0 = e; }
        int i1 = -1; float v1 = -INFINITY;
#pragma unroll
        for (int e = 0; e < 8; ++e) if (e != i0 && sel[e] > v1) { v1 = sel[e]; i1 = e; }
        const float p1 = expf(v1 - v0), den = 1.f + p1;
        g0 = gv / den; g1 = gv * p1 / den; e0 = gi * 8 + i0; e1 = gi * 8 + i1;
        s0 = atomicAdd((unsigned*)&sh[e0], 1u); s1 = atomicAdd((unsigned*)&sh[e1], 1u);
    }
    __syncthreads();
    if (tid < 32) { const unsigned c = sh[tid]; sh[32 + tid] = c ? atomicAdd(&CNT[tid], c) : 0u; }
    __syncthreads();
    if (tid < 128) {
        const int t = t0 + tid; const unsigned d0 = sh[32 + e0] + s0, d1 = sh[32 + e1] + s1;
        LTOK[(size_t)e0 * LCAP + d0] = 2 * t; LW[(size_t)e0 * LCAP + d0] = g0;
        LTOK[(size_t)e1 * LCAP + d1] = 2 * t + 1; LW[(size_t)e1 * LCAP + d1] = g1;
    }
    __syncthreads();
}

__device__ __forceinline__ void route_tokens_fast(const Params& P, LAS unsigned char* lds, int t0) {
    typedef float f32x4 __attribute__((ext_vector_type(4)));
    const int tid = threadIdx.x, lane = tid & 63, wave = tid >> 6, fr = lane & 15, fq = lane >> 4;
    const half_t* H2 = (const half_t*)(P.ws + WS_V2); const half_t* WR = (const half_t*)(P.ws + WS_WR);
    LAS float* LGT = (LAS float*)(lds + 102400); LAS unsigned* sh = (LAS unsigned*)(lds + 126976);
    f32x4 acc[3];
#pragma unroll
    for (int et = 0; et < 3; ++et) acc[et] = (f32x4){0.f, 0.f, 0.f, 0.f};
    const half_t* hrow = H2 + (size_t)(t0 + wave * 16 + fr) * DM + 8 * fq;
    h8_t bfr[32];
#pragma unroll
    for (int ks = 0; ks < 32; ++ks) bfr[ks] = *(const h8_t*)(hrow + ks * 32);
#pragma unroll
    for (int kh = 0; kh < 2; ++kh) {
        __syncthreads();
#pragma unroll
        for (int it = 0; it < 12; ++it) { const int i = tid + it * 512; const int p = i / (48 * 64), r = (i / 64) % 48, c = i % 64;
            *(LAS u4_t*)(lds + (p * 48 + r) * 1040 + c * 16) = *(const u4_t*)(WR + (size_t)p * 48 * 1024 + (size_t)r * 1024 + kh * 512 + c * 8); }
        __syncthreads();
#pragma unroll
        for (int ks = 0; ks < 16; ++ks) {
            const h8_t b = bfr[kh * 16 + ks];
#pragma unroll
            for (int et = 0; et < 3; ++et) {
                const h8_t whi = *(const LAS h8_t*)(lds + (et * 16 + fr) * 1040 + ks * 64 + fq * 16);
                const h8_t wlo = *(const LAS h8_t*)(lds + (48 + et * 16 + fr) * 1040 + ks * 64 + fq * 16);
                acc[et] = __builtin_amdgcn_mfma_f32_16x16x32_f16(whi, b, acc[et], 0, 0, 0);
                acc[et] = __builtin_amdgcn_mfma_f32_16x16x32_f16(wlo, b, acc[et], 0, 0, 0);
            }
        }
    }
#pragma unroll
    for (int et = 0; et < 3; ++et)
#pragma unroll
        for (int r = 0; r < 4; ++r) LGT[(wave * 16 + fr) * 48 + et * 16 + 4 * fq + r] = acc[et][r];
    if (tid < 64) sh[tid] = 0u;
    __syncthreads();
    unsigned* CNT = (unsigned*)(P.ws + WS_CTL) + CW_CNT; int* LTOK = (int*)(P.ws + WS_LTOK); float* LW = (float*)(P.ws + WS_LW);
    int e0 = 0, e1 = 0; float g0 = 0.f, g1 = 0.f; unsigned s0 = 0, s1 = 0;
    float rmean = 0.f, rrstd = 0.f;
    if (tid < 128) {
        { const f4_t* p = (const f4_t*)((const float*)(P.ws + WS_ST2) + ((size_t)(t0 + tid) * 16) * 2); float sm = 0.f, sq = 0.f;
#pragma unroll
          for (int k = 0; k < 8; ++k) { const f4_t t = p[k]; sm += t[0] + t[2]; sq += t[1] + t[3]; }
          rmean = sm * (1.f / DM); rrstd = 1.0f / sqrtf(sq * (1.f / DM) - rmean * rmean + LN_EPS);
          *(f2_t*)((float*)(P.ws + WS_MR2) + (size_t)(t0 + tid) * 2) = (f2_t){rmean, rrstd}; }
        const float* UR = (const float*)(P.ws + WS_CTL) + CW_UR; const float* CR = (const float*)(P.ws + WS_CTL) + CW_CR;
        float lg[36];
#pragma unroll
        for (int r = 0; r < 36; ++r) lg[r] = (rrstd * LGT[tid * 48 + r] - rrstd * rmean * UR[r] + CR[r]) * (1.f / 32.f);
        float pg[4]; float mx = -INFINITY;
#pragma unroll
        for (int g = 0; g < 4; ++g) { pg[g] = lg[g] + P.b_rg[g]; mx = fmaxf(mx, pg[g]); }
        float sum = 0.f;
#pragma unroll
        for (int g = 0; g < 4; ++g) { pg[g] = expf(pg[g] - mx); sum += pg[g]; }
        int gi = 0; float gv = pg[0];
#pragma unroll
        for (int g = 1; g < 4; ++g) if (pg[g] > gv) { gv = pg[g]; gi = g; }
        gv /= sum;
        float sel[8];
#pragma unroll
        for (int e = 0; e < 8; ++e) { float a = lg[4 + e];
#pragma unroll
            for (int g = 1; g < 4; ++g) a = (gi == g) ? lg[4 + 8 * g + e] : a;
            sel[e] = a + P.b_re[gi * 8 + e]; }
        int i0 = 0; float v0 = sel[0];
#pragma unroll
        for (int e = 1; e < 8; ++e) if (sel[e] > v0) { v0 = sel[e]; i0 = e; }
        int i1 = -1; float v1 = -INFINITY;
#pragma unroll
        for (int e = 0; e < 8; ++e) if (e != i0 && sel[e] > v1) { v1 = sel[e]; i1 = e; }
        const float p1 = expf(v1 - v0), den = 1.f + p1;
        g0 = gv / den; g1 = gv * p1 / den; e0 = gi * 8 + i0; e1 = gi * 8 + i1;
        s0 = atomicAdd((unsigned*)&sh[e0], 1u); s1 = atomicAdd((unsigned*)&sh[e1], 1u);
    }
    __syncthreads();
    if (tid < 32) { const unsigned c = sh[tid]; sh[32 + tid] = c ? atomicAdd(&CNT[tid], c) : 0u; }
    __syncthreads();
    if (tid < 128) {
        const int t = t0 + tid; const unsigned d0 = sh[32 + e0] + s0, d1 = sh[32 + e1] + s1;
        LTOK[(size_t)e0 * LCAP + d0] = 2 * t; LW[(size_t)e0 * LCAP + d0] = g0;
        LTOK[(size_t)e1 * LCAP + d1] = 2 * t + 1; LW[(size_t)e1 * LCAP + d1] = g1;
        float* LMR = (float*)(P.ws + WS_LMR);
        *(f2_t*)(LMR + ((size_t)e0 * LCAP + d0) * 2) = (f2_t){rmean, rrstd}; *(f2_t*)(LMR + ((size_t)e1 * LCAP + d1) * 2) = (f2_t){rmean, rrstd};
    }
    __syncthreads();
}

__device__ __forceinline__ void final_ln_row(const Params& P, int row, int lane) {
    const half_t* H2 = (const half_t*)(P.ws + WS_H2); const half_t* Y = (const half_t*)(P.ws + WS_Y);
    f4_t v[4]; float s = 0.f;
#pragma unroll
    for (int j = 0; j < 4; ++j) { const int c = 256 * j + 4 * lane;
        const h4_t hh = *(const h4_t*)(H2 + (size_t)row * DM + c), y0 = *(const h4_t*)(Y + (size_t)(2 * row) * DM + c), y1 = *(const h4_t*)(Y + (size_t)(2 * row + 1) * DM + c);
#pragma unroll
        for (int i = 0; i < 4; ++i) v[j][i] = ALPHA * (float)hh[i] + ((float)y0[i] + (float)y1[i]);
        s += (v[j].x + v[j].y) + (v[j].z + v[j].w); }
    const float mean = wave_sum(s) * (1.f / DM); float s2 = 0.f;
#pragma unroll
    for (int j = 0; j < 4; ++j) { v[j] = v[j] - mean; s2 += (v[j].x * v[j].x + v[j].y * v[j].y) + (v[j].z * v[j].z + v[j].w * v[j].w); }
    const float rstd = 1.f / sqrtf(wave_sum(s2) * (1.f / DM) + LN_EPS);
#pragma unroll
    for (int j = 0; j < 4; ++j) { const int c = 256 * j + 4 * lane; *(f4_t*)(P.out + (size_t)row * DM + c) = v[j] * rstd * *(const f4_t*)(P.ln_f_g + c) + *(const f4_t*)(P.ln_f_b + c); }
}

__device__ __forceinline__ void final_ln_row2(const Params& P, int row, int lane) {
    const half_t* H2 = (const half_t*)(P.ws + WS_V2); const half_t* Y = (const half_t*)(P.ws + WS_Y);
    const f2_t mr0 = *(const f2_t*)((const float*)(P.ws + WS_MR2) + (size_t)row * 2), mr1 = *(const f2_t*)((const float*)(P.ws + WS_MR2) + (size_t)(row + 1) * 2);
    f4_t g2v[4], b2v[4];
#pragma unroll
    for (int j = 0; j < 4; ++j) { g2v[j] = *(const f4_t*)(P.ln_x_g + 256 * j + 4 * lane); b2v[j] = *(const f4_t*)(P.ln_x_b + 256 * j + 4 * lane); }
    h4_t hh[2][4], y0[2][4], y1[2][4];
#pragma unroll
    for (int q = 0; q < 2; ++q)
#pragma unroll
        for (int j = 0; j < 4; ++j) { const int c = 256 * j + 4 * lane; hh[q][j] = *(const h4_t*)(H2 + (size_t)(row + q) * DM + c); y0[q][j] = *(const h4_t*)(Y + (size_t)(2 * (row + q)) * DM + c); y1[q][j] = *(const h4_t*)(Y + (size_t)(2 * (row + q) + 1) * DM + c); }
    f4_t gv[4], bv[4];
#pragma unroll
    for (int j = 0; j < 4; ++j) { const int c = 256 * j + 4 * lane; gv[j] = *(const f4_t*)(P.ln_f_g + c); bv[j] = *(const f4_t*)(P.ln_f_b + c); }
#pragma unroll
    for (int q = 0; q < 2; ++q) {
        f4_t v[4]; float s = 0.f;
#pragma unroll
        for (int j = 0; j < 4; ++j) {
#pragma unroll
            for (int i = 0; i < 4; ++i) { const float mean2 = q ? mr1.x : mr0.x, rstd2 = q ? mr1.y : mr0.y; const float h2v = ((float)hh[q][j][i] - mean2) * rstd2 * g2v[j][i] + b2v[j][i];
                v[j][i] = ALPHA * h2v + ((float)y0[q][j][i] + (float)y1[q][j][i]); }
            s += (v[j].x + v[j].y) + (v[j].z + v[j].w); }
        const float mean = wave_sum(s) * (1.f / DM); float s2 = 0.f;
#pragma unroll
        for (int j = 0; j < 4; ++j) { v[j] = v[j] - mean; s2 += (v[j].x * v[j].x + v[j].y * v[j].y) + (v[j].z * v[j].z + v[j].w * v[j].w); }
        const float rstd = 1.f / sqrtf(wave_sum(s2) * (1.f / DM) + LN_EPS);
#pragma unroll
        for (int j = 0; j < 4; ++j) { const int c = 256 * j + 4 * lane; *(f4_t*)(P.out + (size_t)(row + q) * DM + c) = v[j] * rstd * gv[j] + bv[j]; }
    }
}

__device__ __forceinline__ void final_ln_rows(const Params& P, int gw, int ngw, int lane) {
    const half_t* H2 = (const half_t*)(P.ws + WS_V2); const half_t* Y = (const half_t*)(P.ws + WS_Y); const float* MR = (const float*)(P.ws + WS_MR2);
    f4_t g2v[4], b2v[4], gv[4], bv[4];
#pragma unroll
    for (int j = 0; j < 4; ++j) { const int c = 256 * j + 4 * lane; g2v[j] = *(const f4_t*)(P.ln_x_g + c) * ALPHA; b2v[j] = *(const f4_t*)(P.ln_x_b + c) * ALPHA; gv[j] = *(const f4_t*)(P.ln_f_g + c); bv[j] = *(const f4_t*)(P.ln_f_b + c); }
    h4_t hh[2][4], y0[2][4], y1[2][4], nh[2][4], n0[2][4], n1[2][4]; f2_t mr[2], nm[2];
#define FL_LOAD(HH, Y0, Y1, MRR, R) do { _Pragma("unroll") for (int q = 0; q < 2; ++q) { MRR[q] = *(const f2_t*)(MR + (size_t)((R) + q) * 2); \
        _Pragma("unroll") for (int j = 0; j < 4; ++j) { const int c = 256 * j + 4 * lane; HH[q][j] = *(const h4_t*)(H2 + (size_t)((R) + q) * DM + c); \
            Y0[q][j] = *(const h4_t*)(Y + (size_t)(2 * ((R) + q)) * DM + c); Y1[q][j] = *(const h4_t*)(Y + (size_t)(2 * ((R) + q) + 1) * DM + c); } } } while (0)
    int row = 2 * gw;
    if (row < T) FL_LOAD(hh, y0, y1, mr, row);
    for (; row < T; row += 2 * ngw) {
        const int nrow = row + 2 * ngw;
        if (nrow < T) FL_LOAD(nh, n0, n1, nm, nrow);
#pragma unroll
        for (int q = 0; q < 2; ++q) {
            f4_t v[4]; float s = 0.f; const float mean2 = mr[q].x, rstd2 = mr[q].y;
#pragma unroll
            for (int j = 0; j < 4; ++j) {
#pragma unroll
                for (int i = 0; i < 4; ++i) v[j][i] = (((float)hh[q][j][i] - mean2) * rstd2 * g2v[j][i] + b2v[j][i]) + ((float)y0[q][j][i] + (float)y1[q][j][i]);
                s += (v[j].x + v[j].y) + (v[j].z + v[j].w); }
            const float mean = wave_sum(s) * (1.f / DM); float s2 = 0.f;
#pragma unroll
            for (int j = 0; j < 4; ++j) { v[j] = v[j] - mean; s2 += (v[j].x * v[j].x + v[j].y * v[j].y) + (v[j].z * v[j].z + v[j].w * v[j].w); }
            const float rstd = 1.f / sqrtf(wave_sum(s2) * (1.f / DM) + LN_EPS);
#pragma unroll
            for (int j = 0; j < 4; ++j) { const int c = 256 * j + 4 * lane; *(f4_t*)(P.out + (size_t)(row + q) * DM + c) = v[j] * rstd * gv[j] + bv[j]; }
        }
#pragma unroll
        for (int q = 0; q < 2; ++q) { mr[q] = nm[q];
#pragma unroll
            for (int j = 0; j < 4; ++j) { hh[q][j] = nh[q][j]; y0[q][j] = n0[q][j]; y1[q][j] = n1[q][j]; } }
    }
#undef FL_LOAD
}

namespace pg {
typedef float f32x4 __attribute__((ext_vector_type(4)));
constexpr int BM = 256, BK = 64, HALF = 128, HTB = HALF * BK * 2, STAGE_BYTES = 8 * HTB, NXCD = 8, WGM = 8;
__host__ __device__ __forceinline__ int lds_byte(int r, int c) { const int st = (r >> 4) * 2 + (c >> 5), rr = r & 15, cc = c & 31, ob = rr * 64 + cc * 2; return st * 1024 + (ob ^ (((ob >> 9) & 1) << 5)); }
__host__ __device__ __forceinline__ void stage_rc(int b, int& R, int& C) { const int st = b / 1024, sb = b % 1024, swz = sb ^ (((sb >> 9) & 1) << 5); R = (st >> 1) * 16 + swz / 64; C = (st & 1) * 32 + (swz % 64) / 2; }
__host__ __device__ __forceinline__ int perm32(int rho) { const int n = rho >> 4, i = rho & 15; return 8 * (i >> 2) + 4 * n + (i & 3); }
struct Unit { int pm, pn, z, rb, aux; };

struct StaticOrder {
    int nM, nN, nwg, G, c, pm0;
    __device__ void init(int nM_, int nN_, int G_, int c_, int pm0_) { nM = nM_; nN = nN_; nwg = nM * nN; G = G_; c = c_; pm0 = pm0_; }
    __device__ bool next(int i, Unit& u) const {
        const long L = (long)i * G + c; if (L >= nwg) return false;
        int wgid = (int)L; { const int q = nwg / NXCD, r = nwg % NXCD, xcd = wgid % NXCD, off = wgid / NXCD; wgid = (xcd < r ? xcd * (q + 1) : r * (q + 1) + (xcd - r) * q) + off; }
        const int nig = WGM * nN, gid = wgid / nig, fm = gid * WGM, gsz = (nM - fm) < WGM ? (nM - fm) : WGM;
        u.pm = pm0 + fm + ((wgid % nig) % gsz); u.pn = (wgid % nig) / gsz; u.z = 0; u.rb = i; u.aux = 0; return true;
    }
};
struct OneUnit {
    int pm, pn;
    __device__ bool next(int i, Unit& u) const { if (i) return false; u.pm = pm; u.pn = pn; u.z = 0; u.rb = 0; u.aux = 0; return true; }
};
struct DenseProb {
    static constexpr bool GATHER = false;
    const half_t* A; const half_t* B; size_t a_sm, a_sn, b_sn, b_sb; int lda, ldb, K, pad;
    __device__ __forceinline__ const char* a_ptr(const Unit& u) const { return (const char*)(A + (size_t)u.pm * a_sm + (size_t)u.pn * a_sn); }
    __device__ __forceinline__ const char* b_ptr(const Unit& u) const { return (const char*)(B + (size_t)u.pn * b_sn + (size_t)(u.pm >> 4) * b_sb); }
    __device__ __forceinline__ unsigned a_row_off(const Unit&, int r) const { return (unsigned)(r * lda) * 2u; }
    __device__ __forceinline__ int ldb_of() const { return ldb; }
};
__device__ __forceinline__ DenseProb dense(const half_t* A, int lda, const half_t* B, int ldb, int K) { return DenseProb{A, B, (size_t)BM * lda, 0, (size_t)BM * ldb, 0, lda, ldb, K, 0}; }

struct EpiF16 {
    static constexpr bool PERM = true, AFTER_DRAIN = false;
    half_t* C; int ldc; float scale; int rmode, bskip;
    static constexpr int NVM = 16; __device__ __forceinline__ bool nvm_ok(const Unit&) const { return true; }
    __device__ __forceinline__ void operator()(f32x4 (&acc)[2][2][4][2], const Unit& u, int wr, int wc, int fr, int fq) const {
        const int rt = rmode ? (u.pn >> 2) * 4 + u.pm : u.pm, ct = rmode ? (u.pn & 3) : u.pn;
        const int row0 = rt * BM + wr * 64 + fr, col0 = ct * BM + wc * 32 + 8 * fq;
#pragma unroll
        for (int ai = 0; ai < 2; ++ai)
#pragma unroll
            for (int m = 0; m < 4; ++m) { half_t* rowp = C + (size_t)(rt >> 2) * bskip + (size_t)(row0 + ai * HALF + m * 16) * ldc + col0;
#pragma unroll
                for (int bj = 0; bj < 2; ++bj) { const f32x4 v0 = acc[ai][bj][m][0] * scale, v1 = acc[ai][bj][m][1] * scale;
                    u4_t w; w.x = pkh(v0[0], v0[1]); w.y = pkh(v0[2], v0[3]); w.z = pkh(v1[0], v1[1]); w.w = pkh(v1[2], v1[3]);
                    *(u4_t*)(rowp + bj * HALF) = w; } }
    }
};

struct EpiZ {
    static constexpr bool PERM = true, AFTER_DRAIN = false;
    static constexpr bool PREFETCH = true;
    half_t* Z; const int* pos; LAS unsigned char* side; int mode, pad;
    static constexpr int NVM = 16; __device__ __forceinline__ bool nvm_ok(const Unit&) const { return mode == 0; }
    __device__ __forceinline__ void prefetch(const Unit& u, int tid, int wid) const {
        if (u.pn >= 6 && wid < 4) __builtin_amdgcn_global_load_lds((const unsigned*)(pos + u.pm * BM) + tid, (LAS unsigned*)(side + wid * 256), 4, 0, 0); }
    __device__ __forceinline__ void operator()(f32x4 (&acc)[2][2][4][2], const Unit& u, int wr, int wc, int fr, int fq) const {
        if (mode & 2) return;
        const int pn = u.pn, row0 = u.pm * BM + wr * 64 + fr, col0 = pn * BM + wc * 32 + 8 * fq;
        const bool rope0 = (pn >= 6), rope1 = (pn == 6 || pn == 7);
        const float sc = (pn <= 1 || pn == 6 || pn == 7) ? C2_64 : 1.f;
        const int i0 = 16 * (wc & 1) + 4 * fq;
        float invf[4];
#pragma unroll
        for (int j = 0; j < 4; ++j) invf[j] = inv_freq(i0 + j);
#pragma unroll
        for (int ai = 0; ai < 2; ++ai)
#pragma unroll
            for (int m = 0; m < 4; ++m) { const int row = row0 + ai * HALF + m * 16; half_t* rowp = Z + (size_t)row * ZW + col0;
                float cs[4], sn[4];
                if (rope0) { const float p = (float)((const LAS int*)side)[wr * 64 + fr + ai * HALF + m * 16];
#pragma unroll
                    for (int j = 0; j < 4; ++j) { const float rev = p * invf[j] * 0.15915494309189535f; const float fr_ = rev - floorf(rev); sn[j] = __builtin_amdgcn_sinf(fr_); cs[j] = __builtin_amdgcn_cosf(fr_); } }
#pragma unroll
                for (int bj = 0; bj < 2; ++bj) { f32x4 v0 = acc[ai][bj][m][0], v1 = acc[ai][bj][m][1];
                    if (bj == 0 ? rope0 : rope1) {
                        const f32x4 a = v0, b = v1;
                        v0[0] = a[0] * cs[0] - a[1] * sn[0]; v0[1] = a[1] * cs[0] + a[0] * sn[0]; v0[2] = a[2] * cs[1] - a[3] * sn[1]; v0[3] = a[3] * cs[1] + a[2] * sn[1];
                        v1[0] = b[0] * cs[2] - b[1] * sn[2]; v1[1] = b[1] * cs[2] + b[0] * sn[2]; v1[2] = b[2] * cs[3] - b[3] * sn[3]; v1[3] = b[3] * cs[3] + b[2] * sn[3]; }
                    v0 = v0 * sc; v1 = v1 * sc;
                    u4_t w; w.x = pkh(v0[0], v0[1]); w.y = pkh(v0[2], v0[3]); w.z = pkh(v1[0], v1[1]); w.w = pkh(v1[2], v1[3]);
                    if (mode & 1) { asm volatile("" :: "v"(w)); } else *(u4_t*)(rowp + bj * HALF) = w; } }
    }
};

struct PanelStats {
    unsigned* xbuf;
    unsigned* cnt;
    unsigned* tmo;
    int ntn; float eps; unsigned code; int pad;
    __device__ __forceinline__ bool run(const f32x4 (&v)[2][2][4][2], const Unit& u, int wr, int wc, int fr, int fq, LAS unsigned char* lds, int wid, int lane) const {
        typedef float f32x2v __attribute__((ext_vector_type(2)));
        LAS f32x2v* P = (LAS f32x2v*)lds;
        LAS f32x2v* S = (LAS f32x2v*)(lds + 8192);
        LAS unsigned* flag = (LAS unsigned*)(lds + 8192 + 2048);
#pragma unroll
        for (int ai = 0; ai < 2; ++ai)
#pragma unroll
            for (int m = 0; m < 4; ++m) {
                float s = 0.f;
#pragma unroll
                for (int bj = 0; bj < 2; ++bj)
#pragma unroll
                    for (int n = 0; n < 2; ++n) { const f32x4 x = v[ai][bj][m][n]; s += (x[0] + x[1]) + (x[2] + x[3]); }
                s += __shfl_xor(s, 16); s += __shfl_xor(s, 32);
                const float mw = s * (1.0f / 64.0f); float q = 0.f;
#pragma unroll
                for (int bj = 0; bj < 2; ++bj)
#pragma unroll
                    for (int n = 0; n < 2; ++n) { const f32x4 d = v[ai][bj][m][n] - mw; q += (d[0] * d[0] + d[1] * d[1]) + (d[2] * d[2] + d[3] * d[3]); }
                q += __shfl_xor(q, 16); q += __shfl_xor(q, 32);
                if (fq == 0) P[(ai * HALF + wr * 64 + m * 16 + fr) * 4 + wc] = (f32x2v){mw, q};
            }
        asm volatile("s_waitcnt lgkmcnt(0)" ::: "memory"); __builtin_amdgcn_s_barrier(); asm volatile("" ::: "memory");
        const int row = wid * 32 + (lane & 31);
        if (lane < 32) {
            const f32x2v a = P[row * 4 + 0], b = P[row * 4 + 1], c = P[row * 4 + 2], d = P[row * 4 + 3];
            const float mt = (a.x + b.x + c.x + d.x) * 0.25f;
            const float da = a.x - mt, db = b.x - mt, dc = c.x - mt, dd = d.x - mt;
            const float m2 = (a.y + b.y) + (c.y + d.y) + 64.0f * ((da * da + db * db) + (dc * dc + dd * dd));
            unsigned long long* slot = (unsigned long long*)xbuf + ((size_t)(u.pm * BM + row) * 4 + u.pn);
            __hip_atomic_store(slot, ((unsigned long long)__float_as_uint(m2) << 32) | __float_as_uint(mt), __ATOMIC_RELAXED, __HIP_MEMORY_SCOPE_AGENT);
        }
        asm volatile("s_waitcnt vmcnt(0)" ::: "memory");
        if (lane == 0) __hip_atomic_fetch_add(cnt + 64 * u.pm, 1u, __ATOMIC_RELAXED, __HIP_MEMORY_SCOPE_AGENT);
        if (wid == 0) {
            bool dead = false; const unsigned long long t0 = __builtin_amdgcn_s_memrealtime(); const unsigned want = 8u * (unsigned)ntn;
            for (;;) {
                if ((unsigned)__builtin_amdgcn_readfirstlane(__hip_atomic_load(cnt + 64 * u.pm, __ATOMIC_RELAXED, __HIP_MEMORY_SCOPE_AGENT)) >= want) break;
                if (__builtin_amdgcn_s_memrealtime() - t0 > 2000000ull) {
                    if (lane == 0) { unsigned expect = 0u; __hip_atomic_compare_exchange_strong(tmo + 1, &expect, code | (unsigned)(u.pm & 0xff), __ATOMIC_RELAXED, __ATOMIC_RELAXED, __HIP_MEMORY_SCOPE_AGENT);
                                     __hip_atomic_store(tmo, 1u, __ATOMIC_RELAXED, __HIP_MEMORY_SCOPE_AGENT); }
                    dead = true; break; }
                __builtin_amdgcn_s_sleep(2);
            }
            __builtin_amdgcn_fence(__ATOMIC_ACQUIRE, "agent");
            if (lane == 0) flag[0] = dead ? 1u : 0u;
        }
        asm volatile("s_waitcnt vmcnt(0) lgkmcnt(0)" ::: "memory"); __builtin_amdgcn_s_barrier(); asm volatile("" ::: "memory");
        const bool bad = flag[0] != 0u;
        if (lane < 32) {
            const unsigned long long* slot = (const unsigned long long*)xbuf + (size_t)(u.pm * BM + row) * 4; float mt[4], m2[4]; float ms = 0.f;
#pragma unroll
            for (int t = 0; t < 4; ++t) { if (t < ntn) { const unsigned long long w = __hip_atomic_load(slot + t, __ATOMIC_RELAXED, __HIP_MEMORY_SCOPE_AGENT); mt[t] = __uint_as_float((unsigned)w); m2[t] = __uint_as_float((unsigned)(w >> 32)); } else { mt[t] = 0.f; m2[t] = 0.f; } ms += mt[t]; }
            const float mean = ms / (float)ntn; float q = 0.f;
#pragma unroll
            for (int t = 0; t < 4; ++t) if (t < ntn) { const float dm = mt[t] - mean; q += m2[t] + 256.0f * dm * dm; }
            S[row] = (f32x2v){mean, 1.0f / sqrtf(q / (256.0f * (float)ntn) + eps)};
        }
        asm volatile("s_waitcnt lgkmcnt(0)" ::: "memory"); __builtin_amdgcn_s_barrier(); asm volatile("" ::: "memory");
        return bad;
    }
};
template <bool RES_F32>
struct EpiLN {
    static constexpr bool PERM = true, AFTER_DRAIN = true;
    const float* resf; const half_t* resh; half_t* out; const float* gam; const float* bet; PanelStats st;
    __device__ __forceinline__ void fused(f32x4 (&acc)[2][2][4][2], const Unit& u, int wr, int wc, int fr, int fq, LAS unsigned char* lds, int wid, int lane) const {
        typedef float f32x2v __attribute__((ext_vector_type(2)));
        const LAS f32x2v* S = (const LAS f32x2v*)(lds + 8192);
        const int col0 = u.pn * BM + wc * 32 + 8 * fq;
#pragma unroll
        for (int ai = 0; ai < 2; ++ai)
#pragma unroll
            for (int m = 0; m < 4; ++m) { const size_t off = (size_t)(u.pm * BM + ai * HALF + wr * 64 + m * 16 + fr) * DM + col0;
#pragma unroll
                for (int bj = 0; bj < 2; ++bj) { f32x4 r0, r1;
                    if (RES_F32) { r0 = *(const f32x4*)(resf + off + bj * HALF); r1 = *(const f32x4*)(resf + off + bj * HALF + 4); }
                    else { const h8_t hh = *(const h8_t*)(resh + off + bj * HALF); r0 = (f32x4){(float)hh[0], (float)hh[1], (float)hh[2], (float)hh[3]}; r1 = (f32x4){(float)hh[4], (float)hh[5], (float)hh[6], (float)hh[7]}; }
                    acc[ai][bj][m][0] += r0 * ALPHA; acc[ai][bj][m][1] += r1 * ALPHA; }
                asm volatile("" : "+v"(acc[ai][0][m][0]), "+v"(acc[ai][0][m][1]), "+v"(acc[ai][1][m][0]), "+v"(acc[ai][1][m][1]));
                if (m & 1) asm volatile("" ::: "memory"); }
        const bool bad = st.run(acc, u, wr, wc, fr, fq, lds, wid, lane);
        f32x4 gv[2][2], bv[2][2];
#pragma unroll
        for (int bj = 0; bj < 2; ++bj)
#pragma unroll
            for (int n = 0; n < 2; ++n) { gv[bj][n] = *(const f32x4*)(gam + col0 + bj * HALF + 4 * n); bv[bj][n] = *(const f32x4*)(bet + col0 + bj * HALF + 4 * n); }
#pragma unroll
        for (int ai = 0; ai < 2; ++ai)
#pragma unroll
            for (int m = 0; m < 4; ++m) { const int r = ai * HALF + wr * 64 + m * 16 + fr; const f32x2v sr = S[r]; const size_t off = (size_t)(u.pm * BM + r) * DM + col0;
#pragma unroll
                for (int bj = 0; bj < 2; ++bj) { const f32x4 o0 = (acc[ai][bj][m][0] - sr.x) * sr.y * gv[bj][0] + bv[bj][0], o1 = (acc[ai][bj][m][1] - sr.x) * sr.y * gv[bj][1] + bv[bj][1];
                    u4_t w; w.x = pkh(o0[0], o0[1]); w.y = pkh(o0[2], o0[3]); w.z = pkh(o1[0], o1[1]); w.w = pkh(o1[2], o1[3]);
                    if (bad) { w.x = 0x7e007e00u; w.y = 0x7e007e00u; w.z = 0x7e007e00u; w.w = 0x7e007e00u; }
                    *(u4_t*)(out + off + bj * HALF) = w; } }
    }
};

struct EpiSoftmax {
    static constexpr bool PERM = true, AFTER_DRAIN = false;
    half_t* PXo; LAS unsigned char* xl;
    static constexpr int NVM = 16; __device__ __forceinline__ bool nvm_ok(const Unit&) const { return true; }
    __device__ __forceinline__ void operator()(f32x4 (&acc)[2][2][4][2], const Unit& u, int wr, int wc, int fr, int fq) const {
        typedef float f32x2v __attribute__((ext_vector_type(2)));
        LAS f32x2v* X = (LAS f32x2v*)xl;
        float mxs[2][4];
#pragma unroll
        for (int ai = 0; ai < 2; ++ai)
#pragma unroll
            for (int m = 0; m < 4; ++m) {
                float mx = -INFINITY;
#pragma unroll
                for (int bj = 0; bj < 2; ++bj)
#pragma unroll
                    for (int n = 0; n < 2; ++n) { const f32x4 x = acc[ai][bj][m][n]; mx = fmaxf(mx, fmaxf(fmaxf(x[0], x[1]), fmaxf(x[2], x[3]))); }
                mx = fmaxf(mx, __shfl_xor(mx, 16)); mx = fmaxf(mx, __shfl_xor(mx, 32));
                float sm = 0.f;
#pragma unroll
                for (int bj = 0; bj < 2; ++bj)
#pragma unroll
                    for (int n = 0; n < 2; ++n) { f32x4 x = acc[ai][bj][m][n];
#pragma unroll
                        for (int i = 0; i < 4; ++i) { x[i] = __builtin_amdgcn_exp2f(x[i] - mx); sm += x[i]; }
                        acc[ai][bj][m][n] = x; }
                sm += __shfl_xor(sm, 16); sm += __shfl_xor(sm, 32);
                mxs[ai][m] = mx;
                if (fq == 0) X[(ai * HALF + wr * 64 + m * 16 + fr) * 4 + wc] = (f32x2v){mx, sm};
            }
        asm volatile("s_waitcnt lgkmcnt(0)" ::: "memory"); __builtin_amdgcn_s_barrier(); asm volatile("" ::: "memory");
        const int row0 = u.pm * BM + wr * 64 + fr, col0 = u.pn * BM + wc * 32 + 8 * fq;
#pragma unroll
        for (int ai = 0; ai < 2; ++ai)
#pragma unroll
            for (int m = 0; m < 4; ++m) { const int r = ai * HALF + wr * 64 + m * 16 + fr;
                const f32x2v a = X[r * 4 + 0], b = X[r * 4 + 1], c = X[r * 4 + 2], d = X[r * 4 + 3];
                const float M = fmaxf(fmaxf(a.x, b.x), fmaxf(c.x, d.x));
                const float tot = a.y * __builtin_amdgcn_exp2f(a.x - M) + b.y * __builtin_amdgcn_exp2f(b.x - M) + c.y * __builtin_amdgcn_exp2f(c.x - M) + d.y * __builtin_amdgcn_exp2f(d.x - M);
                const float f = __builtin_amdgcn_exp2f(mxs[ai][m] - M) / tot;
                half_t* rowp = PXo + (size_t)(row0 + ai * HALF + m * 16) * DM + col0;
#pragma unroll
                for (int bj = 0; bj < 2; ++bj) { const f32x4 v0 = acc[ai][bj][m][0] * f, v1 = acc[ai][bj][m][1] * f;
                    u4_t w; w.x = pkh(v0[0], v0[1]); w.y = pkh(v0[2], v0[3]); w.z = pkh(v1[0], v1[1]); w.w = pkh(v1[2], v1[3]);
                    *(u4_t*)(rowp + bj * HALF) = w; } }
        asm volatile("s_waitcnt lgkmcnt(0)" ::: "memory"); __builtin_amdgcn_s_barrier(); asm volatile("" ::: "memory");
    }
};

struct GTProb {
    static constexpr bool GATHER = false;
    const half_t* KXp; const half_t* WQSp; int K, pad;
    __device__ __forceinline__ const char* a_ptr(const Unit& u) const { return (const char*)(KXp + (size_t)(u.pm >> 2) * 256 * 1024 + (u.pm & 3) * 256); }
    __device__ __forceinline__ const char* b_ptr(const Unit& u) const { return (const char*)(WQSp + (size_t)u.pn * 256 * 1024 + (u.pm & 3) * 256); }
    __device__ __forceinline__ unsigned a_row_off(const Unit&, int r) const { return (unsigned)(r * 1024) * 2u; }
    __device__ __forceinline__ int ldb_of() const { return 1024; }
};
struct VWProb {
    static constexpr bool GATHER = false;
    const half_t* WXOp; const half_t* VXp; int K, pad;
    __device__ __forceinline__ const char* a_ptr(const Unit& u) const { return (const char*)(WXOp + (size_t)u.pm * 256 * 1024 + (u.pn & 3) * 256); }
    __device__ __forceinline__ const char* b_ptr(const Unit& u) const { return (const char*)(VXp + (size_t)(u.pn >> 2) * 256 * 1024 + (u.pn & 3) * 256); }
    __device__ __forceinline__ unsigned a_row_off(const Unit&, int r) const { return (unsigned)(r * 1024) * 2u; }
    __device__ __forceinline__ int ldb_of() const { return 1024; }
};
struct EpiSoftmaxFold {
    static constexpr bool PERM = true, AFTER_DRAIN = false, PREFETCH = true;
    half_t* PXo; LAS unsigned char* xl; const float* UB; LAS unsigned char* mr; LAS unsigned char* side; float scale; int pad;
    static constexpr int NVM = 16; __device__ __forceinline__ bool nvm_ok(const Unit&) const { return true; }
    __device__ __forceinline__ void prefetch(const Unit& u, int tid, int wid) const {
        const int bh = (u.pm >> 4) * 4 + u.pn; const float* uc = (tid < 256) ? UB + bh * 256 + tid : UB + 16384 + bh * 256 + (tid - 256);
        __builtin_amdgcn_global_load_lds((const unsigned*)uc, (LAS unsigned*)(side + wid * 256), 4, 0, 0); }
    __device__ __forceinline__ void operator()(f32x4 (&acc)[2][2][4][2], const Unit& u, int wr, int wc, int fr, int fq) const {
        typedef float f32x2v __attribute__((ext_vector_type(2)));
        LAS f32x2v* X = (LAS f32x2v*)xl;
        f32x4 uv[2][2], cv[2][2];
#pragma unroll
        for (int bj = 0; bj < 2; ++bj)
#pragma unroll
            for (int n = 0; n < 2; ++n) { const int cl = wc * 32 + 8 * fq + bj * HALF + 4 * n; uv[bj][n] = *(const LAS f32x4*)(side + cl * 4); cv[bj][n] = *(const LAS f32x4*)(side + 1024 + cl * 4); }
        float mxs[2][4];
#pragma unroll
        for (int ai = 0; ai < 2; ++ai)
#pragma unroll
            for (int m = 0; m < 4; ++m) { const int r = ai * HALF + wr * 64 + m * 16 + fr; const f32x2v t = ((const LAS f32x2v*)mr)[u.rb * 256 + r];
                const float a = t.y * scale, bc = -t.y * t.x * scale;
                float mx = -INFINITY;
#pragma unroll
                for (int bj = 0; bj < 2; ++bj)
#pragma unroll
                    for (int n = 0; n < 2; ++n) { const f32x4 x = acc[ai][bj][m][n] * a + uv[bj][n] * bc + cv[bj][n] * scale; acc[ai][bj][m][n] = x; mx = fmaxf(mx, fmaxf(fmaxf(x[0], x[1]), fmaxf(x[2], x[3]))); }
                mx = fmaxf(mx, __shfl_xor(mx, 16)); mx = fmaxf(mx, __shfl_xor(mx, 32));
                float sm = 0.f;
#pragma unroll
                for (int bj = 0; bj < 2; ++bj)
#pragma unroll
                    for (int n = 0; n < 2; ++n) { f32x4 x = acc[ai][bj][m][n];
#pragma unroll
                        for (int i = 0; i < 4; ++i) { x[i] = __builtin_amdgcn_exp2f(x[i] - mx); sm += x[i]; }
                        acc[ai][bj][m][n] = x; }
                sm += __shfl_xor(sm, 16); sm += __shfl_xor(sm, 32);
                mxs[ai][m] = mx;
                if (fq == 0) X[r * 4 + wc] = (f32x2v){mx, sm};
            }
        asm volatile("s_waitcnt lgkmcnt(0)" ::: "memory"); __builtin_amdgcn_s_barrier(); asm volatile("" ::: "memory");
        const int row0 = u.pm * BM + wr * 64 + fr, col0 = u.pn * BM + wc * 32 + 8 * fq;
#pragma unroll
        for (int ai = 0; ai < 2; ++ai)
#pragma unroll
            for (int m = 0; m < 4; ++m) { const int r = ai * HALF + wr * 64 + m * 16 + fr;
                const f32x2v a = X[r * 4 + 0], b = X[r * 4 + 1], c = X[r * 4 + 2], d = X[r * 4 + 3];
                const float M = fmaxf(fmaxf(a.x, b.x), fmaxf(c.x, d.x));
                const float tot = a.y * __builtin_amdgcn_exp2f(a.x - M) + b.y * __builtin_amdgcn_exp2f(b.x - M) + c.y * __builtin_amdgcn_exp2f(c.x - M) + d.y * __builtin_amdgcn_exp2f(d.x - M);
                const float f = __builtin_amdgcn_exp2f(mxs[ai][m] - M) / tot;
                half_t* rowp = PXo + (size_t)(row0 + ai * HALF + m * 16) * DM + col0;
#pragma unroll
                for (int bj = 0; bj < 2; ++bj) { const f32x4 v0 = acc[ai][bj][m][0] * f, v1 = acc[ai][bj][m][1] * f;
                    u4_t w; w.x = pkh(v0[0], v0[1]); w.y = pkh(v0[2], v0[3]); w.z = pkh(v1[0], v1[1]); w.w = pkh(v1[2], v1[3]);
                    *(u4_t*)(rowp + bj * HALF) = w; } }
        asm volatile("s_waitcnt lgkmcnt(0)" ::: "memory"); __builtin_amdgcn_s_barrier(); asm volatile("" ::: "memory");
    }
};

struct MoeOrder {
    LAS int* tab; int nun, total;
    __device__ __forceinline__ void init(const unsigned* cnt, int G, int c, LAS unsigned char* lds_tab) {
        tab = (LAS int*)lds_tab; const int tid = threadIdx.x;
        __syncthreads();
        if (tid < 64) { const int e = tid & 31; const int ce = (int)cnt[e]; const int nt = (ce + 255) >> 8; int inc = nt;
#pragma unroll
            for (int o = 1; o < 32; o <<= 1) { const int t = __shfl_up(inc, o, 32); if (e >= o) inc += t; }
            if (tid < 32) { tab[128 + e] = inc; tab[192 + e] = ce; } }
        __syncthreads();
        const int tot = tab[128 + 31] * 4;
        if (tid < 12) { const long L = (long)tid * G + c;
            if (L < tot) { int wgid = (int)L; { const int q = tot / NXCD, r = tot % NXCD, xcd = wgid % NXCD, off = wgid / NXCD; wgid = (xcd < r ? xcd * (q + 1) : r * (q + 1) + (xcd - r) * q) + off; }
                const int g = wgid >> 2; int e = 0; while (e < NEXP - 1 && g >= tab[128 + e]) ++e;
                const int start = (e > 0) ? tab[128 + e - 1] : 0;
                tab[tid * 8 + 0] = g - start; tab[tid * 8 + 1] = wgid & 3; tab[tid * 8 + 2] = e; tab[tid * 8 + 3] = g * 256; tab[tid * 8 + 4] = tab[192 + e]; } }
        __syncthreads();
        total = __builtin_amdgcn_readfirstlane(tot);
        nun = (total > c) ? (total - c + G - 1) / G : 0; if (nun > 12) nun = 12;
    }
    __device__ __forceinline__ bool next(int i, Unit& u) const {
        if (i >= nun) return false;
        u.pm = __builtin_amdgcn_readfirstlane(tab[i * 8 + 0]); u.pn = __builtin_amdgcn_readfirstlane(tab[i * 8 + 1]); u.z = __builtin_amdgcn_readfirstlane(tab[i * 8 + 2]);
        u.rb = __builtin_amdgcn_readfirstlane(tab[i * 8 + 3]); u.aux = __builtin_amdgcn_readfirstlane(tab[i * 8 + 4]); return true;
    }
};
struct GUProb {
    static constexpr bool GATHER = true;
    const half_t* H2p; const half_t* W; const unsigned* cnt; const int* ltok; LAS unsigned char* itab; int K, pad;
    __device__ __forceinline__ void prefetch_idx(const Unit& u, int tid, int wid) const { if (wid < 4) __builtin_amdgcn_global_load_lds((const unsigned*)(ltok + (size_t)u.z * LCAP + u.pm * BM) + tid, (LAS unsigned*)(itab + wid * 256), 4, 0, 0); }
    __device__ __forceinline__ unsigned a_row_off_lds(const Unit& u, int r) const { const int idx = u.pm * BM + r; const int tk = (idx < u.aux) ? (((const LAS int*)itab)[r] >> 1) : 0; return (unsigned)tk * 2048u; }
    __device__ __forceinline__ const char* a_ptr(const Unit&) const { return (const char*)H2p; }
    __device__ __forceinline__ const char* b_ptr(const Unit& u) const { return (const char*)(W + ((size_t)u.z * 1024 + (size_t)u.pn * BM) * 1024); }
    __device__ __forceinline__ unsigned a_row_off(const Unit& u, int r) const { const int idx = u.pm * BM + r; const int tk = (idx < u.aux) ? (ltok[(size_t)u.z * LCAP + idx] >> 1) : 0; return (unsigned)tk * 2048u; }
    __device__ __forceinline__ int ldb_of() const { return 1024; }
};
struct EpiGU {
    static constexpr bool PERM = true, AFTER_DRAIN = false;
    static constexpr bool PREFETCH = true;
    half_t* ACTo; const float* U; const float* Cc; const float* lmr; LAS unsigned char* side;
    static constexpr int NVM = 16; __device__ __forceinline__ bool nvm_ok(const Unit&) const { return true; }
    __device__ __forceinline__ void prefetch(const Unit& u, int tid, int wid) const {
        __builtin_amdgcn_global_load_lds((const unsigned*)(lmr + ((size_t)u.z * LCAP + u.pm * BM) * 2) + tid, (LAS unsigned*)(side + wid * 256), 4, 0, 0);
        const float* uc = (tid < 256) ? U + u.z * 1024 + u.pn * BM + tid : Cc + u.z * 1024 + u.pn * BM + (tid - 256);
        __builtin_amdgcn_global_load_lds((const unsigned*)uc, (LAS unsigned*)(side + 2048 + wid * 256), 4, 0, 0); }
    __device__ __forceinline__ void operator()(f32x4 (&acc)[2][2][4][2], const Unit& u, int wr, int wc, int fr, int fq) const {
        typedef float f32x2v __attribute__((ext_vector_type(2)));
        asm volatile("" : "+v"(fr), "+v"(fq));
        const int row0 = u.rb + wr * 64 + fr, colI = u.pn * BM + wc * 32 + 8 * fq, col0 = colI >> 1;
        f32x4 uv[2][2], cv[2][2];
#pragma unroll
        for (int bj = 0; bj < 2; ++bj)
#pragma unroll
            for (int n = 0; n < 2; ++n) { const int cl = wc * 32 + 8 * fq + bj * HALF + 4 * n; uv[bj][n] = *(const LAS f32x4*)(side + 2048 + cl * 4); cv[bj][n] = *(const LAS f32x4*)(side + 3072 + cl * 4); }
#pragma unroll
        for (int ai = 0; ai < 2; ++ai)
#pragma unroll
            for (int m = 0; m < 4; ++m) { const int rl = wr * 64 + fr + ai * HALF + m * 16; half_t* rowp = ACTo + (size_t)(u.rb + rl) * DEXP + col0;
                const f32x2v t = ((const LAS f32x2v*)side)[rl];
                const float a = t.y, bc = -t.y * t.x;
#pragma unroll
                for (int bj = 0; bj < 2; ++bj) { const f32x4 v0 = acc[ai][bj][m][0] * a + uv[bj][0] * bc + cv[bj][0], v1 = acc[ai][bj][m][1] * a + uv[bj][1] * bc + cv[bj][1];
                    const float a0 = v0[0] * __builtin_amdgcn_rcpf(1.f + __builtin_amdgcn_exp2f(-LOG2E * v0[0])) * v0[1], a1 = v0[2] * __builtin_amdgcn_rcpf(1.f + __builtin_amdgcn_exp2f(-LOG2E * v0[2])) * v0[3];
                    const float a2 = v1[0] * __builtin_amdgcn_rcpf(1.f + __builtin_amdgcn_exp2f(-LOG2E * v1[0])) * v1[1], a3 = v1[2] * __builtin_amdgcn_rcpf(1.f + __builtin_amdgcn_exp2f(-LOG2E * v1[2])) * v1[3];
                    *(unsigned long long*)(rowp + bj * (HALF / 2)) = (unsigned long long)pkh(a0, a1) | ((unsigned long long)pkh(a2, a3) << 32); } }
        (void)row0;
    }
};
struct DownProb {
    static constexpr bool GATHER = false;
    const half_t* ACTp; const half_t* W; int K, pad;
    __device__ __forceinline__ const char* a_ptr(const Unit& u) const { return (const char*)(ACTp + (size_t)u.rb * DEXP); }
    __device__ __forceinline__ const char* b_ptr(const Unit& u) const { return (const char*)(W + ((size_t)u.z * 1024 + (size_t)u.pn * BM) * DEXP); }
    __device__ __forceinline__ unsigned a_row_off(const Unit&, int r) const { return (unsigned)(r * DEXP) * 2u; }
    __device__ __forceinline__ int ldb_of() const { return DEXP; }
};
struct EpiDown {
    static constexpr bool PERM = true, AFTER_DRAIN = false;
    static constexpr bool PREFETCH = true;
    half_t* Yo; const unsigned* cnt; const int* ltok; const float* lw; LAS unsigned char* side;
    static constexpr int NVM = 16; __device__ __forceinline__ bool nvm_ok(const Unit& u) const { return (u.pm + 1) * BM <= u.aux; }
    __device__ __forceinline__ void prefetch(const Unit& u, int tid, int wid) const {
        const unsigned* src = (tid < 256) ? (const unsigned*)(ltok + (size_t)u.z * LCAP + u.pm * BM) + tid : (const unsigned*)(lw + (size_t)u.z * LCAP + u.pm * BM) + (tid - 256);
        __builtin_amdgcn_global_load_lds(src, (LAS unsigned*)(side + wid * 256), 4, 0, 0); }
    __device__ __forceinline__ void operator()(f32x4 (&acc)[2][2][4][2], const Unit& u, int wr, int wc, int fr, int fq) const {
        const int idx0 = u.pm * BM + wr * 64 + fr, col0 = u.pn * BM + wc * 32 + 8 * fq, ce = u.aux;
#pragma unroll
        for (int ai = 0; ai < 2; ++ai)
#pragma unroll
            for (int m = 0; m < 4; ++m) { const int idx = idx0 + ai * HALF + m * 16;
                if (idx < ce) { const int rl = idx - u.pm * BM; const int t2 = ((const LAS int*)side)[rl]; const float g = ((const LAS float*)(side + 1024))[rl]; half_t* rowp = Yo + (size_t)t2 * DM + col0;
#pragma unroll
                    for (int bj = 0; bj < 2; ++bj) { const f32x4 v0 = acc[ai][bj][m][0] * g, v1 = acc[ai][bj][m][1] * g;
                        u4_t w; w.x = pkh(v0[0], v0[1]); w.y = pkh(v0[2], v0[3]); w.z = pkh(v1[0], v1[1]); w.w = pkh(v1[2], v1[3]);
                        *(u4_t*)(rowp + bj * HALF) = w; } } }
    }
};

template <int RESM>
struct EpiV {
    static constexpr bool PERM = true, AFTER_DRAIN = false;
    const half_t* res; half_t* V; float* ST; const float* g; const float* b; LAS unsigned char* mr;
    static constexpr int NVM = 40; __device__ __forceinline__ bool nvm_ok(const Unit&) const { return true; }
    __device__ __forceinline__ void operator()(f32x4 (&acc)[2][2][4][2], const Unit& u, int wr, int wc, int fr, int fq) const {
        typedef float f32x2v __attribute__((ext_vector_type(2)));
        const int col0 = u.pn * BM + wc * 32 + 8 * fq;
        f32x4 gv[2][2], bv[2][2];
        if (RESM == 1) {
#pragma unroll
            for (int bj = 0; bj < 2; ++bj)
#pragma unroll
                for (int n = 0; n < 2; ++n) { gv[bj][n] = *(const f32x4*)(g + col0 + bj * HALF + 4 * n); bv[bj][n] = *(const f32x4*)(b + col0 + bj * HALF + 4 * n); } }
#pragma unroll
        for (int ai = 0; ai < 2; ++ai) {
            h8_t hh[4][2];
#pragma unroll
            for (int m = 0; m < 4; ++m)
#pragma unroll
                for (int bj = 0; bj < 2; ++bj) hh[m][bj] = *(const h8_t*)(res + (size_t)(u.pm * BM + ai * HALF + wr * 64 + m * 16 + fr) * DM + col0 + bj * HALF);
#pragma unroll
            for (int m = 0; m < 4; ++m) { const int r = ai * HALF + wr * 64 + m * 16 + fr; const int row = u.pm * BM + r; const size_t off = (size_t)row * DM + col0;
                float mean = 0.f, rstd = 1.f;
                if (RESM == 1) { const f32x2v t = ((const LAS f32x2v*)mr)[u.rb * 256 + r]; mean = t.x; rstd = t.y; }
                float sm = 0.f, sq = 0.f;
#pragma unroll
                for (int bj = 0; bj < 2; ++bj) { const h8_t h = hh[m][bj];
                    f32x4 r0 = (f32x4){(float)h[0], (float)h[1], (float)h[2], (float)h[3]}, r1 = (f32x4){(float)h[4], (float)h[5], (float)h[6], (float)h[7]};
                    if (RESM == 1) { r0 = (r0 - mean) * rstd * gv[bj][0] + bv[bj][0]; r1 = (r1 - mean) * rstd * gv[bj][1] + bv[bj][1]; }
                    const f32x4 v0 = acc[ai][bj][m][0] + r0 * ALPHA, v1 = acc[ai][bj][m][1] + r1 * ALPHA;
                    u4_t w; w.x = pkh(v0[0], v0[1]); w.y = pkh(v0[2], v0[3]); w.z = pkh(v1[0], v1[1]); w.w = pkh(v1[2], v1[3]);
                    *(u4_t*)(V + off + bj * HALF) = w;
                    sm += (v0[0] + v0[1]) + (v0[2] + v0[3]) + (v1[0] + v1[1]) + (v1[2] + v1[3]);
                    sq += (v0[0] * v0[0] + v0[1] * v0[1]) + (v0[2] * v0[2] + v0[3] * v0[3]) + (v1[0] * v1[0] + v1[1] * v1[1]) + (v1[2] * v1[2] + v1[3] * v1[3]); }
                sm += __shfl_xor(sm, 16); sm += __shfl_xor(sm, 32); sq += __shfl_xor(sq, 16); sq += __shfl_xor(sq, 32);
                if (fq == 0) *(f32x2v*)(ST + ((size_t)row * 16 + u.pn * 4 + wc) * 2) = (f32x2v){sm, sq}; }
            asm volatile("" ::: "memory"); }
    }
};
struct EpiFold {
    static constexpr bool PERM = true, AFTER_DRAIN = false;
    static constexpr bool PREFETCH = true;
    half_t* C; const float* U; const float* Cc; LAS unsigned char* mr; LAS unsigned char* side; float scale; int pad;
    static constexpr int NVM = 16; __device__ __forceinline__ bool nvm_ok(const Unit&) const { return true; }
    __device__ __forceinline__ void prefetch(const Unit& u, int tid, int wid) const {
        const float* uc = (tid < 256) ? U + u.pn * BM + tid : Cc + u.pn * BM + (tid - 256);
        __builtin_amdgcn_global_load_lds((const unsigned*)uc, (LAS unsigned*)(side + wid * 256), 4, 0, 0); }
    __device__ __forceinline__ void operator()(f32x4 (&acc)[2][2][4][2], const Unit& u, int wr, int wc, int fr, int fq) const {
        typedef float f32x2v __attribute__((ext_vector_type(2)));
        const int col0 = u.pn * BM + wc * 32 + 8 * fq;
        f32x4 uv[2][2], cv[2][2];
#pragma unroll
        for (int bj = 0; bj < 2; ++bj)
#pragma unroll
            for (int n = 0; n < 2; ++n) { const int cl = wc * 32 + 8 * fq + bj * HALF + 4 * n; uv[bj][n] = *(const LAS f32x4*)(side + cl * 4); cv[bj][n] = *(const LAS f32x4*)(side + 1024 + cl * 4); }
#pragma unroll
        for (int ai = 0; ai < 2; ++ai)
#pragma unroll
            for (int m = 0; m < 4; ++m) { const int r = ai * HALF + wr * 64 + m * 16 + fr; const f32x2v t = ((const LAS f32x2v*)mr)[u.rb * 256 + r];
                const float a = t.y, bc = -t.y * t.x; half_t* rowp = C + (size_t)(u.pm * BM + r) * DM + col0;
#pragma unroll
                for (int bj = 0; bj < 2; ++bj) { const f32x4 v0 = (acc[ai][bj][m][0] * a + uv[bj][0] * bc + cv[bj][0]) * scale, v1 = (acc[ai][bj][m][1] * a + uv[bj][1] * bc + cv[bj][1]) * scale;
                    u4_t w; w.x = pkh(v0[0], v0[1]); w.y = pkh(v0[2], v0[3]); w.z = pkh(v1[0], v1[1]); w.w = pkh(v1[2], v1[3]);
                    *(u4_t*)(rowp + bj * HALF) = w; } }
    }
};
template <class Sched>
__device__ __forceinline__ void row_tables(const Sched& S, const float* ST, LAS unsigned char* mr) {
    typedef float f32x2v __attribute__((ext_vector_type(2)));
    const int tid = threadIdx.x, i = tid >> 8, r = tid & 255; Unit u;
    if (S.next(i, u)) { const f32x4* p = (const f32x4*)(ST + ((size_t)(u.pm * BM + r) * 16) * 2); float sm = 0.f, sq = 0.f;
#pragma unroll
        for (int k = 0; k < 8; ++k) { const f32x4 t = p[k]; sm += t[0] + t[2]; sq += t[1] + t[3]; }
        const float mean = sm * (1.f / DM), var = sq * (1.f / DM) - mean * mean;
        ((LAS f32x2v*)mr)[i * 256 + r] = (f32x2v){mean, 1.0f / sqrtf(var + LN_EPS)}; }
    __syncthreads();
}

template <class E, class = void> struct has_prefetch { static constexpr bool value = false; };
template <class E> struct has_prefetch<E, decltype((void)E::PREFETCH)> { static constexpr bool value = E::PREFETCH; };
template <class Prob, class Epi, class Sched, bool ALIGN_EPI, bool RELAX = true>
__device__ __forceinline__ void gemm_phase(LAS unsigned char* lds, const Prob& g, const Sched& S, const Epi& E) {
    const int tid = threadIdx.x, wid = __builtin_amdgcn_readfirstlane(tid >> 6), lane = tid & 63, wr = wid >> 2, wc = wid & 3, fr = lane & 15, fq = lane >> 4;
    const int K = g.K, nt = K / BK;
    int sR[2], sC[2], sRb[2];
#pragma unroll
    for (int i = 0; i < 2; ++i) { stage_rc(tid * 16 + i * 8192, sR[i], sC[i]); sRb[i] = Epi::PERM ? ((sR[i] & ~31) + perm32(sR[i] & 31)) : sR[i]; }
    unsigned voffB[2];
#pragma unroll
    for (int i = 0; i < 2; ++i) voffB[i] = (unsigned)(sRb[i] * g.ldb_of() + sC[i]) * 2u;
    const size_t kstep = (size_t)(BK * 2);
    const size_t hstepB = (size_t)HALF * g.ldb_of() * 2;
    const unsigned ldsw = (unsigned)wid * 1024u;
    const int aoff = lds_byte(wr * 64 + fr, fq * 8), boff = lds_byte(wc * 32 + fr, fq * 8);
#define PG_SA(b, h) (((b) * 2 + (h)) * HTB)
#define PG_SB(b, h) ((4 + (b) * 2 + (h)) * HTB)
#define PG_STAGE(bufoff, gbase, voff) do { _Pragma("unroll") for (int _i = 0; _i < 2; ++_i) \
        __builtin_amdgcn_global_load_lds((const unsigned*)((const char*)(gbase) + (voff)[_i]), (LAS unsigned*)(lds + (bufoff) + ldsw + _i * 8192), 16, 0, 0); } while (0)
#define PG_LDA(dst, b, h) do { _Pragma("unroll") for (int m = 0; m < 4; ++m) _Pragma("unroll") for (int k = 0; k < 2; ++k) dst[m][k] = *(const LAS h8_t*)(lds + PG_SA(b, h) + aoff + m * 2048 + k * 1024); } while (0)
#define PG_LDB(dst, b, h) do { _Pragma("unroll") for (int n = 0; n < 2; ++n) _Pragma("unroll") for (int k = 0; k < 2; ++k) dst[n][k] = *(const LAS h8_t*)(lds + PG_SB(b, h) + boff + n * 2048 + k * 1024); } while (0)
#define PG_MMA(ai, bj, At, Bt) do { __builtin_amdgcn_s_setprio(1); _Pragma("unroll") for (int m = 0; m < 4; ++m) _Pragma("unroll") for (int n = 0; n < 2; ++n) _Pragma("unroll") for (int k = 0; k < 2; ++k) \
        acc[ai][bj][m][n] = __builtin_amdgcn_mfma_f32_16x16x32_f16(Bt[n][k], At[m][k], acc[ai][bj][m][n], 0, 0, 0); __builtin_amdgcn_s_setprio(0); } while (0)
#define PG_WAIT_V(n) asm volatile("s_waitcnt vmcnt(" #n ")" ::: "memory")
#define PG_WAIT_F() do { if constexpr (RELAX) asm volatile("s_cmp_lg_u32 %0, 0\n\ts_cbranch_scc1 1f\n\ts_waitcnt vmcnt(8)\n1:\n\ts_waitcnt vmcnt(%1)" :: "s"(__builtin_amdgcn_readfirstlane(wf)), "n"(8 + Epi::NVM) : "memory", "scc"); else PG_WAIT_V(8); } while (0)
#define PG_WAIT_L(n) asm volatile("s_waitcnt lgkmcnt(" #n ")" ::: "memory")
#define PG_BAR __builtin_amdgcn_s_barrier()
#define PG_SCHED __builtin_amdgcn_sched_barrier(0)
#define PG_VOFFA(dst, u) do { _Pragma("unroll") for (int _h = 0; _h < 2; ++_h) _Pragma("unroll") for (int _i = 0; _i < 2; ++_i) dst[_h][_i] = g.a_row_off(u, _h * HALF + sR[_i]) + (unsigned)sC[_i] * 2u; } while (0)
    Unit cur, nxt; int ui = 0, pnv = 0;
    if (!S.next(0, cur)) return;
    f32x4 acc[2][2][4][2];
#pragma unroll
    for (int a = 0; a < 2; ++a)
#pragma unroll
        for (int b = 0; b < 2; ++b)
#pragma unroll
            for (int m = 0; m < 4; ++m)
#pragma unroll
                for (int n = 0; n < 2; ++n) acc[a][b][m][n] = (f32x4){0.f, 0.f, 0.f, 0.f};
    h8_t At[4][2], B0[2][2], B1[2][2];
    const char* cA = g.a_ptr(cur); const char* cB = g.b_ptr(cur);
    unsigned vA[2][2], nvA[2][2];
    PG_VOFFA(vA, cur);
    PG_STAGE(PG_SB(0, 0), cB, voffB); PG_STAGE(PG_SB(0, 1), cB + hstepB, voffB); PG_STAGE(PG_SA(0, 0), cA, vA[0]); PG_STAGE(PG_SA(0, 1), cA, vA[1]);
    if (wr == 1) PG_BAR;
    PG_WAIT_V(2); PG_BAR;
    PG_STAGE(PG_SB(1, 0), cB + kstep, voffB); PG_STAGE(PG_SA(1, 0), cA + kstep, vA[0]); PG_STAGE(PG_SB(1, 1), cB + hstepB + kstep, voffB); PG_STAGE(PG_SA(1, 1), cA + kstep, vA[1]);
    PG_WAIT_V(8); PG_BAR;
    for (;;) {
        const bool has_next = S.next(ui + 1, nxt);
        const char* nA = has_next ? g.a_ptr(nxt) : cA; const char* nB = has_next ? g.b_ptr(nxt) : cB;
        if constexpr (Prob::GATHER) { if (has_next) g.prefetch_idx(nxt, tid, wid); }
        int wf = (ui > 0) ? pnv : 0;
        for (int t = 0; t < nt; t += 2) {
            const bool last = (t == nt - 2);
            if constexpr (Prob::GATHER) { if (last) {
#pragma unroll
                for (int _h = 0; _h < 2; ++_h)
#pragma unroll
                    for (int _i = 0; _i < 2; ++_i) nvA[_h][_i] = has_next ? g.a_row_off_lds(nxt, _h * HALF + sR[_i]) + (unsigned)sC[_i] * 2u : vA[_h][_i]; } }
            const char* a2 = last ? nA : cA + (size_t)(t + 2) * kstep; const char* b2 = last ? nB : cB + (size_t)(t + 2) * kstep;
            const char* a3 = a2 + kstep; const char* b3 = b2 + kstep;
            unsigned wA[2][2];
#pragma unroll
            for (int _h = 0; _h < 2; ++_h)
#pragma unroll
                for (int _i = 0; _i < 2; ++_i) wA[_h][_i] = (Prob::GATHER && last) ? nvA[_h][_i] : vA[_h][_i];
            if constexpr (has_prefetch<Epi>::value) { if (last) E.prefetch(cur, tid, wid); }
            PG_LDB(B0, 0, 0); PG_LDB(B1, 0, 1); PG_SCHED; PG_LDA(At, 0, 0);
            PG_WAIT_F(); PG_WAIT_L(0); PG_BAR; PG_MMA(0, 0, At, B0); PG_MMA(0, 1, At, B1); PG_BAR; PG_SCHED;
            PG_LDA(At, 0, 1); PG_STAGE(PG_SB(0, 0), b2, voffB); PG_STAGE(PG_SB(0, 1), b2 + hstepB, voffB); PG_STAGE(PG_SA(0, 0), a2, wA[0]);
            PG_WAIT_F(); PG_WAIT_L(0); PG_BAR; PG_MMA(1, 0, At, B0); PG_MMA(1, 1, At, B1); PG_BAR; PG_SCHED;
            PG_LDB(B0, 1, 0); PG_LDB(B1, 1, 1); PG_SCHED; PG_LDA(At, 1, 0); PG_STAGE(PG_SA(0, 1), a2, wA[1]);
            PG_WAIT_F(); PG_WAIT_L(0); PG_BAR; PG_MMA(0, 0, At, B0); PG_MMA(0, 1, At, B1); PG_BAR; PG_SCHED;
            PG_LDA(At, 1, 1); PG_STAGE(PG_SB(1, 0), b3, voffB); PG_STAGE(PG_SB(1, 1), b3 + hstepB, voffB); PG_STAGE(PG_SA(1, 0), a3, wA[0]);
            PG_WAIT_V(8); PG_WAIT_L(0); PG_BAR; PG_MMA(1, 0, At, B0); PG_MMA(1, 1, At, B1); PG_BAR; PG_SCHED;
            PG_STAGE(PG_SA(1, 1), a3, wA[1]);
            if constexpr (RELAX) { wf = 0; asm volatile("" : "+s"(wf)); }
        }
        if constexpr (ALIGN_EPI) { if (wr == 0) PG_BAR; }
        if constexpr (!Epi::AFTER_DRAIN) { E(acc, cur, wr, wc, fr, fq); pnv = E.nvm_ok(cur) ? 1 : 0; }
        if (!has_next) break;
#pragma unroll
        for (int a = 0; a < 2; ++a)
#pragma unroll
            for (int b = 0; b < 2; ++b)
#pragma unroll
                for (int m = 0; m < 4; ++m)
#pragma unroll
                    for (int n = 0; n < 2; ++n) acc[a][b][m][n] = (f32x4){0.f, 0.f, 0.f, 0.f};
        cur = nxt; cA = nA; cB = nB; ++ui;
        if (Prob::GATHER) {
#pragma unroll
            for (int _h = 0; _h < 2; ++_h)
#pragma unroll
                for (int _i = 0; _i < 2; ++_i) vA[_h][_i] = nvA[_h][_i]; }
        if constexpr (ALIGN_EPI) { if (wr == 1) PG_BAR; }
    }
    PG_WAIT_V(0);
    if constexpr (!ALIGN_EPI) { if (wr == 0) PG_BAR; }
    PG_BAR;
    if constexpr (Epi::AFTER_DRAIN) { E.fused(acc, cur, wr, wc, fr, fq, lds, wid, lane); asm volatile("s_waitcnt lgkmcnt(0)" ::: "memory"); PG_BAR; }
#undef PG_SA
#undef PG_SB
#undef PG_STAGE
#undef PG_LDA
#undef PG_LDB
#undef PG_MMA
#undef PG_WAIT_V
#undef PG_WAIT_F
#undef PG_WAIT_L
#undef PG_BAR
#undef PG_SCHED
#undef PG_VOFFA
}
}

namespace attn {
typedef short s16x4 __attribute__((ext_vector_type(4)));
typedef short s16x8 __attribute__((ext_vector_type(8)));
typedef float f32x16 __attribute__((ext_vector_type(16)));
constexpr int NW = 8, QBLK = 32, QB = QBLK * NW, KVBLK = 64;
__device__ __forceinline__ int crow(int r, int hi) { return (r & 3) + 8 * (r >> 2) + 4 * hi; }
#define SBAR() __builtin_amdgcn_sched_barrier(0)
constexpr int NSLOT = 3, SLOTB = 9216;
constexpr int LDS_K = 0, LDS_V = NSLOT * SLOTB, LDS_WS = 2 * NSLOT * SLOTB, LDS_OST = LDS_WS + NW * 64 * 4, LDS_BYTES = LDS_OST + NW * 4096;
constexpr float NEGS = -8192.f;
__device__ __forceinline__ void glds16s(const void* sbase, unsigned voff, unsigned lds_dst) { unsigned keep;
  asm volatile("s_mov_b32 %0, m0\n\ts_mov_b32 m0, %3\n\ts_nop 4\n\tglobal_load_lds_dwordx4 %1, %2\n\ts_mov_b32 m0, %0" : "=&s"(keep) : "v"(voff), "s"(sbase), "s"(lds_dst) : "memory"); }
__device__ __forceinline__ float max3f(float a, float b, float c) { float r; asm("v_max3_f32 %0, %1, %2, %3" : "=v"(r) : "v"(a), "v"(b), "v"(c)); return r; }
__device__ __forceinline__ float max2f(float a, float b) { float r; asm("v_max_f32_e32 %0, %1, %2" : "=v"(r) : "v"(a), "v"(b)); return r; }
__device__ __forceinline__ float fadd_s(float a, float b) { float r; asm("v_add_f32_e32 %0, %1, %2" : "=v"(r) : "v"(a), "v"(b)); return r; }
__device__ __forceinline__ float fsub_s(float a, float b) { float r; asm("v_sub_f32_e32 %0, %1, %2" : "=v"(r) : "v"(a), "v"(b)); return r; }
#define WAIT_BAR(N) asm volatile("s_waitcnt vmcnt(" #N ") lgkmcnt(0)\n\ts_barrier" ::: "memory")
#define MF16(a, b, c) __builtin_amdgcn_mfma_f32_32x32x16_f16(a, b, c, 0, 0, 0)
typedef __attribute__((address_space(3))) const char* lds_cptr;
typedef short v4i16_t __attribute__((ext_vector_type(4)));
__device__ __forceinline__ void kload2(h8_t* kf, lds_cptr kp, int j) { kf[2 * j] = *(const LAS h8_t*)(kp + j * 2048); kf[2 * j + 1] = *(const LAS h8_t*)(kp + j * 2048 + 512); }
__device__ __forceinline__ s16x4 vtr(lds_cptr p) { return __builtin_bit_cast(s16x4, __builtin_amdgcn_ds_read_tr16_b64_v4i16((LAS v4i16_t*)p)); }
__device__ __forceinline__ float rowmax(const f32x16& p0, const f32x16& p1) {
  float a = max3f(p0[0], p0[1], p1[0]), b = max3f(p0[2], p0[3], p1[1]); a = max3f(a, p1[2], p1[3]);
#pragma unroll
  for (int r = 4; r < 16; r += 4) { a = max3f(a, p0[r], p0[r + 1]); b = max3f(b, p0[r + 2], p0[r + 3]); a = max3f(a, p1[r], p1[r + 1]); b = max3f(b, p1[r + 2], p1[r + 3]); }
  const float m = max2f(a, b);
  auto rr = __builtin_amdgcn_permlane32_swap(__float_as_uint(m), __float_as_uint(m), false, false);
  return max2f(__uint_as_float(rr[0]), __uint_as_float(rr[1]));
}
__device__ __forceinline__ void cmask(f32x16& p0, f32x16& p1, int jb, int qrel, int hi) {
  const float NEG = -INFINITY; const int kb = 64 * jb + 4 * hi;
#pragma unroll
  for (int r = 0; r < 16; ++r) { const int kv = kb + (r & 3) + 8 * (r >> 2); if (kv > qrel) p0[r] = NEG; if (kv + 32 > qrel) p1[r] = NEG; }
}
__device__ __forceinline__ void smask(f32x16& p0, f32x16& p1, int kb0, int qrel, int hi) {
  const int kb = kb0 + 4 * hi;
#pragma unroll
  for (int r = 0; r < 16; ++r) { const int kv = kb + (r & 3) + 8 * (r >> 2); if ((unsigned)(qrel - kv) > 127u) p0[r] = NEGS; if ((unsigned)(qrel - kv - 32) > 127u) p1[r] = NEGS; }
}
__device__ __forceinline__ void pv(f32x16* o, int vb, h8_t pa0, h8_t pa1, h8_t pa2, h8_t pa3) {
#pragma unroll
  for (int d0 = 0; d0 < 2; ++d0) { s16x4 lo[4], hi[4];
#pragma unroll
    for (int ks = 0; ks < 4; ++ks) {
      asm volatile("ds_read_b64_tr_b16 %0,%1 offset:%c2" : "=&v"(lo[ks]) : "v"(vb), "i"(d0 * 4096 + ks * 1024) : "memory");
      asm volatile("ds_read_b64_tr_b16 %0,%1 offset:%c2" : "=&v"(hi[ks]) : "v"(vb), "i"(d0 * 4096 + ks * 1024 + 512) : "memory"); }
    asm volatile("s_waitcnt lgkmcnt(0)" ::: "memory"); SBAR();
#define PK(k) __builtin_bit_cast(h8_t, (s16x8){lo[k][0], lo[k][1], lo[k][2], lo[k][3], hi[k][0], hi[k][1], hi[k][2], hi[k][3]})
    o[d0] = MF16(pa0, PK(0), o[d0]); o[d0] = MF16(pa1, PK(1), o[d0]); o[d0] = MF16(pa2, PK(2), o[d0]); o[d0] = MF16(pa3, PK(3), o[d0]);
#undef PK
  }
}

template <int MODE, int THRL>
__device__ __forceinline__ void attn_unit(int b, int h, int qb, const half_t* Zp, const half_t* BKp, const int* TSp, const float* CUMp, const float* sinks, half_t* Op, char* shm) {
  int lane; asm volatile("v_mbcnt_lo_u32_b32 %0, -1, 0\n\tv_mbcnt_hi_u32_b32 %0, -1, %0" : "=v"(lane));
  const int r32 = lane & 31, hi = lane >> 5; const int wid = __builtin_amdgcn_readfirstlane(threadIdx.x >> 6);
  const long rowbase = (long)b * SEQ; const int q0 = (MODE == 0) ? qb * QB : qb * 64;
  const int hq = (MODE == 0) ? h : 4 * h + (wid & 3), wrow = (MODE == 0) ? wid * QBLK : (wid >> 2) * QBLK;
  const int qcol = (MODE == 0) ? ZQF + h * 64 : ZQS + hq * 64, kcol = (MODE == 0) ? ZKF + h * 64 : ZKS + h * 64, vcol = (MODE == 0) ? ZVF + h * 64 : ZVS + h * 64;
  const int ocol = (MODE == 0) ? h * 64 : 512 + hq * 64;
  const int tile0 = (MODE == 0) ? __builtin_amdgcn_readfirstlane(TSp[(b * 8 + h) * 16 + qb]) : ((qb - 2 < 0) ? 0 : (qb - 2 > 60) ? 60 : qb - 2);
  const int NT = (MODE == 0) ? 4 * qb + 4 - tile0 : 4;
  const int krel0 = (MODE == 0) ? (tile0 - 4 * qb) * 64 : (tile0 - qb) * 64;
  const half_t* Qw = Zp + (rowbase + q0 + wrow) * ZW + qcol;
  const half_t* Kh = Zp + (rowbase + (long)tile0 * KVBLK) * ZW + kcol; const half_t* Vh = Zp + (rowbase + (long)tile0 * KVBLK) * ZW + vcol;
  const unsigned lds0 = (unsigned)(uintptr_t)shm;
  float* wsf = (float*)(shm + LDS_WS) + wid * 64;
  const unsigned koff = (unsigned)(lane * ZW + wid * 8) * 2u;
  const unsigned voff = (unsigned)((16 * (wid & 3) + (lane >> 2)) * ZW + (wid >> 2) * 32 + (lane & 3) * 8) * 2u;
  const unsigned boff = (unsigned)lane * 16u;
  const half_t* Bh = BKp + ((long)(b * 8 + h) * SEQ + (long)tile0 * KVBLK) * 8;
  const unsigned kdst = lds0 + LDS_K + wid * 1024, vdst = lds0 + LDS_V + wid * 1024, bdst = lds0 + LDS_K + 8192;
#define DMA_K(t, slot) do { glds16s(Kh + (long)(t) * KVBLK * ZW, koff, (unsigned)__builtin_amdgcn_readfirstlane(kdst + (slot))); \
    if (MODE == 0 && wid == 0) glds16s(Bh + (long)(t) * KVBLK * 8, boff, (unsigned)__builtin_amdgcn_readfirstlane(bdst + (slot))); } while (0)
#define DMA_V(t, slot) glds16s(Vh + (long)(t) * KVBLK * ZW, voff, (unsigned)__builtin_amdgcn_readfirstlane(vdst + (slot)))
#define WAITB(N, NB) do { if (MODE == 0 && wid == 0) { WAIT_BAR_N(N + NB); } else { WAIT_BAR_N(N); } } while (0)
#define WAIT_BAR_N(n) do { if ((n) == 0) WAIT_BAR(0); else if ((n) == 1) WAIT_BAR(1); else if ((n) == 2) WAIT_BAR(2); else if ((n) == 3) WAIT_BAR(3); else if ((n) == 4) WAIT_BAR(4); else WAIT_BAR(5); } while (0)
  h8_t kf[10];
  const lds_cptr shm3 = (lds_cptr)shm; const lds_cptr kp0 = shm3 + LDS_K + hi * 1024 + r32 * 16; const lds_cptr kpe = shm3 + LDS_K + 8192 + r32 * 16;
  const lds_cptr vp0 = shm3 + LDS_V + ((lane >> 4) & 1) * 32 + (lane & 3) * 8 + (4 * hi + ((lane & 15) >> 2)) * 64;
  if (MODE == 1 && wid == 0) { const u4_t one_ = (u4_t){0x3C003C00u, 0u, 0u, 0u};
#pragma unroll
    for (int sl = 0; sl < NSLOT; ++sl) *(LAS u4_t*)(shm3 + LDS_K + sl * SLOTB + 8192 + lane * 16) = one_; }
  DMA_K(0, 0); DMA_V(0, 0); DMA_K(1, SLOTB);
  h8_t qr[4];
#pragma unroll
  for (int d0 = 0; d0 < 4; ++d0) qr[d0] = *reinterpret_cast<const h8_t*>(&Qw[(long)r32 * ZW + d0 * 16 + hi * 8]);
  h8_t qe; float mhat = 0.f, l_reg = 0.f; f32x16 o[2]; o[0] = f32x16{}; o[1] = f32x16{};
#define SETQE(TARGET) do { const float nt_ = -(TARGET); const half_t mh_ = (half_t)nt_; const half_t ml_ = (half_t)(nt_ - (float)mh_); mhat = -((float)mh_ + (float)ml_); \
    const unsigned mw_ = (unsigned)__builtin_bit_cast(unsigned short, mh_) | ((unsigned)__builtin_bit_cast(unsigned short, ml_) << 16); \
    u4_t w_; w_.x = (MODE == 0) ? 0x3C003C00u : mw_; w_.y = (MODE == 0) ? mw_ : 0u; w_.z = 0u; w_.w = 0u; if (hi != 0) { w_.x = 0u; w_.y = 0u; } qe = __builtin_bit_cast(h8_t, w_); } while (0)
  if (MODE == 0) { const float bq = -CUMp[(long)(b * 8 + h) * SEQ + q0 + wid * QBLK + r32] * LOG2E; SETQE(bq); } else { SETQE(0.f); }
  const f32x16 zero16 = f32x16{};
  const int qrel = wrow + r32;
#define CMASK(P0, P1, t) do { if (MODE == 0) { int jb_ = (t) - (NT - 4); if (jb_ >= 0) cmask(P0, P1, jb_, qrel, hi); } else smask(P0, P1, krel0 + 64 * (t), qrel, hi); } while (0)
  bool resc = false;
#define START(P0, P1) do { const float rm = rowmax(P0, P1); resc = false; \
    if (MODE == 1 || __any(rm > (float)THRL)) { const float mold_ = mhat; SETQE(mold_ + ((MODE == 1) ? rm : __builtin_fmaxf(rm, 0.f))); const float dl = mhat - mold_; \
      _Pragma("unroll") for (int r = 0; r < 16; ++r) { P0[r] = fsub_s(P0[r], dl); P1[r] = fsub_s(P1[r], dl); } } \
    _Pragma("unroll") for (int r = 0; r < 16; ++r) P0[r] = __builtin_amdgcn_exp2f(P0[r]); } while (0)
#define RESC() do { if (resc) { asm volatile("s_waitcnt lgkmcnt(0)" ::: "memory"); \
      _Pragma("unroll") for (int d_ = 0; d_ < 2; ++d_) _Pragma("unroll") for (int r = 0; r < 16; ++r) o[d_][r] *= wsf[crow(r, hi)]; } } while (0)
  f32x16 pA0, pA1, pB0, pB1;
  int sl_prev = 0, sl_cur = 0, sl_next = SLOTB;
#define ROT() do { sl_prev = sl_cur; sl_cur = sl_next; sl_next = (sl_next == (NSLOT - 1) * SLOTB) ? 0 : sl_next + SLOTB; } while (0)
  DMA_K(2, 2 * SLOTB);
  WAITB(3, 2);
  { const lds_cptr kb = kp0;
#pragma unroll
    for (int d0 = 0; d0 < 4; ++d0) { const h8_t b0 = *(const LAS h8_t*)(kb + d0 * 2048), b1 = *(const LAS h8_t*)(kb + d0 * 2048 + 512);
      if (d0 == 0) { pA0 = MF16(b0, qr[0], zero16); pA1 = MF16(b1, qr[0], zero16); } else { pA0 = MF16(b0, qr[d0], pA0); pA1 = MF16(b1, qr[d0], pA1); } }
    { const h8_t e0 = *(const LAS h8_t*)(kpe), e1 = *(const LAS h8_t*)(kpe + 512); pA0 = MF16(e0, qe, pA0); pA1 = MF16(e1, qe, pA1); } }
  asm volatile("s_nop 15\n\ts_nop 7" : "+v"(pA0), "+v"(pA1)); CMASK(pA0, pA1, 0);
  START(pA0, pA1);
  _Pragma("unroll") for (int r = 0; r < 16; ++r) pA1[r] = __builtin_amdgcn_exp2f(pA1[r]);
  WAIT_BAR(0);
  DMA_K(3, 0); DMA_V(1, SLOTB);
  ROT();
  kload2(kf, kp0 + sl_cur, 0); kload2(kf, kp0 + sl_cur, 1); kload2(kf, kp0 + sl_cur, 2); kload2(kf, kp0 + sl_cur, 3);
  kf[8] = *(const LAS h8_t*)(kpe + sl_cur); kf[9] = *(const LAS h8_t*)(kpe + sl_cur + 512);
  WAITB(2, 1);
  s16x4 vlo[8], vhi[8]; u4_t pw0, pw1, pw2, pw3;
#define PKW(P, B) pkh(P[B], P[B + 1])
#define PAF(k) __builtin_bit_cast(h8_t, pw##k)
#define VFR(i) __builtin_bit_cast(h8_t, (s16x8){vlo[i][0], vlo[i][1], vlo[i][2], vlo[i][3], vhi[i][0], vhi[i][1], vhi[i][2], vhi[i][3]})
#define PIN(x) asm volatile("" : "+v"(x))
#define MX3(a, b, c) __builtin_fmaxf(__builtin_fmaxf((a), (b)), (c))
#define GAPA(MF, A0, A1, A2, A3, W0, W1, PW) do { MF; sacc += A0; sacc += A1; sacc += A2; sacc += A3; PIN(sacc); W0; W1; PIN(PW); SBAR(); } while (0)
#define EX(v) __builtin_amdgcn_exp2f(v)
#define GAPB(MF, X, B) do { MF; X[B] = EX(X[B]); X[B + 1] = EX(X[B + 1]); X[B + 2] = EX(X[B + 2]); X[B + 3] = EX(X[B + 3]); PIN(X); SBAR(); } while (0)
#define VRD(i) do { vlo[i] = vtr(vp_ + (((i) >> 2) * 4096 + ((i) & 3) * 1024)); vhi[i] = vtr(vp_ + (((i) >> 2) * 4096 + ((i) & 3) * 1024 + 512)); } while (0)
#define KRD(G, j) do { if (G) { kload2(kf, kp0 + sl_next, j); SBAR(); } } while (0)
#define KRDE(G) do { if (G) { kf[8] = *(const LAS h8_t*)(kpe + sl_next); kf[9] = *(const LAS h8_t*)(kpe + sl_next + 512); SBAR(); } } while (0)
#define STEP(C0, C1, P0, P1, t, GK, GV, GL) do { SBAR(); \
    const lds_cptr vp_ = vp0 + sl_prev; \
    VRD(0); SBAR(); float sacc = (P0[0] + P0[1]); \
    GAPA(C0 = MF16(kf[0], qr[0], zero16), P0[2], P0[3], P0[4], P0[5],     pw0[0] = PKW(P0, 0), pw0[1] = PKW(P0, 2), pw0); \
    VRD(4); SBAR(); GAPA(C1 = MF16(kf[1], qr[0], zero16), P0[6], P0[7], P0[8], P0[9],     pw0[2] = PKW(P0, 4), pw0[3] = PKW(P0, 6), pw0); \
    VRD(1); SBAR(); GAPA(C0 = MF16(kf[2], qr[1], C0),   P0[10], P0[11], P0[12], P0[13], pw1[0] = PKW(P0, 8), pw1[1] = PKW(P0, 10), pw1); \
    VRD(5); SBAR(); GAPA(C1 = MF16(kf[3], qr[1], C1),   P0[14], P0[15], P1[0], P1[1],   pw1[2] = PKW(P0, 12), pw1[3] = PKW(P0, 14), pw1); \
    VRD(2); SBAR(); GAPA(C0 = MF16(kf[4], qr[2], C0),   P1[2], P1[3], P1[4], P1[5],     pw2[0] = PKW(P1, 0), pw2[1] = PKW(P1, 2), pw2); \
    VRD(6); SBAR(); GAPA(C1 = MF16(kf[5], qr[2], C1),   P1[6], P1[7], P1[8], P1[9],     pw2[2] = PKW(P1, 4), pw2[3] = PKW(P1, 6), pw2); \
    VRD(3); SBAR(); GAPA(C0 = MF16(kf[6], qr[3], C0),   P1[10], P1[11], P1[12], P1[13], pw3[0] = PKW(P1, 8), pw3[1] = PKW(P1, 10), pw3); \
    VRD(7); SBAR(); GAPA(C1 = MF16(kf[7], qr[3], C1),   P1[14], P1[15], 0.f, 0.f,       pw3[2] = PKW(P1, 12), pw3[3] = PKW(P1, 14), pw3); \
    C0 = MF16(kf[8], qe, C0); C1 = MF16(kf[9], qe, C1); SBAR(); \
    l_reg += sacc; \
    if (GK) { DMA_K((t) + 3, sl_cur); } if (GV) { DMA_V((t) + 1, sl_next); } \
    CMASK(C0, C1, t); \
    { float a = MX3(C0[0], C0[1], C1[0]), b = MX3(C0[2], C0[3], C1[1]); a = MX3(a, C1[2], C1[3]); \
      _Pragma("unroll") for (int r = 4; r < 16; r += 4) { a = MX3(a, C0[r], C0[r + 1]); b = MX3(b, C0[r + 2], C0[r + 3]); a = MX3(a, C1[r], C1[r + 1]); b = MX3(b, C1[r + 2], C1[r + 3]); } \
      float rm = __builtin_fmaxf(a, b); { auto rr = __builtin_amdgcn_permlane32_swap(__float_as_uint(rm), __float_as_uint(rm), false, false); rm = __builtin_fmaxf(__uint_as_float(rr[0]), __uint_as_float(rr[1])); } \
      resc = false; \
      if (__builtin_expect(__any(rm > (float)THRL), 0)) { const float mold_ = mhat; SETQE(mold_ + __builtin_fmaxf(rm, 0.f)); const float dl = mhat - mold_; \
        _Pragma("unroll") for (int r = 0; r < 16; ++r) { C0[r] -= dl; C1[r] -= dl; } \
        const float f = __builtin_amdgcn_exp2f(-dl); l_reg *= f; if (hi == 0) wsf[r32] = f; resc = true; } } \
    SBAR(); \
    GAPB(o[0] = MF16(PAF(0), VFR(0), o[0]), C0, 0); \
    GAPB(o[1] = MF16(PAF(0), VFR(4), o[1]), C0, 4); \
    KRD(GL, 0); GAPB(o[0] = MF16(PAF(1), VFR(1), o[0]), C0, 8); \
    KRD(GL, 1); GAPB(o[1] = MF16(PAF(1), VFR(5), o[1]), C0, 12); \
    KRD(GL, 2); GAPB(o[0] = MF16(PAF(2), VFR(2), o[0]), C1, 0); \
    KRD(GL, 3); GAPB(o[1] = MF16(PAF(2), VFR(6), o[1]), C1, 4); \
    KRDE(GL); GAPB(o[0] = MF16(PAF(3), VFR(3), o[0]), C1, 8); \
    GAPB(o[1] = MF16(PAF(3), VFR(7), o[1]), C1, 12); \
    } while (0)
  int t = 1;
  if (MODE == 0) {
#undef CMASK
#define CMASK(P0, P1, t) do { } while (0)
    for (; t + 5 < NT; t += 2) {
      STEP(pB0, pB1, pA0, pA1, t, true, true, true);     WAITB(2, 1); RESC(); ROT();
      STEP(pA0, pA1, pB0, pB1, t + 1, true, true, true); WAITB(2, 1); RESC(); ROT();
    }
#undef CMASK
#define CMASK(P0, P1, t) do { if (MODE == 0) { int jb_ = (t) - (NT - 4); if (jb_ >= 0) cmask(P0, P1, jb_, qrel, hi); } else smask(P0, P1, krel0 + 64 * (t), qrel, hi); } while (0)
  }
#define ENDW(tt) do { if ((tt) + 3 < NT) { WAITB(2, 1); } else if ((tt) + 2 < NT) { WAITB(1, 0); } else { WAIT_BAR(0); } } while (0)
  for (; t + 1 < NT; t += 2) {
    STEP(pB0, pB1, pA0, pA1, t, (t + 3 < NT), (t + 1 < NT), (t + 1 < NT));         ENDW(t);     RESC(); ROT();
    STEP(pA0, pA1, pB0, pB1, t + 1, (t + 4 < NT), (t + 2 < NT), (t + 2 < NT));     ENDW(t + 1); RESC(); ROT();
  }
  STEP(pB0, pB1, pA0, pA1, NT - 1, false, false, false); RESC();
  { float sacc = pB0[0] + pB0[1]; _Pragma("unroll") for (int r = 2; r < 16; ++r) sacc += pB0[r]; _Pragma("unroll") for (int r = 0; r < 16; ++r) sacc += pB1[r]; l_reg += sacc;
    pw0 = (u4_t){PKW(pB0, 0), PKW(pB0, 2), PKW(pB0, 4), PKW(pB0, 6)}; pw1 = (u4_t){PKW(pB0, 8), PKW(pB0, 10), PKW(pB0, 12), PKW(pB0, 14)};
    pw2 = (u4_t){PKW(pB1, 0), PKW(pB1, 2), PKW(pB1, 4), PKW(pB1, 6)}; pw3 = (u4_t){PKW(pB1, 8), PKW(pB1, 10), PKW(pB1, 12), PKW(pB1, 14)};
    SBAR(); pv(o, (int)(unsigned)(uintptr_t)(vp0 + sl_cur), PAF(0), PAF(1), PAF(2), PAF(3)); }
#undef PKW
#undef PAF
#undef VFR
#undef PIN
#undef MX3
#undef GAPA
#undef GAPB
#undef EX
#undef VRD
#undef KRD
#undef KRDE
#undef STEP
#undef ENDW
  { auto rr = __builtin_amdgcn_permlane32_swap(__float_as_uint(l_reg), __float_as_uint(l_reg), false, false); l_reg = __uint_as_float(rr[0]) + __uint_as_float(rr[1]); }
  if (MODE == 1) l_reg += __builtin_amdgcn_exp2f(sinks[hq] * LOG2E - mhat);
  if (hi == 0) wsf[32 + r32] = l_reg; asm volatile("s_waitcnt lgkmcnt(0)" ::: "memory");
  float rli[16];
#pragma unroll
  for (int r = 0; r < 16; ++r) rli[r] = __builtin_amdgcn_rcpf(wsf[32 + crow(r, hi)]);
  half_t* Ow = Op + (rowbase + q0 + wrow) * DM + ocol;
  { half_t* stg = (half_t*)(shm + LDS_OST) + wid * 2048;
#pragma unroll
    for (int r = 0; r < 16; ++r) { const int orow = crow(r, hi);
#pragma unroll
      for (int d0 = 0; d0 < 2; ++d0) stg[orow * 64 + d0 * 32 + r32] = (half_t)(o[d0][r] * rli[r]); }
    asm volatile("s_waitcnt lgkmcnt(0)" ::: "memory");
#pragma unroll
    for (int i = 0; i < 4; ++i) { const int row = i * 8 + (lane >> 3), ch = lane & 7; const u4_t v = *(const u4_t*)(stg + row * 64 + ch * 8); *(u4_t*)(Ow + (long)row * DM + ch * 8) = v; } }
  asm volatile("s_waitcnt lgkmcnt(0)\n\ts_barrier" ::: "memory");
#undef DMA_K
#undef DMA_V
#undef WAITB
#undef WAIT_BAR_N
#undef CMASK
#undef START
#undef RESC
#undef SETQE
#undef ROT
}

template <int NU>
__device__ __forceinline__ void swa_units(int b, int h, int qb0, const half_t* Zp, const float* sinks, half_t* Op, char* shm, LAS unsigned char* wsx) {
  int lane; asm volatile("v_mbcnt_lo_u32_b32 %0, -1, 0\n\tv_mbcnt_hi_u32_b32 %0, -1, %0" : "=v"(lane));
  const int r32 = lane & 31, hi = lane >> 5; const int wid = __builtin_amdgcn_readfirstlane(threadIdx.x >> 6);
  const long rowbase = (long)b * SEQ;
  const int hq = 4 * h + (wid & 3), wrow = (wid >> 2) * QBLK;
  const int qcol = ZQS + hq * 64, kcol = ZKS + h * 64, vcol = ZVS + h * 64, ocol = 512 + hq * 64;
  const unsigned lds0 = (unsigned)(uintptr_t)shm; const lds_cptr shm3 = (lds_cptr)shm;
  const unsigned koff = (unsigned)(lane * ZW + wid * 8) * 2u;
  const unsigned voff = (unsigned)((16 * (wid & 3) + (lane >> 2)) * ZW + (wid >> 2) * 32 + (lane & 3) * 8) * 2u;
  const int vlane = ((lane >> 4) & 1) * 32 + (lane & 3) * 8 + (4 * hi + ((lane & 15) >> 2)) * 64;
  LAS float* wsf = (LAS float*)(wsx + wid * 256);
  const float sinkl = sinks[hq] * LOG2E;
#define SW_T0(qb) (((qb) - 2 < 0) ? 0 : ((qb) - 2 > 61) ? 61 : (qb) - 2)
#define SW_ISSUE(qb, u) do { const int t0_ = SW_T0(qb); _Pragma("unroll") for (int t_ = 0; t_ < 3; ++t_) { \
      glds16s(Zp + (rowbase + (long)(t0_ + t_) * KVBLK) * ZW + kcol, koff, (unsigned)__builtin_amdgcn_readfirstlane(lds0 + ((u) * 6 + t_) * 8192 + wid * 1024)); \
      glds16s(Zp + (rowbase + (long)(t0_ + t_) * KVBLK) * ZW + vcol, voff, (unsigned)__builtin_amdgcn_readfirstlane(lds0 + ((u) * 6 + 3 + t_) * 8192 + wid * 1024)); } } while (0)
#define SW_QLOAD(dst, qb) do { const half_t* qw_ = Zp + (rowbase + (qb) * 64 + wrow) * ZW + qcol; _Pragma("unroll") for (int d0 = 0; d0 < 4; ++d0) dst[d0] = *reinterpret_cast<const h8_t*>(&qw_[(long)r32 * ZW + d0 * 16 + hi * 8]); } while (0)
  h8_t qc[4], qn[4];
  SW_QLOAD(qc, qb0); SW_ISSUE(qb0, 0);
#pragma unroll
  for (int i = 0; i < NU; ++i) {
    const int qb = qb0 + i, u = i & 1;
    if (i + 1 < NU) { SW_QLOAD(qn, qb + 1); SW_ISSUE(qb + 1, u ^ 1); asm volatile("s_waitcnt vmcnt(10)\n\ts_barrier" ::: "memory"); }
    else asm volatile("s_waitcnt vmcnt(0)\n\ts_barrier" ::: "memory");
    const int tile0 = SW_T0(qb), krel0 = (tile0 - qb) * 64, qrel = wrow + r32;
    f32x16 s0[3], s1[3];
#pragma unroll
    for (int t = 0; t < 3; ++t) { const lds_cptr kb = shm3 + (u * 6 + t) * 8192 + hi * 1024 + r32 * 16;
#pragma unroll
      for (int d0 = 0; d0 < 4; ++d0) { const h8_t b0 = *(const LAS h8_t*)(kb + d0 * 2048), b1 = *(const LAS h8_t*)(kb + d0 * 2048 + 512);
        if (d0 == 0) { s0[t] = MF16(b0, qc[0], f32x16{}); s1[t] = MF16(b1, qc[0], f32x16{}); } else { s0[t] = MF16(b0, qc[d0], s0[t]); s1[t] = MF16(b1, qc[d0], s1[t]); } } }
    float m = -INFINITY;
#pragma unroll
    for (int t = 0; t < 3; ++t) { smask(s0[t], s1[t], krel0 + 64 * t, qrel, hi); m = __builtin_fmaxf(m, rowmax(s0[t], s1[t])); }
    float l = 0.f; f32x16 o[2]; o[0] = f32x16{}; o[1] = f32x16{};
#pragma unroll
    for (int t = 0; t < 3; ++t) {
#pragma unroll
      for (int r = 0; r < 16; ++r) { s0[t][r] = __builtin_amdgcn_exp2f(s0[t][r] - m); s1[t][r] = __builtin_amdgcn_exp2f(s1[t][r] - m); l += s0[t][r] + s1[t][r]; }
      const u4_t pw0 = (u4_t){pkh(s0[t][0], s0[t][1]), pkh(s0[t][2], s0[t][3]), pkh(s0[t][4], s0[t][5]), pkh(s0[t][6], s0[t][7])};
      const u4_t pw1 = (u4_t){pkh(s0[t][8], s0[t][9]), pkh(s0[t][10], s0[t][11]), pkh(s0[t][12], s0[t][13]), pkh(s0[t][14], s0[t][15])};
      const u4_t pw2 = (u4_t){pkh(s1[t][0], s1[t][1]), pkh(s1[t][2], s1[t][3]), pkh(s1[t][4], s1[t][5]), pkh(s1[t][6], s1[t][7])};
      const u4_t pw3 = (u4_t){pkh(s1[t][8], s1[t][9]), pkh(s1[t][10], s1[t][11]), pkh(s1[t][12], s1[t][13]), pkh(s1[t][14], s1[t][15])};
      pv(o, (int)(unsigned)(uintptr_t)(shm3 + (u * 6 + 3 + t) * 8192 + vlane), __builtin_bit_cast(h8_t, pw0), __builtin_bit_cast(h8_t, pw1), __builtin_bit_cast(h8_t, pw2), __builtin_bit_cast(h8_t, pw3)); }
    { auto rr = __builtin_amdgcn_permlane32_swap(__float_as_uint(l), __float_as_uint(l), false, false); l = __uint_as_float(rr[0]) + __uint_as_float(rr[1]); }
    l += __builtin_amdgcn_exp2f(sinkl - m);
    if (hi == 0) wsf[32 + r32] = l; asm volatile("s_waitcnt lgkmcnt(0)" ::: "memory");
    float rli[16];
#pragma unroll
    for (int r = 0; r < 16; ++r) rli[r] = __builtin_amdgcn_rcpf(wsf[32 + crow(r, hi)]);
    half_t* Ow = Op + (rowbase + qb * 64 + wrow) * DM + ocol;
    { half_t* stg = (half_t*)(shm + 98304) + wid * 2048;
#pragma unroll
      for (int r = 0; r < 16; ++r) { const int orow = crow(r, hi);
#pragma unroll
        for (int d0 = 0; d0 < 2; ++d0) stg[orow * 64 + d0 * 32 + r32] = (half_t)(o[d0][r] * rli[r]); }
      asm volatile("s_waitcnt lgkmcnt(0)" ::: "memory");
#pragma unroll
      for (int k = 0; k < 4; ++k) { const int row = k * 8 + (lane >> 3), ch = lane & 7; const u4_t v = *(const u4_t*)(stg + row * 64 + ch * 8); *(u4_t*)(Ow + (long)row * DM + ch * 8) = v; } }
    asm volatile("s_waitcnt lgkmcnt(0)\n\ts_barrier" ::: "memory");
#pragma unroll
    for (int d0 = 0; d0 < 4; ++d0) qc[d0] = qn[d0];
  }
#undef SW_T0
#undef SW_ISSUE
#undef SW_QLOAD
}
#undef SBAR
#undef WAIT_BAR
#undef MF16
}

#define GAS __attribute__((address_space(1)))
typedef GAS unsigned gu32;
#define RLX_AGENT __ATOMIC_RELAXED, __HIP_MEMORY_SCOPE_AGENT
constexpr int CW_TMO = 0, CW_CODE = 1;
constexpr int CW_BAR = 4096;
constexpr int CW_SEAM = 16384, SEAM_BANK = 128 * 64;
constexpr int LDS_BYTES = 147456;
constexpr int MISC_OFF = 131072 + 320;
constexpr int MR_OFF = 131072 + 1024 + 8192;
constexpr int SD_OFF = 131072 + 1024 + 8192 + 4096;
constexpr int XL_OFF = 131072 + 1024;

#define XB_TMO      128
#define XB_XCNT(j)  (256  + 64 * (j))
#define XB_XSUB(j)  (1280 + 64 * (j))
#define XB_XGEN(j)  (2304 + 64 * (j))
#define XB_TOP      3328
#define XB_TOPGEN   3392
#define XCD_BAR_WORDS 3456
#define XB_LSUB(j)  (3520 + 64 * (j))
#define XB_LGEN(j)  (4544 + 64 * (j))
#define XB_SPIN_CAP (1u << 22)
__device__ __forceinline__ unsigned xb_ld(unsigned* p)              { return __hip_atomic_load(p, __ATOMIC_RELAXED, __HIP_MEMORY_SCOPE_AGENT); }
__device__ __forceinline__ unsigned xb_add(unsigned* p, unsigned v) { return __hip_atomic_fetch_add(p, v, __ATOMIC_RELAXED, __HIP_MEMORY_SCOPE_AGENT); }
__device__ __forceinline__ unsigned xb_xcc_id() { return (unsigned)__builtin_amdgcn_s_getreg((3 << 11) | 20) & 0xFu; }
#define XB_SPIN(cond, bar) do { unsigned _sp = 0; while (cond) { __builtin_amdgcn_s_sleep(1); \
    if ((++_sp & 255u) == 0u) { if (xb_ld(&(bar)[XB_TMO])) break; if (_sp > XB_SPIN_CAP) { atomicAdd(&(bar)[XB_TMO], 1u); break; } } } } while (0)
struct XcdBarrier { unsigned* bar; unsigned x; volatile LAS unsigned* st; };
__device__ __forceinline__ XcdBarrier xcd_barrier_post(unsigned* bar, volatile LAS unsigned* st) {
    XcdBarrier b; b.bar = bar; b.x = xb_xcc_id(); b.st = st;
    if (threadIdx.x == 0) st[3] = xb_add(&bar[XB_XCNT(b.x)], 1u);
    return b;
}
__device__ __forceinline__ void xcd_barrier_complete(unsigned* bar, unsigned x, unsigned& nloc, unsigned& nx, unsigned& even) {
    const unsigned G = gridDim.x * gridDim.y * gridDim.z;
    unsigned sum, cnt, mine, ev, sp = 0u;
    for (;;) {
        sum = 0u; cnt = 0u; mine = 0u; ev = 1u;
#pragma unroll
        for (unsigned j = 0; j < 16; ++j) { const unsigned c = xb_ld(&bar[XB_XCNT(j)]); sum += c; cnt += (c > 0u) ? 1u : 0u; mine = (j == x) ? c : mine; ev &= (c == ((j < 8u) ? G / 8u : 0u)) ? 1u : 0u; }
        if (sum == G) break;
        __builtin_amdgcn_s_sleep(1);
        if ((++sp & 255u) == 0u) { if (xb_ld(&bar[XB_TMO])) break; if (sp > XB_SPIN_CAP) { atomicAdd(&bar[XB_TMO], 1u); break; } }
    }
    nloc = mine > 0u ? mine : 1u; nx = cnt > 0u ? cnt : 1u; even = (sum == G) ? ev : 0u;
}
__device__ __forceinline__ void xcd_barrier(const XcdBarrier& b) {
    asm volatile("s_waitcnt vmcnt(0)" ::: "memory");
    __syncthreads();
    if (threadIdx.x == 0) {
        unsigned* bar = b.bar;
        __builtin_amdgcn_s_waitcnt(0);
        unsigned nloc = b.st[0], nx = b.st[1];
        if (nloc == 0u) { unsigned even; xcd_barrier_complete(bar, b.x, nloc, nx, even); b.st[0] = nloc; b.st[1] = nx; b.st[2] = even; }
        const unsigned old = xb_add(&bar[XB_XSUB(b.x)], 1u);
        const unsigned gen = old / nloc;
        if (old + 1u == (gen + 1u) * nloc) {
            __builtin_amdgcn_fence(__ATOMIC_RELEASE, "agent");
            asm volatile("s_waitcnt vmcnt(0)" ::: "memory");
            const unsigned og = xb_add(&bar[XB_TOP], 1u);
            const unsigned tg = og / nx;
            if (og + 1u == (tg + 1u) * nx) xb_add(&bar[XB_TOPGEN], 1u);
            else XB_SPIN(xb_ld(&bar[XB_TOPGEN]) == tg, bar);
            __builtin_amdgcn_fence(__ATOMIC_ACQUIRE, "agent");
            xb_add(&bar[XB_XGEN(b.x)], 1u);
            asm volatile("s_waitcnt vmcnt(0)" ::: "memory");
        } else {
            XB_SPIN(xb_ld(&bar[XB_XGEN(b.x)]) == gen, bar);
            __builtin_amdgcn_fence(__ATOMIC_ACQUIRE, "agent");
            asm volatile("s_waitcnt vmcnt(0)" ::: "memory");
        }
    }
    __syncthreads();
}

__device__ __forceinline__ void xcd_barrier_local(const XcdBarrier& b) {
    asm volatile("s_waitcnt vmcnt(0)" ::: "memory");
    __syncthreads();
    if (threadIdx.x == 0) {
        unsigned* bar = b.bar;
        __builtin_amdgcn_s_waitcnt(0);
        const unsigned nloc = b.st[0];
        const unsigned old = __hip_atomic_fetch_add(&bar[XB_LSUB(b.x)], 1u, __ATOMIC_RELAXED, __HIP_MEMORY_SCOPE_WORKGROUP);
        const unsigned gen = old / nloc;
        if (old + 1u == (gen + 1u) * nloc) (void)__hip_atomic_fetch_add(&bar[XB_LGEN(b.x)], 1u, __ATOMIC_RELAXED, __HIP_MEMORY_SCOPE_WORKGROUP);
        else XB_SPIN(xb_ld(&bar[XB_LGEN(b.x)]) == gen, bar);
        __builtin_amdgcn_fence(__ATOMIC_ACQUIRE, "agent");
        asm volatile("s_waitcnt vmcnt(0)" ::: "memory");
    }
    __syncthreads();
}

#ifndef REPEAT_MASK
#define REPEAT_MASK 0
#endif
#ifndef PROBE_PHASE
#define PROBE_PHASE -1
#endif
#ifndef PROBE_MODE
#define PROBE_MODE 0
#endif
constexpr int NPHASE = 14;
struct Args { Params P; int ph_lo, ph_hi, mode, pad; };
static_assert(sizeof(Args) == sizeof(Params) + 16 && sizeof(Params) == 25 * 8, "Args has no padding");

__global__ void __launch_bounds__(512, 2) mega(Args a) {
    extern __shared__ __attribute__((aligned(16))) unsigned char lds_raw[];
    LAS unsigned char* lds = (LAS unsigned char*)lds_raw;
    const Params& P = a.P;
    const int tid = threadIdx.x, wave = __builtin_amdgcn_readfirstlane(tid >> 6);
    const int G = gridDim.x, wg = blockIdx.x, gw = wg * 8 + wave, ngw = G * 8;
#define LANE_NOW() ((int)(threadIdx.x & 63u))
    unsigned char* ws = P.ws;
    volatile LAS unsigned* MISC = (volatile LAS unsigned*)(lds + MISC_OFF);
    for (int u = tid; u < (LDS_BYTES - 131072) / 4; u += 512) ((LAS unsigned*)(lds + 131072))[u] = 0u;
    __syncthreads();
    unsigned* ctl = (unsigned*)(ws + WS_CTL);
    XcdBarrier bar = xcd_barrier_post(ctl + CW_BAR, MISC + 8);
    const int lo = a.ph_lo, hi = a.ph_hi;
#define IN(k) (lo <= (k) && (k) < hi)
#define SEAM(k) do { if ((k) + 1 < hi) xcd_barrier(bar); } while (0)
#define REP_BEGIN(k) for (int rep_ = 0; rep_ <= ((REPEAT_MASK >> (k)) & 1); ++rep_) {
#define REP_END(k) if (rep_ < ((REPEAT_MASK >> (k)) & 1)) xcd_barrier(bar); }

    half_t* XH = (half_t*)(ws + WS_XH); half_t* Z = (half_t*)(ws + WS_Z); half_t* O = (half_t*)(ws + WS_O); half_t* H1 = (half_t*)(ws + WS_H1); half_t* H2 = (half_t*)(ws + WS_H2);
    half_t* QX = (half_t*)(ws + WS_QX); half_t* PX = (half_t*)(ws + WS_PX); half_t* OX = (half_t*)(ws + WS_OX); half_t* KX = (half_t*)(ws + WS_KX); half_t* VXT = (half_t*)(ws + WS_VXT);
    half_t* MEMH = (half_t*)(ws + WS_MEMH); half_t* ACT = (half_t*)(ws + WS_ACT); half_t* Y = (half_t*)(ws + WS_Y); float* TMP = (float*)(ws + WS_TMP);
    half_t* WIN = (half_t*)(ws + WS_WIN); half_t* WMO = (half_t*)(ws + WS_WMO); half_t* WXQ = (half_t*)(ws + WS_WXQ); half_t* WXK = (half_t*)(ws + WS_WXK); half_t* WXV = (half_t*)(ws + WS_WXV);
    half_t* WXO = (half_t*)(ws + WS_WXO); half_t* WGU = (half_t*)(ws + WS_WGU); half_t* WD = (half_t*)(ws + WS_WD);
    const unsigned* CNT = (const unsigned*)(ws + WS_CTL) + CW_CNT; const int* LTOK = (const int*)(ws + WS_LTOK); const float* LW = (const float*)(ws + WS_LW);

    if (IN(0)) { REP_BEGIN(0) phase_prep(P, lds, wg, G); REP_END(0) SEAM(0); }
    int vwg = wg; bool loc = false;
    if (lo == 0 && hi == NPHASE && G == 256 && __builtin_amdgcn_readfirstlane((int)MISC[10]) != 0) { loc = true; vwg = __builtin_amdgcn_readfirstlane((int)(MISC[11] * 8u + bar.x)); }
    const int vx = vwg & 7, vr = vwg >> 3;
#define SEAM_L(k) do { if ((k) + 1 < hi) { if (loc) xcd_barrier_local(bar); else xcd_barrier(bar); } } while (0)
    if (IN(1)) { REP_BEGIN(1)
        if (G == 256) { if (vr >= 24) scan_bh(P, (LAS float*)lds, vx * 8 + vr - 24); } else { for (int bh = wg; bh < 64; bh += G) scan_bh(P, (LAS float*)lds, bh); }
        if (G == 256 && vr >= 16 && vr < 20) { const pg::DenseProb g = pg::dense(MEMH, 1024, WXK, 1024, 1024); const pg::OneUnit S{vx, vr & 3}; pg::EpiF16 E{KX, 1024, 1.f, 0, 0};
          pg::gemm_phase<pg::DenseProb, pg::EpiF16, pg::OneUnit, true, false>(lds, g, S, E); }
        if (G == 256 && vr >= 20 && vr < 24) { const pg::DenseProb g = pg::dense(MEMH, 1024, WXV, 1024, 1024); const pg::OneUnit S{vx, vr & 3}; pg::EpiF16 E{VXT, 1024, 1.f, 0, 0};
          pg::gemm_phase<pg::DenseProb, pg::EpiF16, pg::OneUnit, true, false>(lds, g, S, E); }
        { const pg::DenseProb g = pg::dense(XH, 1024, WIN, 1024, 1024); pg::StaticOrder S; S.init(T / 256, ZW / 256, G, vwg, 0); pg::EpiZ E{Z, P.pos, lds + MR_OFF, a.mode, 0};
          pg::gemm_phase<pg::DenseProb, pg::EpiZ, pg::StaticOrder, true>(lds, g, S, E); }
        if (G != 256) {
          { const pg::DenseProb g = pg::dense(MEMH, 1024, WXK, 1024, 1024); pg::StaticOrder S; S.init(MROWS / 256, 4, G, wg, 0); pg::EpiF16 E{KX, 1024, 1.f, 0, 0};
            pg::gemm_phase<pg::DenseProb, pg::EpiF16, pg::StaticOrder, true>(lds, g, S, E); }
          { const pg::DenseProb g = pg::dense(MEMH, 1024, WXV, 1024, 1024); pg::StaticOrder S; S.init(MROWS / 256, 4, G, wg, 0); pg::EpiF16 E{VXT, 1024, 1.f, 0, 0};
            pg::gemm_phase<pg::DenseProb, pg::EpiF16, pg::StaticOrder, true>(lds, g, S, E); }
        }
        REP_END(1) SEAM_L(1);
    }
    if (IN(2)) { REP_BEGIN(2)
        if (G == 256) {
            const int bb = vx, jj = vr;
            const half_t* BK = (const half_t*)(ws + WS_BK); const int* TS = (const int*)(ws + WS_TS);
            { LAS int* cst = (LAS int*)(lds + 98304); LAS int* ord = cst + 128;
              if (tid < 128) cst[tid] = 4 * (tid & 15) + 4 - TS[(bb * 8 + (tid >> 4)) * 16 + (tid & 15)];
              __syncthreads();
              if (tid < 128) { const int c = cst[tid]; int rk = 0; for (int uu = 0; uu < 128; ++uu) { const int cu = cst[uu]; rk += (cu > c || (cu == c && uu < tid)) ? 1 : 0; } ord[rk] = tid; }
              __syncthreads();
              int us[4];
#pragma unroll
              for (int i = 0; i < 4; ++i) { const int pos = (i == 0) ? jj : (i == 1) ? 63 - jj : (i == 2) ? 64 + jj : 127 - jj; us[i] = __builtin_amdgcn_readfirstlane(ord[pos]); }
              __syncthreads();
              for (int i = 0; i < 4; ++i) attn::attn_unit<0, 14>(bb, us[i] >> 4, us[i] & 15, Z, BK, TS, (const float*)(ws + WS_CUM), P.sinks, O, (char*)lds_raw); }
            attn::swa_units<4>(bb, (jj * 4) >> 6, (jj * 4) & 63, Z, P.sinks, O, (char*)lds_raw, lds + XL_OFF);
        } else {
            for (int it = gw; it < 2048; it += ngw) { const int bh = it >> 5, j = it & 31; attn_naive_item<0>(P, j, bh, LANE_NOW()); attn_naive_item<0>(P, 63 - j, bh, LANE_NOW()); }
            for (int it = gw; it < 4096; it += ngw) attn_naive_item<1>(P, it & 63, it >> 6, LANE_NOW());
        }
        REP_END(2) SEAM_L(2);
    }
    if (IN(3)) { REP_BEGIN(3)
        {
          const float* U1 = (const float*)ctl + CW_U1; const float* C1 = (const float*)ctl + CW_C1; float* UB = (float*)(ws + WS_UBH); const int lane_ = LANE_NOW();
          for (int mr_ = (G == 256) ? vx * 256 + vr * 8 + wave : gw; mr_ < MROWS; mr_ += (G == 256) ? MROWS : ngw) { float su[4], sc[4];
#pragma unroll
              for (int j = 0; j < 4; ++j) { const h4_t kv = *(const h4_t*)(KX + (size_t)mr_ * DM + 256 * j + 4 * lane_); const f4_t uu = *(const f4_t*)(U1 + 256 * j + 4 * lane_), cc = *(const f4_t*)(C1 + 256 * j + 4 * lane_);
                  su[j] = (float)kv[0] * uu[0] + (float)kv[1] * uu[1] + (float)kv[2] * uu[2] + (float)kv[3] * uu[3]; sc[j] = (float)kv[0] * cc[0] + (float)kv[1] * cc[1] + (float)kv[2] * cc[2] + (float)kv[3] * cc[3]; }
#pragma unroll
              for (int j = 0; j < 4; ++j) { su[j] = wave_sum(su[j]); sc[j] = wave_sum(sc[j]); }
              if (lane_ < 4) { float a = su[0], c = sc[0];
#pragma unroll
                  for (int j = 1; j < 4; ++j) { a = (lane_ == j) ? su[j] : a; c = (lane_ == j) ? sc[j] : c; }
                  const int bh = (mr_ >> 8) * 4 + lane_; UB[bh * 256 + (mr_ & 255)] = a; UB[16384 + bh * 256 + (mr_ & 255)] = c; } }
          constexpr int XSK = (int)((XB_STRIDE - 2 * MiB) / 2);
          if (G == 256) {
            if (vr < 16) { const pg::GTProb g{KX, (const half_t*)(ws + WS_WQS), 256, 0}; const pg::OneUnit S{vx * 4 + (vr >> 2), vr & 3}; pg::EpiF16 E{(half_t*)(ws + WS_GT), 1024, 1.f, 0, XSK};
              pg::gemm_phase<pg::GTProb, pg::EpiF16, pg::OneUnit, true, false>(lds, g, S, E); }
            else { const pg::VWProb g{WXO, VXT, 256, 0}; const pg::OneUnit S{vr & 3, vx * 4 + ((vr - 16) >> 2)}; pg::EpiF16 E{(half_t*)(ws + WS_VWT), 1024, 1.f, 1, XSK};
              pg::gemm_phase<pg::VWProb, pg::EpiF16, pg::OneUnit, true, false>(lds, g, S, E); }
          } else {
            { const pg::GTProb g{KX, (const half_t*)(ws + WS_WQS), 256, 0}; pg::StaticOrder S; S.init(32, 4, G, wg, 0); pg::EpiF16 E{(half_t*)(ws + WS_GT), 1024, 1.f, 0, XSK};
              pg::gemm_phase<pg::GTProb, pg::EpiF16, pg::StaticOrder, true, false>(lds, g, S, E); }
            { const pg::VWProb g{WXO, VXT, 256, 0}; pg::StaticOrder S; S.init(4, 32, G, wg, 0); pg::EpiF16 E{(half_t*)(ws + WS_VWT), 1024, 1.f, 1, XSK};
              pg::gemm_phase<pg::VWProb, pg::EpiF16, pg::StaticOrder, true, false>(lds, g, S, E); } } }
        const pg::DenseProb g = pg::dense(O, 1024, WMO, 1024, 1024); pg::StaticOrder S; S.init(T / 256, 4, G, vwg, 0);
        pg::EpiV<0> E{XH, H1, (float*)(ws + WS_ST1), nullptr, nullptr, lds + MR_OFF};
        pg::gemm_phase<pg::DenseProb, pg::EpiV<0>, pg::StaticOrder, true>(lds, g, S, E);
        REP_END(3) SEAM_L(3);
    }
    if (IN(5)) { REP_BEGIN(5)
        { const pg::DenseProb g{H1, (const half_t*)(ws + WS_GT), (size_t)256 * 1024, 0, (size_t)256 * 1024, XB_STRIDE / 2, 1024, 1024, 1024, 0}; pg::StaticOrder S; S.init(T / 256, 4, G, vwg, 0);
          pg::row_tables(S, (const float*)(ws + WS_ST1), lds + MR_OFF);
          pg::EpiSoftmaxFold E{PX, lds + XL_OFF, (const float*)(ws + WS_UBH), lds + MR_OFF, lds + SD_OFF, C2_256, 0};
          pg::gemm_phase<pg::DenseProb, pg::EpiSoftmaxFold, pg::StaticOrder, true>(lds, g, S, E); }
        REP_END(5) SEAM_L(5);
    }
    if (IN(8)) { REP_BEGIN(8)
        const pg::DenseProb g{PX, (const half_t*)(ws + WS_VWT), (size_t)256 * 1024, 0, (size_t)256 * 1024, XB_STRIDE / 2, 1024, 1024, 1024, 0}; pg::StaticOrder S; S.init(T / 256, 4, G, vwg, 0);
        pg::row_tables(S, (const float*)(ws + WS_ST1), lds + MR_OFF);
        pg::EpiV<1> E{H1, (half_t*)(ws + WS_V2), (float*)(ws + WS_ST2), P.ln_mix_g, P.ln_mix_b, lds + MR_OFF};
        pg::gemm_phase<pg::DenseProb, pg::EpiV<1>, pg::StaticOrder, true>(lds, g, S, E);
        REP_END(8) SEAM_L(8);
    }
    if (IN(10)) { REP_BEGIN(10)
        const bool conv_first = (wg & 1) != 0;
        for (int pass = 0; pass < 2; ++pass) {
            if ((pass == 0) == conv_first) { LAS float* scr = (LAS float*)(lds + 32768 + wave * 8448); const int ln_ = LANE_NOW();
                for (int it = gw; it < NQ_GU; it += ngw) conv_gu_item(P, scr, it, ln_); __syncthreads(); }
            else { for (int it = (G == 256) ? vx * 32 + vr : wg; it < T / 128; it += G) route_tokens_fast(P, lds, it * 128); } }
        REP_END(10) SEAM(10);
    }
    if (IN(11)) { REP_BEGIN(11)
        const pg::GUProb g{(const half_t*)(ws + WS_V2), WGU, CNT, LTOK, lds + XL_OFF, 1024, 0}; pg::MoeOrder S; S.init(CNT, G, wg, lds + SD_OFF);
        pg::EpiGU E{ACT, (const float*)ctl + CW_UGU, (const float*)ctl + CW_CGU, (const float*)(ws + WS_LMR), lds + MR_OFF};
        pg::gemm_phase<pg::GUProb, pg::EpiGU, pg::MoeOrder, true>(lds, g, S, E);
        {
          const int first = (S.total > 4 * G && S.total < 5 * G) ? S.total - 4 * G : 0, nsl = G - first;
          if (wg >= first) { LAS float* scr = (LAS float*)(lds + 32768 + wave * 8448); const int ln_ = LANE_NOW();
              for (int it = (wg - first) * 8 + wave; it < NQ_WD; it += nsl * 8) conv_wd_item(P, scr, it, ln_); } }
        REP_END(11) SEAM(11);
    }
    if (IN(12)) { REP_BEGIN(12)
        const pg::DownProb g{ACT, WD, 512, 0}; pg::MoeOrder S; S.init(CNT, G, wg, lds + SD_OFF); pg::EpiDown E{Y, CNT, LTOK, LW, lds + MR_OFF};
        pg::gemm_phase<pg::DownProb, pg::EpiDown, pg::MoeOrder, true>(lds, g, S, E);
        REP_END(12) SEAM(12);
    }
    if (IN(13)) { REP_BEGIN(13) final_ln_rows(P, gw, ngw, LANE_NOW()); REP_END(13) }
#undef IN
#undef SEAM
#undef SEAM_L
}

extern "C" void kernel_launch(void* const* d_in, const int* in_sizes, int n_in, void* d_out, int out_size, void* d_ws, size_t ws_size, hipStream_t stream) {
    static int grid = 0;
    if (grid == 0) {
        if (n_in != 23 || in_sizes[0] != T * DM || out_size != T * DM || ws_size < WS_END) { fprintf(stderr, "kernel_launch: unexpected shapes (n_in %d, in0 %d, out %d, ws %zu)\n", n_in, n_in > 0 ? in_sizes[0] : -1, out_size, ws_size); grid = -1; return; }
        int dev = 0, cus = 0;
        if (hipGetDevice(&dev) != hipSuccess || hipDeviceGetAttribute(&cus, hipDeviceAttributeMultiprocessorCount, dev) != hipSuccess) { grid = -1; return; }
        if (hipFuncSetAttribute((const void*)mega, hipFuncAttributeMaxDynamicSharedMemorySize, LDS_BYTES) != hipSuccess) { fprintf(stderr, "kernel_launch: hipFuncSetAttribute failed\n"); grid = -1; return; }
        int per_cu = 0;
        if (hipOccupancyMaxActiveBlocksPerMultiprocessor(&per_cu, (const void*)mega, 512, LDS_BYTES) != hipSuccess || per_cu < 1) fprintf(stderr, "kernel_launch: occupancy query reports %d\n", per_cu);
        (void)hipGetLastError();
        grid = cus;
    }
    if (grid < 0) return;
    (void)hipMemsetAsync((char*)d_ws + WS_CTL, 0, CTL_BYTES, stream);
    Args a{};
    Params& P = a.P;
    P.x = (const float*)d_in[0]; P.mem = (const float*)d_in[1]; P.pos = (const int*)d_in[2]; P.w_in = (const float*)d_in[3]; P.b_forget = (const float*)d_in[4];
    P.sinks = (const float*)d_in[5]; P.w_mix_out = (const float*)d_in[6]; P.ln_mix_g = (const float*)d_in[7]; P.ln_mix_b = (const float*)d_in[8];
    P.w_xq = (const float*)d_in[9]; P.w_xkv = (const float*)d_in[10]; P.w_xout = (const float*)d_in[11]; P.ln_x_g = (const float*)d_in[12]; P.ln_x_b = (const float*)d_in[13];
    P.w_rg = (const float*)d_in[14]; P.b_rg = (const float*)d_in[15]; P.w_re = (const float*)d_in[16]; P.b_re = (const float*)d_in[17];
    P.w_gate = (const float*)d_in[18]; P.w_up = (const float*)d_in[19]; P.w_down = (const float*)d_in[20]; P.ln_f_g = (const float*)d_in[21]; P.ln_f_b = (const float*)d_in[22];
    P.out = (float*)d_out; P.ws = (unsigned char*)d_ws;
    a.ph_lo = 0; a.ph_hi = NPHASE;
    hipLaunchKernelGGL(mega, dim3(grid), dim3(512), LDS_BYTES, stream, a);
#if PROBE_PHASE >= 0
    a.ph_lo = PROBE_PHASE; a.ph_hi = PROBE_PHASE + 1; a.mode = PROBE_MODE;
    hipLaunchKernelGGL(mega, dim3(grid), dim3(512), LDS_BYTES, stream, a);
#endif
}
```
